# Optimizing an MI355X kernel written in HIP

```python
import math
import jax, jax.numpy as jnp
from jax import lax
import numpy as np

D_MODEL = 1024
BATCH = 16
SEQ = 2048
DEPTH = 1

RET_HEADS = 4
RET_DK = 128
RET_DV = 128
RET_WIDTH = RET_HEADS * RET_DV
RET_CHUNK = 128
ROPE_BASE = 10000.0
DIFF_HEADS = 4
DIFF_DK = 64
DIFF_DV = 128
DIFF_WIDTH = DIFF_HEADS * DIFF_DV
Q_BLOCK = 128
MIX_WIDTH = RET_WIDTH + DIFF_WIDTH
COL_SIZES = (RET_HEADS * RET_DK, RET_HEADS * RET_DK, RET_WIDTH, RET_WIDTH,
             DIFF_HEADS * 2 * DIFF_DK, DIFF_HEADS * 2 * DIFF_DK, DIFF_WIDTH)
IN_COLS = sum(COL_SIZES)
COL_SPLITS = tuple(int(s) for s in np.cumsum(COL_SIZES)[:-1])
PEER_HEADS = 8
PEER_N_KEYS = 128
PEER_N_EXPERTS = PEER_N_KEYS * PEER_N_KEYS
PEER_D_QUERY = 256
PEER_D_HALF = PEER_D_QUERY // 2
PEER_TOPK = 16
PEER_TOKEN_CHUNK = 128
DEEPNORM_ALPHA = (2.0 * DEPTH) ** 0.25
DEEPNORM_BETA = (8.0 * DEPTH) ** -0.25
LN_EPS = 1e-5

kernel_name = "hymba_retnet_diffattn_peer_deepnorm"


def lambda_init(layer_idx):
    return 0.8 - 0.6 * math.exp(-0.3 * (layer_idx - 1))


def layer_norm(x, g, b):
    xf = x.astype(jnp.float32)
    mu = jnp.mean(xf, -1, keepdims=True)
    var = jnp.mean(jnp.square(xf - mu), -1, keepdims=True)
    return ((xf - mu) * lax.rsqrt(var + LN_EPS) * g + b).astype(x.dtype)


def rotary(x, pos):
    half = x.shape[-1] // 2
    inv = ROPE_BASE ** (-jnp.arange(half, dtype=jnp.float32) / half)
    ang = pos.astype(jnp.float32)[:, None] * inv[None, :]
    cos = jnp.cos(ang).astype(x.dtype)
    sin = jnp.sin(ang).astype(x.dtype)
    x1, x2 = x[..., :half], x[..., half:]
    return jnp.concatenate([x1 * cos - x2 * sin, x1 * sin + x2 * cos], axis=-1)


def retention_chunkwise(q, k, v):
    B, H, S, dk = q.shape
    dv = v.shape[-1]
    C = RET_CHUNK
    n = S // C
    qf, kf, vf = q.astype(jnp.float32), k.astype(jnp.float32) * dk ** -0.5, v.astype(jnp.float32)
    log_g = jnp.log1p(-(2.0 ** (-5.0 - jnp.arange(H, dtype=jnp.float32))))
    idx = jnp.arange(C, dtype=jnp.float32)
    rel = idx[:, None] - idx[None, :]
    decay_in = jnp.where(rel[None] >= 0, jnp.exp(jnp.maximum(rel, 0.0)[None] * log_g[:, None, None]), 0.0)
    decay_q = jnp.exp((idx + 1.0)[None, :] * log_g[:, None])
    decay_k = jnp.exp((C - 1.0 - idx)[None, :] * log_g[:, None])
    decay_c = jnp.exp(C * log_g)

    def to_chunks(t):
        return t.reshape(B, H, n, C, t.shape[-1]).transpose(2, 0, 1, 3, 4)

    def step(state, inp):
        qi, ki, vi = inp
        s = jnp.einsum('bhid,bhjd->bhij', qi, ki) * decay_in[None]
        inner = jnp.einsum('bhij,bhjv->bhiv', s, vi)
        cross = jnp.einsum('bhid,bhdv->bhiv', qi, state) * decay_q[None, :, :, None]
        state = state * decay_c[None, :, None, None] + jnp.einsum(
            'bhjd,bhjv->bhdv', ki * decay_k[None, :, :, None], vi)
        return state, inner + cross

    state0 = jnp.zeros((B, H, dk, dv), jnp.float32)
    _, out = lax.scan(step, state0, (to_chunks(qf), to_chunks(kf), to_chunks(vf)))
    return out.transpose(1, 2, 0, 3, 4).reshape(B, H, S, dv).astype(q.dtype)


def diff_attention(q, k, v, lam):
    B, H, _, S, dk = q.shape
    dv = v.shape[-1]
    nb = S // Q_BLOCK
    scale = dk ** -0.5
    kpos = jnp.arange(S)
    qb = q.reshape(B, H, 2, nb, Q_BLOCK, dk).transpose(3, 0, 1, 2, 4, 5)

    def block(args):
        qi, i = args
        s = jnp.einsum('bhcqd,bhckd->bhcqk', qi, k).astype(jnp.float32) * scale
        qpos = i * Q_BLOCK + jnp.arange(Q_BLOCK)
        mask = kpos[None, :] <= qpos[:, None]
        p = jax.nn.softmax(jnp.where(mask, s, -jnp.inf), axis=-1)
        a = p[:, :, 0] - lam * p[:, :, 1]
        return jnp.einsum('bhqk,bhkv->bhqv', a.astype(v.dtype), v)

    out = lax.map(block, (qb, jnp.arange(nb)))
    return out.transpose(1, 2, 0, 3, 4).reshape(B, H, S, dv)


def head_norm(o, g, b, rms_only):
    B, H, S, d = o.shape
    of = o.astype(jnp.float32)
    if rms_only:
        on = of * lax.rsqrt(jnp.mean(jnp.square(of), -1, keepdims=True) + LN_EPS)
    else:
        mu = jnp.mean(of, -1, keepdims=True)
        var = jnp.mean(jnp.square(of - mu), -1, keepdims=True)
        on = (of - mu) * lax.rsqrt(var + LN_EPS)
    on = on.transpose(0, 2, 1, 3).reshape(B, S, H * d) * g
    if b is not None:
        on = on + b
    return on.astype(o.dtype)


def hybrid_mixer(x, w_in, ret_gn_g, ret_gn_b, lq1, lk1, lq2, lk2, subln_g, w_out, lam_init):
    B, S, _ = x.shape
    pos = jnp.arange(S)
    proj = x @ w_in
    rq, rk, rv, rg, dq, dk, dv = jnp.split(proj, COL_SPLITS, axis=-1)
    heads = lambda t, d: t.reshape(B, S, -1, d).transpose(0, 2, 1, 3)
    r_out = retention_chunkwise(rotary(heads(rq, RET_DK), pos), rotary(heads(rk, RET_DK), pos),
                                heads(rv, RET_DV))
    r = jax.nn.silu(rg) * head_norm(r_out, ret_gn_g, ret_gn_b, rms_only=False)
    dq = dq.reshape(B, S, DIFF_HEADS, 2, DIFF_DK).transpose(0, 2, 3, 1, 4)
    dk = dk.reshape(B, S, DIFF_HEADS, 2, DIFF_DK).transpose(0, 2, 3, 1, 4)
    f32 = jnp.float32
    lam = (jnp.exp(jnp.sum(lq1.astype(f32) * lk1.astype(f32)))
           - jnp.exp(jnp.sum(lq2.astype(f32) * lk2.astype(f32))) + lam_init)
    d_out = diff_attention(dq, dk, heads(dv, DIFF_DV), lam)
    d = head_norm(d_out, subln_g, None, rms_only=True) * (1.0 - lam_init)
    return jnp.concatenate([r, d], axis=-1) @ w_out


def peer(x, w_query, sub_keys, expert_u, expert_v):
    B, S, D = x.shape
    T = B * S
    xt = x.reshape(T, D)
    q = (xt @ w_query).reshape(T, PEER_HEADS, 2, PEER_D_HALF)
    s = jnp.einsum('thcd,hckd->thck', q, sub_keys).astype(jnp.float32)
    top_s, top_i = lax.top_k(s, PEER_TOPK)
    cand_s = (top_s[:, :, 0, :, None] + top_s[:, :, 1, None, :]).reshape(T, PEER_HEADS, PEER_TOPK ** 2)
    cand_i = (top_i[:, :, 0, :, None] * PEER_N_KEYS + top_i[:, :, 1, None, :]).reshape(T, PEER_HEADS, PEER_TOPK ** 2)
    best_s, pos = lax.top_k(cand_s, PEER_TOPK)
    expert_idx = jnp.take_along_axis(cand_i, pos, axis=-1)
    gate = jax.nn.softmax(best_s, axis=-1)
    C = PEER_TOKEN_CHUNK
    nc = T // C
    E = PEER_HEADS * PEER_TOPK

    def chunk(args):
        xc, ic, gc = args
        u = jnp.take(expert_u, ic, axis=0)
        h = jax.nn.gelu(jnp.einsum('cd,ced->ce', xc, u).astype(jnp.float32), approximate=False)
        vv = jnp.take(expert_v, ic, axis=0)
        return jnp.einsum('ce,ced->cd', (gc * h).astype(vv.dtype), vv)

    out = lax.map(chunk, (xt.reshape(nc, C, D), expert_idx.reshape(nc, C, E), gate.reshape(nc, C, E)))
    return out.reshape(B, S, D).astype(x.dtype)


def setup_inputs(seed: int = 0) -> dict:
    key = jax.random.key(seed)
    ks = jax.random.split(key, 24)
    nrm = lambda k, shape, s: jax.random.normal(k, shape, jnp.float32) * s
    L = DEPTH
    beta = DEEPNORM_BETA
    col_scale = jnp.concatenate([
        jnp.full((COL_SIZES[0] + COL_SIZES[1],), 1.0),
        jnp.full((COL_SIZES[2],), beta),
        jnp.full((COL_SIZES[3] + COL_SIZES[4] + COL_SIZES[5],), 1.0),
        jnp.full((COL_SIZES[6],), beta),
    ]).astype(jnp.float32)
    w_in = nrm(ks[1], (L, D_MODEL, IN_COLS), D_MODEL ** -0.5) * col_scale
    return {
        "x": nrm(ks[0], (BATCH, SEQ, D_MODEL), 1.0),
        "w_in": w_in,
        "ret_gn_g": 1.0 + nrm(ks[2], (L, RET_WIDTH), 0.02),
        "ret_gn_b": nrm(ks[3], (L, RET_WIDTH), 0.02),
        "diff_lambda_q1": nrm(ks[4], (L, DIFF_DK), 0.1),
        "diff_lambda_k1": nrm(ks[5], (L, DIFF_DK), 0.1),
        "diff_lambda_q2": nrm(ks[6], (L, DIFF_DK), 0.1),
        "diff_lambda_k2": nrm(ks[7], (L, DIFF_DK), 0.1),
        "diff_subln_g": 1.0 + nrm(ks[8], (L, DIFF_WIDTH), 0.02),
        "w_out": nrm(ks[9], (L, MIX_WIDTH, D_MODEL), MIX_WIDTH ** -0.5 * beta),
        "ln1_g": 1.0 + nrm(ks[10], (L, D_MODEL), 0.02),
        "ln1_b": nrm(ks[11], (L, D_MODEL), 0.02),
        "peer_w_query": nrm(ks[12], (L, D_MODEL, PEER_HEADS * PEER_D_QUERY), D_MODEL ** -0.5),
        "peer_sub_keys": nrm(ks[13], (L, PEER_HEADS, 2, PEER_N_KEYS, PEER_D_HALF), PEER_D_HALF ** -0.5),
        "peer_u": nrm(ks[14], (L, PEER_N_EXPERTS, D_MODEL), D_MODEL ** -0.5),
        "peer_v": nrm(ks[15], (L, PEER_N_EXPERTS, D_MODEL), beta),
        "ln2_g": 1.0 + nrm(ks[16], (L, D_MODEL), 0.02),
        "ln2_b": nrm(ks[17], (L, D_MODEL), 0.02),
    }


def reference(x, w_in, ret_gn_g, ret_gn_b, diff_lambda_q1, diff_lambda_k1, diff_lambda_q2,
              diff_lambda_k2, diff_subln_g, w_out, ln1_g, ln1_b, peer_w_query, peer_sub_keys,
              peer_u, peer_v, ln2_g, ln2_b):
    for l in range(DEPTH):
        mix = hybrid_mixer(x, w_in[l], ret_gn_g[l], ret_gn_b[l], diff_lambda_q1[l], diff_lambda_k1[l],
                           diff_lambda_q2[l], diff_lambda_k2[l], diff_subln_g[l], w_out[l],
                           lambda_init(l + 1))
        x = layer_norm(DEEPNORM_ALPHA * x + mix, ln1_g[l], ln1_b[l])
        ffn = peer(x, peer_w_query[l], peer_sub_keys[l], peer_u[l], peer_v[l])
        x = layer_norm(DEEPNORM_ALPHA * x + ffn, ln2_g[l], ln2_b[l])
    return x
```

```cpp
#include <hip/hip_runtime.h>
#include <cstdio>
#include <cstdint>
#include <cmath>
namespace pg8 {
#define PG8_LAS __attribute__((address_space(3)))
typedef unsigned short bf16_t;
typedef short bf16x8 __attribute__((ext_vector_type(8)));
typedef float f32x4 __attribute__((ext_vector_type(4)));
typedef unsigned u32x4 __attribute__((ext_vector_type(4)));
constexpr int BM = 256, BK = 64, HALF = 128, HTB = HALF * BK * 2  , STAGE_BYTES = 8 * HTB, NXCD = 8, WGM = 8;

__host__ __device__ __forceinline__ int lds_byte(int r, int c) { const int st = (r >> 4) * 2 + (c >> 5), rr = r & 15, cc = c & 31, ob = rr * 64 + cc * 2; return st * 1024 + (ob ^ (((ob >> 9) & 1) << 5)); }
__host__ __device__ __forceinline__ void stage_rc(int b, int& R, int& C) { const int st = b / 1024, sb = b % 1024, swz = sb ^ (((sb >> 9) & 1) << 5); R = (st >> 1) * 16 + swz / 64; C = (st & 1) * 32 + (swz % 64) / 2; }
__host__ __device__ __forceinline__ int perm32(int rho) { const int n = rho >> 4, i = rho & 15; return 8 * (i >> 2) + 4 * n + (i & 3); }

struct Unit { int pm, pn; };
struct Gemm { const bf16_t* A; const bf16_t* Bt; int M, N, K; };

struct StaticOrder {
    int nM, nN, nwg, G, c;
    __host__ __device__ void init(int M, int N, int G_, int c_) { nM = M / BM; nN = N / BM; nwg = nM * nN; G = G_; c = c_; }
    __host__ __device__ bool next(int i, Unit& u) const {
        const long L = (long)i * G + c; if (L >= nwg) return false;
        int wgid = (int)L; { const int q = nwg / NXCD, r = nwg % NXCD, xcd = wgid % NXCD, off = wgid / NXCD; wgid = (xcd < r ? xcd * (q + 1) : r * (q + 1) + (xcd - r) * q) + off; }
        const int nig = WGM * nN, gid = wgid / nig, fm = gid * WGM, gsz = (nM - fm) < WGM ? (nM - fm) : WGM;
        u.pm = fm + ((wgid % nig) % gsz); u.pn = (wgid % nig) / gsz; return true;
    }
    __device__ __forceinline__ void a_ready(const Unit&) const {}
    __device__ __forceinline__ void done(const Unit&) const {}
};

__device__ __forceinline__ unsigned cvt_pk_bf16(float lo, float hi) { unsigned r; asm volatile("v_cvt_pk_bf16_f32 %0, %1, %2" : "=v"(r) : "v"(lo), "v"(hi)); return r; }
typedef float f32x2 __attribute__((ext_vector_type(2)));
__device__ __forceinline__ f32x2 gelu_pk(f32x2 v) {
    const f32x2 av = __builtin_elementwise_abs(v), d = av * 0.2316418882f + 1.0f;
    f32x2 t; t.x = __builtin_amdgcn_rcpf(d.x); t.y = __builtin_amdgcn_rcpf(d.y);
    f32x2 q = t * 0.5307027145f + (-0.7265760135f); q = q * t + 0.7107068705f; q = q * t + (-0.142248368f); q = q * t + 0.127414796f; q = q * t;
    const f32x2 s = (v * v) * (-0.72134752044f);
    f32x2 e; e.x = __builtin_amdgcn_exp2f(s.x); e.y = __builtin_amdgcn_exp2f(s.y);
    const f32x2 m = v * (q * e), r = v - m;
    f32x2 o; o.x = v.x < 0.f ? m.x : r.x; o.y = v.y < 0.f ? m.y : r.y; return o;
}

struct EpiProj {
    static constexpr bool PERM = true, AFTER_DRAIN = false;
    bf16_t* O; int ldc; const float* rope; float kscale, qscale;
    __device__ __forceinline__ void operator()(const f32x4 (&acc)[2][2][4][2], const Unit& u, int wr, int wc, int fr, int fq) const {
        const int row0 = u.pm * BM + wr * 64 + fr; const int col0 = u.pn * BM + wc * 32 + 8 * fq;
        const int pn = u.pn;
        const bool rot = pn < 4; const bool gate = (pn == 6 || pn == 7);
        const float sc = (pn == 2 || pn == 3) ? kscale : ((pn == 8 || pn == 9) ? qscale : 1.f);
#pragma unroll
        for (int ai = 0; ai < 2; ++ai)
#pragma unroll
            for (int m = 0; m < 4; ++m) {
                const int row = row0 + ai * HALF + m * 16;
                bf16_t* rowp = O + (size_t)row * ldc + col0;
                f32x4 cs0 = (f32x4){1.f, 0.f, 1.f, 0.f}, cs1 = cs0;
                if (rot) { const float* rp = rope + ((size_t)(row & 2047) * 64 + 16 * wc + 4 * fq) * 2; cs0 = *(const f32x4*)rp; cs1 = *(const f32x4*)(rp + 4); }
#pragma unroll
                for (int bj = 0; bj < 2; ++bj) {
                    f32x4 v0 = acc[ai][bj][m][0], v1 = acc[ai][bj][m][1];
                    if (rot) {
                        f32x4 r0, r1;
                        r0[0] = v0[0] * cs0[0] - v0[1] * cs0[1]; r0[1] = v0[0] * cs0[1] + v0[1] * cs0[0];
                        r0[2] = v0[2] * cs0[2] - v0[3] * cs0[3]; r0[3] = v0[2] * cs0[3] + v0[3] * cs0[2];
                        r1[0] = v1[0] * cs1[0] - v1[1] * cs1[1]; r1[1] = v1[0] * cs1[1] + v1[1] * cs1[0];
                        r1[2] = v1[2] * cs1[2] - v1[3] * cs1[3]; r1[3] = v1[2] * cs1[3] + v1[3] * cs1[2];
                        v0 = r0; v1 = r1;
                    }
                    if (gate) {
#pragma unroll
                        for (int j = 0; j < 4; ++j) { v0[j] = v0[j] * __builtin_amdgcn_rcpf(1.f + __builtin_amdgcn_exp2f(-1.4426950408889634f * v0[j])); v1[j] = v1[j] * __builtin_amdgcn_rcpf(1.f + __builtin_amdgcn_exp2f(-1.4426950408889634f * v1[j])); }
                    }
                    v0 = v0 * sc; v1 = v1 * sc;
                    u32x4 w; w.x = cvt_pk_bf16(v0[0], v0[1]); w.y = cvt_pk_bf16(v0[2], v0[3]); w.z = cvt_pk_bf16(v1[0], v1[1]); w.w = cvt_pk_bf16(v1[2], v1[3]);
                    *(u32x4*)(rowp + bj * HALF) = w;
                }
            }
    }
};
struct EpiPlainBf16 {
    static constexpr bool PERM = true, AFTER_DRAIN = false;
    bf16_t* O; int ldc;
    __device__ __forceinline__ void operator()(const f32x4 (&acc)[2][2][4][2], const Unit& u, int wr, int wc, int fr, int fq) const {
        const int row0 = u.pm * BM + wr * 64 + fr; const int col0 = u.pn * BM + wc * 32 + 8 * fq;
#pragma unroll
        for (int ai = 0; ai < 2; ++ai)
#pragma unroll
            for (int m = 0; m < 4; ++m) { bf16_t* rowp = O + (size_t)(row0 + ai * HALF + m * 16) * ldc + col0;
#pragma unroll
                for (int bj = 0; bj < 2; ++bj) { const f32x4 v0 = acc[ai][bj][m][0], v1 = acc[ai][bj][m][1];
                    u32x4 w; w.x = cvt_pk_bf16(v0[0], v0[1]); w.y = cvt_pk_bf16(v0[2], v0[3]); w.z = cvt_pk_bf16(v1[0], v1[1]); w.w = cvt_pk_bf16(v1[2], v1[3]);
                    *(u32x4*)(rowp + bj * HALF) = w; } }
    }
};
struct EpiResF32 {
    static constexpr bool PERM = false, AFTER_DRAIN = false;
    const float* base; float* out; int ldc; float alpha;
    __device__ __forceinline__ void operator()(const f32x4 (&acc)[2][2][4][2], const Unit& u, int wr, int wc, int fr, int fq) const {
        const int row0 = u.pm * BM + wr * 64 + fr; const int col0 = u.pn * BM + wc * 32 + 4 * fq;
#pragma unroll
        for (int ai = 0; ai < 2; ++ai)
#pragma unroll
            for (int m = 0; m < 4; ++m) { const size_t off = (size_t)(row0 + ai * HALF + m * 16) * ldc + col0;
#pragma unroll
                for (int bj = 0; bj < 2; ++bj)
#pragma unroll
                    for (int n = 0; n < 2; ++n) { const f32x4 bs = *(const f32x4*)(base + off + bj * HALF + n * 16); *(f32x4*)(out + off + bj * HALF + n * 16) = bs * alpha + acc[ai][bj][m][n]; } }
    }
};

template <class Epi, class Sched, bool ALIGN_EPI = false, bool SP2 = false>
__device__ __forceinline__ void gemm_phase(PG8_LAS unsigned char* lds, const Gemm g, const Sched& S, const Epi& E) {
    const int tid = threadIdx.x, wid = __builtin_amdgcn_readfirstlane(tid >> 6), lane = tid & 63, wr = wid >> 2, wc = wid & 3, fr = lane & 15, fq = lane >> 4;
    const int K = g.K, nt = K / BK;
    unsigned voffA[2], voffB[2];
#pragma unroll
    for (int i = 0; i < 2; ++i) { int R, C; stage_rc(tid * 16 + i * 8192, R, C); const int Rb = Epi::PERM ? ((R & ~31) + perm32(R & 31)) : R;
        voffA[i] = (unsigned)(R * K + C) * 2u; voffB[i] = (unsigned)(Rb * K + C) * 2u; }
    const size_t kstep = (size_t)(BK * 2);
    const size_t hstep = (size_t)HALF * K * 2;
    const size_t tstep = 2 * hstep;
    const unsigned ldsw = (unsigned)wid * 1024u;
    const int aoff = lds_byte(wr * 64 + fr, fq * 8), boff = lds_byte(wc * 32 + fr, fq * 8);
#define PG8_SA(b, h) (((b) * 2 + (h)) * HTB)
#define PG8_SB(b, h) ((4 + (b) * 2 + (h)) * HTB)
#define PG8_STAGE(bufoff, gbase, voff) do { _Pragma("unroll") for (int _i = 0; _i < 2; ++_i) \
        __builtin_amdgcn_global_load_lds((const unsigned*)((const char*)(gbase) + (voff)[_i]), (PG8_LAS unsigned*)(lds + (bufoff) + ldsw + _i * 8192), 16, 0, 0); } while (0)
#define PG8_LDA(dst, b, h) do { _Pragma("unroll") for (int m = 0; m < 4; ++m) _Pragma("unroll") for (int k = 0; k < 2; ++k) dst[m][k] = *(const PG8_LAS bf16x8*)(lds + PG8_SA(b, h) + aoff + m * 2048 + k * 1024); } while (0)
#define PG8_LDB(dst, b, h) do { _Pragma("unroll") for (int n = 0; n < 2; ++n) _Pragma("unroll") for (int k = 0; k < 2; ++k) dst[n][k] = *(const PG8_LAS bf16x8*)(lds + PG8_SB(b, h) + boff + n * 2048 + k * 1024); } while (0)
#define PG8_MMA(ai, bj, At, Bt) do { __builtin_amdgcn_s_setprio(1); _Pragma("unroll") for (int m = 0; m < 4; ++m) _Pragma("unroll") for (int n = 0; n < 2; ++n) _Pragma("unroll") for (int k = 0; k < 2; ++k) \
        acc[ai][bj][m][n] = __builtin_amdgcn_mfma_f32_16x16x32_bf16(Bt[n][k], At[m][k], acc[ai][bj][m][n], 0, 0, 0); __builtin_amdgcn_s_setprio(0); } while (0)
#define PG8_WAIT_V(n) asm volatile("s_waitcnt vmcnt(" #n ")" ::: "memory")
#define PG8_WAIT_L(n) asm volatile("s_waitcnt lgkmcnt(" #n ")" ::: "memory")
#define PG8_BAR __builtin_amdgcn_s_barrier()
#define PG8_SCHED __builtin_amdgcn_sched_barrier(0)
    Unit cur, nxt; int ui = 0;
    if (!S.next(0, cur)) return;
    f32x4 acc[2][2][4][2];
#pragma unroll
    for (int a = 0; a < 2; ++a)
#pragma unroll
        for (int b = 0; b < 2; ++b)
#pragma unroll
            for (int m = 0; m < 4; ++m)
#pragma unroll
                for (int n = 0; n < 2; ++n) acc[a][b][m][n] = (f32x4){0.f, 0.f, 0.f, 0.f};
    bf16x8 At[4][2], B0[2][2], B1[2][2];
    const char* cA = (const char*)g.A + (size_t)cur.pm * tstep; const char* cB = (const char*)g.Bt + (size_t)cur.pn * tstep;
    S.a_ready(cur);
    if constexpr (SP2) {
        PG8_STAGE(PG8_SB(0, 0), cB, voffB); PG8_STAGE(PG8_SB(0, 1), cB + hstep, voffB); PG8_STAGE(PG8_SA(0, 0), cA, voffA); PG8_STAGE(PG8_SA(0, 1), cA + hstep, voffA);
        if (wr == 1) PG8_BAR;
        PG8_WAIT_V(2); PG8_BAR;
        PG8_STAGE(PG8_SB(1, 0), cB + kstep, voffB); PG8_STAGE(PG8_SA(1, 0), cA + kstep, voffA); PG8_STAGE(PG8_SB(1, 1), cB + hstep + kstep, voffB);
        PG8_WAIT_V(6); PG8_BAR;
    } else {
        PG8_STAGE(PG8_SB(0, 0), cB, voffB); PG8_STAGE(PG8_SA(0, 0), cA, voffA); PG8_STAGE(PG8_SB(0, 1), cB + hstep, voffB); PG8_STAGE(PG8_SA(0, 1), cA + hstep, voffA);
        if (wr == 1) PG8_BAR;
        PG8_WAIT_V(4); PG8_BAR;
        PG8_STAGE(PG8_SB(1, 0), cB + kstep, voffB); PG8_STAGE(PG8_SA(1, 0), cA + kstep, voffA); PG8_STAGE(PG8_SB(1, 1), cB + hstep + kstep, voffB);
        PG8_WAIT_V(6); PG8_BAR;
    }
    for (;;) {
        const bool has_next = S.next(ui + 1, nxt);
        const char* nA = has_next ? (const char*)g.A + (size_t)nxt.pm * tstep : cA; const char* nB = has_next ? (const char*)g.Bt + (size_t)nxt.pn * tstep : cB;
        for (int t = 0; t < nt; t += 2) {
            const bool last = (t == nt - 2);
            const char* a1 = cA + (size_t)(t + 1) * kstep;
            const char* a2 = last ? nA : cA + (size_t)(t + 2) * kstep; const char* b2 = last ? nB : cB + (size_t)(t + 2) * kstep;
            const char* a3 = a2 + kstep; const char* b3 = b2 + kstep;
            if (last && has_next) S.a_ready(nxt);
            if constexpr (SP2) {
            PG8_LDB(B0, 0, 0); PG8_LDB(B1, 0, 1); PG8_SCHED; PG8_LDA(At, 0, 0); PG8_STAGE(PG8_SA(1, 1), a1 + hstep, voffA);
            PG8_WAIT_V(8); PG8_WAIT_L(0); PG8_BAR; PG8_MMA(0, 0, At, B0); PG8_MMA(0, 1, At, B1); PG8_BAR; PG8_SCHED;
            PG8_LDA(At, 0, 1); PG8_STAGE(PG8_SB(0, 0), b2, voffB); PG8_STAGE(PG8_SB(0, 1), b2 + hstep, voffB); PG8_STAGE(PG8_SA(0, 0), a2, voffA);
            PG8_WAIT_V(8); PG8_WAIT_L(0); PG8_BAR; PG8_MMA(1, 0, At, B0); PG8_MMA(1, 1, At, B1); PG8_BAR; PG8_SCHED;
            PG8_LDB(B0, 1, 0); PG8_LDB(B1, 1, 1); PG8_SCHED; PG8_LDA(At, 1, 0); PG8_STAGE(PG8_SA(0, 1), a2 + hstep, voffA);
            PG8_WAIT_V(8); PG8_WAIT_L(0); PG8_BAR; PG8_MMA(0, 0, At, B0); PG8_MMA(0, 1, At, B1); PG8_BAR; PG8_SCHED;
            PG8_LDA(At, 1, 1); PG8_STAGE(PG8_SB(1, 0), b3, voffB); PG8_STAGE(PG8_SB(1, 1), b3 + hstep, voffB); PG8_STAGE(PG8_SA(1, 0), a3, voffA);
            PG8_WAIT_V(8); PG8_WAIT_L(0); PG8_BAR; PG8_MMA(1, 0, At, B0); PG8_MMA(1, 1, At, B1); PG8_BAR; PG8_SCHED;
            } else {
            PG8_LDB(B0, 0, 0); PG8_SCHED; PG8_LDA(At, 0, 0); PG8_STAGE(PG8_SA(1, 1), a1 + hstep, voffA);
            PG8_WAIT_L(8); PG8_BAR; PG8_WAIT_L(0); PG8_MMA(0, 0, At, B0); PG8_BAR; PG8_SCHED;
            PG8_LDB(B1, 0, 1); PG8_STAGE(PG8_SB(0, 0), b2, voffB);
            PG8_BAR; PG8_WAIT_L(0); PG8_MMA(0, 1, At, B1); PG8_BAR;
            PG8_LDA(At, 0, 1); PG8_STAGE(PG8_SA(0, 0), a2, voffA);
            PG8_BAR; PG8_WAIT_L(0); PG8_MMA(1, 0, At, B0); PG8_BAR; PG8_SCHED;
            PG8_STAGE(PG8_SB(0, 1), b2 + hstep, voffB);
            PG8_WAIT_V(6); PG8_BAR; PG8_MMA(1, 1, At, B1); PG8_BAR;
            PG8_LDB(B0, 1, 0); PG8_SCHED; PG8_LDA(At, 1, 0); PG8_STAGE(PG8_SA(0, 1), a2 + hstep, voffA);
            PG8_WAIT_L(8); PG8_BAR; PG8_WAIT_L(0); PG8_MMA(0, 0, At, B0); PG8_BAR; PG8_SCHED;
            PG8_LDB(B1, 1, 1); PG8_STAGE(PG8_SB(1, 0), b3, voffB);
            PG8_BAR; PG8_WAIT_L(0); PG8_MMA(0, 1, At, B1); PG8_BAR;
            PG8_LDA(At, 1, 1); PG8_STAGE(PG8_SA(1, 0), a3, voffA);
            PG8_BAR; PG8_WAIT_L(0); PG8_MMA(1, 0, At, B0); PG8_BAR; PG8_SCHED;
            PG8_STAGE(PG8_SB(1, 1), b3 + hstep, voffB);
            PG8_WAIT_V(6); PG8_BAR; PG8_MMA(1, 1, At, B1); PG8_BAR;
            }
        }
        if constexpr (ALIGN_EPI) { if (wr == 0) PG8_BAR; }
        if constexpr (!Epi::AFTER_DRAIN) { E(acc, cur, wr, wc, fr, fq); S.done(cur); }
        if (!has_next) break;
#pragma unroll
        for (int a = 0; a < 2; ++a)
#pragma unroll
            for (int b = 0; b < 2; ++b)
#pragma unroll
                for (int m = 0; m < 4; ++m)
#pragma unroll
                    for (int n = 0; n < 2; ++n) acc[a][b][m][n] = (f32x4){0.f, 0.f, 0.f, 0.f};
        cur = nxt; cA = nA; cB = nB; ++ui;
        if constexpr (ALIGN_EPI) { if (wr == 1) PG8_BAR; }
    }
    PG8_WAIT_V(0);
    if constexpr (!ALIGN_EPI) { if (wr == 0) PG8_BAR; }
    PG8_BAR;
    if constexpr (Epi::AFTER_DRAIN) { E.fused(acc, cur, wr, wc, fr, fq, lds, wid, lane); S.done(cur); }
#undef PG8_SA
#undef PG8_SB
#undef PG8_STAGE
#undef PG8_LDA
#undef PG8_LDB
#undef PG8_MMA
#undef PG8_WAIT_V
#undef PG8_WAIT_L
#undef PG8_BAR
#undef PG8_SCHED
}
}

#ifndef PG8_SP2
#define PG8_SP2 true
#endif
#ifndef PG8_ALIGN
#define PG8_ALIGN true
#endif
#define GAS __attribute__((address_space(1)))
#define LAS __attribute__((address_space(3)))
typedef unsigned short bf16;
typedef unsigned v4u __attribute__((ext_vector_type(4)));
typedef float f32x4 __attribute__((ext_vector_type(4)));
typedef short bf16x8 __attribute__((ext_vector_type(8)));
typedef GAS unsigned gu32;
typedef GAS unsigned long long gu64;
#define RLX_AGENT __ATOMIC_RELAXED, __HIP_MEMORY_SCOPE_AGENT
#define LDS_WAIT() asm volatile("s_waitcnt lgkmcnt(0)" ::: "memory")
#define VM_WAIT() asm volatile("s_waitcnt vmcnt(0)" ::: "memory")
__device__ __forceinline__ unsigned long long rt() { return __builtin_amdgcn_s_memrealtime(); }
__device__ __forceinline__ unsigned f2bf(float f) { unsigned u = __builtin_bit_cast(unsigned, f); return (u + 0x7fffu + ((u >> 16) & 1u)) >> 16; }
__device__ __forceinline__ unsigned pk2(float lo, float hi) { return f2bf(lo) | (f2bf(hi) << 16); }

#define XB_TMO      128
#define XB_XCNT(j)  (256  + 64 * (j))
#define XB_XSUB(j)  (1280 + 64 * (j))
#define XB_XGEN(j)  (2304 + 64 * (j))
#define XB_TOP      3328
#define XB_TOPGEN   3392
#define XCD_BAR_WORDS 3456
#define XB_SPIN_CAP (1u << 18)

__device__ __forceinline__ unsigned xb_ld(unsigned* p)              { return __hip_atomic_load(p, __ATOMIC_RELAXED, __HIP_MEMORY_SCOPE_AGENT); }
__device__ __forceinline__ unsigned xb_add(unsigned* p, unsigned v) { return __hip_atomic_fetch_add(p, v, __ATOMIC_RELAXED, __HIP_MEMORY_SCOPE_AGENT); }
__device__ __forceinline__ unsigned xb_xcc_id() { return (unsigned)__builtin_amdgcn_s_getreg((3 << 11) | 20) & 0xFu; }
#define XB_SPIN(cond, bar) do { unsigned _sp = 0; while (cond) { __builtin_amdgcn_s_sleep(1); \
    if ((++_sp & 255u) == 0u) { if (xb_ld(&(bar)[XB_TMO])) break; if (_sp > XB_SPIN_CAP) { atomicAdd(&(bar)[XB_TMO], 1u); break; } } } } while (0)

struct XcdBarrier {
    unsigned* bar; unsigned x;
    volatile LAS unsigned* st;
};

__device__ __forceinline__ XcdBarrier xcd_barrier_post(unsigned* bar, volatile LAS unsigned* st) {
    XcdBarrier b; b.bar = bar; b.x = xb_xcc_id(); b.st = st;
    if (threadIdx.x == 0) (void)xb_add(&bar[XB_XCNT(b.x)], 1u);
    return b;
}
__device__ __forceinline__ void xcd_barrier_complete(unsigned* bar, unsigned x, unsigned& nloc, unsigned& nx) {
    const unsigned G = gridDim.x * gridDim.y * gridDim.z;
    unsigned sum, cnt, mine, sp = 0u;
    for (;;) {
        sum = 0u; cnt = 0u; mine = 0u;
#pragma unroll
        for (unsigned j = 0; j < 16; ++j) { const unsigned c = xb_ld(&bar[XB_XCNT(j)]); sum += c; cnt += (c > 0u) ? 1u : 0u; mine = (j == x) ? c : mine; }
        if (sum == G) break;
        __builtin_amdgcn_s_sleep(1);
        if ((++sp & 255u) == 0u) { if (xb_ld(&bar[XB_TMO])) break; if (sp > XB_SPIN_CAP) { atomicAdd(&bar[XB_TMO], 1u); break; } }
    }
    nloc = mine > 0u ? mine : 1u; nx = cnt > 0u ? cnt : 1u;
}

__device__ __forceinline__ void xcd_barrier(const XcdBarrier& b) {
    asm volatile("s_waitcnt vmcnt(0)" ::: "memory");
    __syncthreads();
    if (threadIdx.x == 0) {
        unsigned* bar = b.bar;
        __builtin_amdgcn_s_waitcnt(0);
        unsigned nloc = b.st[0], nx = b.st[1];
        if (nloc == 0u) { xcd_barrier_complete(bar, b.x, nloc, nx); b.st[0] = nloc; b.st[1] = nx; }
        const unsigned old = xb_add(&bar[XB_XSUB(b.x)], 1u);
        const unsigned gen = old / nloc;
        if (old + 1u == (gen + 1u) * nloc) {
            __builtin_amdgcn_fence(__ATOMIC_RELEASE, "agent");
            asm volatile("s_waitcnt vmcnt(0)" ::: "memory");
            const unsigned og = xb_add(&bar[XB_TOP], 1u);
            const unsigned tg = og / nx;
            if (og + 1u == (tg + 1u) * nx) xb_add(&bar[XB_TOPGEN], 1u);
            else XB_SPIN(xb_ld(&bar[XB_TOPGEN]) == tg, bar);
            __builtin_amdgcn_fence(__ATOMIC_ACQUIRE, "agent");
            xb_add(&bar[XB_XGEN(b.x)], 1u);
            asm volatile("s_waitcnt vmcnt(0)" ::: "memory");
        } else {
            XB_SPIN(xb_ld(&bar[XB_XGEN(b.x)]) == gen, bar);
            __builtin_amdgcn_fence(__ATOMIC_ACQUIRE, "agent");
            asm volatile("s_waitcnt vmcnt(0)" ::: "memory");
        }
    }
    __syncthreads();
}

constexpr int NWAVES = 8;
constexpr int BATCH = 16, SEQ = 2048, D = 1024, M = BATCH * SEQ;
constexpr int NPROJ = 3584;
constexpr int C_RQ = 0, C_RK = 512, C_RV = 1024, C_RG = 1536, C_DQ = 2048, C_DK = 2560, C_DV = 3072;
constexpr int NQ = 2048, NEXP = 16384, NSEL = 128;
constexpr float ALPHA = 1.189207115002721f, LN_EPS = 1e-5f, LAMBDA_INIT = 0.2f;
constexpr float QSCALE = 0.125f * 1.4426950408889634f;
constexpr float KSCALE = 0.08838834764831845f;

constexpr size_t MiB = 1u << 20;
constexpr size_t WS_CTL = 0, CTL_ZERO_BYTES = 1 * MiB;
constexpr size_t WS_WIN = 2 * MiB, WS_WOUT = 10 * MiB, WS_WQ = 12 * MiB, WS_SK = 16 * MiB, WS_ROPE = 17 * MiB, WS_MISC = 18 * MiB;
constexpr size_t WS_XB = 32 * MiB;
constexpr size_t WS_PU = 96 * MiB, WS_PV = 128 * MiB;
constexpr size_t WS_PROJ = 160 * MiB;
constexpr size_t WS_X1 = 160 * MiB, WS_IDX = 224 * MiB, WS_GATE = 240 * MiB, WS_QP = 256 * MiB;
constexpr size_t WS_MIX = 400 * MiB;
constexpr size_t WS_END = 464 * MiB;
constexpr int CW_TMO = 0, CW_CODE = 1, CW_BAR = 4096;

constexpr int RING_OFF = 0, RING_BYTES = 131072;
constexpr int LDSCTL_OFF = RING_BYTES, MISC_OFF = LDSCTL_OFF + 320;
constexpr int LDS_BYTES = 147456;

struct Frame {
    LAS unsigned char* lds;
    volatile LAS unsigned* MISC;
    gu32* ctl;
    int tid, lane, wave;
    int vcu, G;
    const float* const* in; float* out; unsigned char* ws;
};

__device__ __forceinline__ float bf2f(unsigned short b) { return __builtin_bit_cast(float, (unsigned)b << 16); }
__device__ __forceinline__ float bflo(unsigned w) { return __builtin_bit_cast(float, w << 16); }
__device__ __forceinline__ float bfhi(unsigned w) { return __builtin_bit_cast(float, w & 0xffff0000u); }
__device__ __forceinline__ float wave_sum(float v) {
#pragma unroll
    for (int o = 1; o < 64; o <<= 1) v += __shfl_xor(v, o);
    return v;
}
__device__ __forceinline__ float wave_max(float v) {
#pragma unroll
    for (int o = 1; o < 64; o <<= 1) v = fmaxf(v, __shfl_xor(v, o));
    return v;
}
__device__ __forceinline__ float dot8(v4u a, v4u b, float s) {
    s = fmaf(bflo(a.x), bflo(b.x), s); s = fmaf(bfhi(a.x), bfhi(b.x), s);
    s = fmaf(bflo(a.y), bflo(b.y), s); s = fmaf(bfhi(a.y), bfhi(b.y), s);
    s = fmaf(bflo(a.z), bflo(b.z), s); s = fmaf(bfhi(a.z), bfhi(b.z), s);
    s = fmaf(bflo(a.w), bflo(b.w), s); s = fmaf(bfhi(a.w), bfhi(b.w), s);
    return s;
}

__device__ __forceinline__ int phys_col(int L) { if (L >= 1024) return L; const int hd = L >> 7, l = L & 127; return hd * 128 + (l < 64 ? 2 * l : 2 * (l - 64) + 1); }
template <bool PERMQK>
__device__ __forceinline__ void p0_transpose_item(const float* W, int K, int N, bf16* WT, LAS float* scr, int item, int lane) {
    const int nblk = N / 32, kb = item / nblk, nb = item % nblk, k0 = 64 * kb, n0 = 32 * nb;
#pragma unroll 8
    for (int i = 0; i < 32; ++i) { const int kk = 2 * i + (lane >> 5); scr[kk * 33 + (lane & 31)] = W[(size_t)(k0 + kk) * N + n0 + (lane & 31)]; }
    LDS_WAIT(); asm volatile("" ::: "memory");
    const int c = lane & 7;
#pragma unroll
    for (int j = 0; j < 4; ++j) { const int n = (lane >> 3) + 8 * j; const LAS float* s = scr + (8 * c) * 33 + n;
        v4u o; o.x = pk2(s[0 * 33], s[1 * 33]); o.y = pk2(s[2 * 33], s[3 * 33]); o.z = pk2(s[4 * 33], s[5 * 33]); o.w = pk2(s[6 * 33], s[7 * 33]);
        const int orow = PERMQK ? phys_col(n0 + n) : (n0 + n);
        *(GAS v4u*)(WT + (size_t)orow * K + k0 + 8 * c) = o; }
    LDS_WAIT(); asm volatile("" ::: "memory");
}
__device__ __forceinline__ void cvt_bf16_stream(const float* src, bf16* dst, size_t n4, int gt, int ngt) {
    for (size_t i = gt; i < n4; i += ngt) { const f32x4 v = ((const GAS f32x4*)src)[i]; typedef unsigned u2 __attribute__((ext_vector_type(2))); u2 o; o.x = pk2(v.x, v.y); o.y = pk2(v.z, v.w); ((GAS u2*)dst)[i] = o; }
}
__device__ __forceinline__ void p0_prologue(Frame& F) {
    LAS float* scr = (LAS float*)(F.lds + RING_OFF + F.wave * 16384);
    const int gw = F.vcu * NWAVES + F.wave, NGW = F.G * NWAVES;
    const int gt = (int)blockIdx.x * (NWAVES * 64) + F.tid, ngt = F.G * NWAVES * 64;
    constexpr int I_IN = (D / 64) * (NPROJ / 32), I_OUT = (D / 64) * (D / 32), I_Q = (D / 64) * (NQ / 32);
    constexpr int NITEMS = I_IN + I_OUT + I_Q;
    for (int it = gw; it < NITEMS; it += NGW) {
        int r = it;
        if (r < I_IN) { p0_transpose_item<true>(F.in[1], D, NPROJ, (bf16*)(F.ws + WS_WIN), scr, r, F.lane); continue; } r -= I_IN;
        if (r < I_OUT) { p0_transpose_item<false>(F.in[9], D, D, (bf16*)(F.ws + WS_WOUT), scr, r, F.lane); continue; } r -= I_OUT;
        p0_transpose_item<false>(F.in[12], D, NQ, (bf16*)(F.ws + WS_WQ), scr, r, F.lane);
    }
    cvt_bf16_stream(F.in[13], (bf16*)(F.ws + WS_SK), (size_t)8 * 2 * 128 * 128 / 4, gt, ngt);
    cvt_bf16_stream(F.in[14], (bf16*)(F.ws + WS_PU), (size_t)NEXP * D / 4, gt, ngt);
    cvt_bf16_stream(F.in[15], (bf16*)(F.ws + WS_PV), (size_t)NEXP * D / 4, gt, ngt);
    cvt_bf16_stream(F.in[0], (bf16*)(F.ws + WS_XB), (size_t)M * D / 4, gt, ngt);
    float* rope = (float*)(F.ws + WS_ROPE);
    for (int e = gt; e < SEQ * 64; e += ngt) {
        const int pos = e >> 6, i = e & 63;
        const float inv = exp2f(-(float)i * (13.287712379549449f / 64.f));
        const float ang = (float)pos * inv;
        const float k = rintf(ang * 0.15915494309189535f);
        float r = fmaf(-k, 6.2831854820251465f, ang); r = fmaf(-k, -1.7484555314695172e-07f, r);
        rope[2 * e] = cosf(r); rope[2 * e + 1] = sinf(r);
    }
}

__device__ __forceinline__ void p2_retention_naive(Frame& F) {
    const bf16* PROJ = (const bf16*)(F.ws + WS_PROJ); bf16* MIX = (bf16*)(F.ws + WS_MIX);
    LAS float* S = (LAS float*)(F.lds + RING_OFF); LAS float* ST = S + 128 * 128;
    const float* gn_g = F.in[2]; const float* gn_b = F.in[3];
    const int t = F.tid;
    for (int u = (int)blockIdx.x; u < BATCH * 4; u += F.G) {
        const int b = u >> 2, h = u & 3;
        const float gam = 1.f - exp2f(-5.f - (float)h); const float l2g = log2f(gam);
        for (int e = t; e < 128 * 128; e += NWAVES * 64) ST[e] = 0.f;
        __syncthreads();
        for (int c = 0; c < 16; ++c) {
            const size_t rb = (size_t)b * SEQ + c * 128;
            {
                const int i = t >> 2, jq = t & 3;
                const GAS v4u* qp = (const GAS v4u*)(PROJ + (rb + i) * NPROJ + C_RQ + h * 128);
#pragma unroll 1
                for (int jj = 0; jj < 32; ++jj) { const int j = jq * 32 + jj; float s = 0.f;
                    if (j <= i) { const GAS v4u* kp = (const GAS v4u*)(PROJ + (rb + j) * NPROJ + C_RK + h * 128);
#pragma unroll
                        for (int d = 0; d < 16; ++d) s = dot8(qp[d], kp[d], s);
                        s *= exp2f((float)(i - j) * l2g); }
                    S[i * 128 + j] = s; }
            }
            __syncthreads();
            {
                const int i = t >> 2, vq = t & 3;
                float o[32];
#pragma unroll
                for (int v = 0; v < 32; ++v) o[v] = 0.f;
#pragma unroll 2
                for (int j = 0; j <= i; ++j) { const float sij = S[i * 128 + j];
                    const GAS v4u* vp = (const GAS v4u*)(PROJ + (rb + j) * NPROJ + C_RV + h * 128 + vq * 32);
#pragma unroll
                    for (int q4 = 0; q4 < 4; ++q4) { const v4u w = vp[q4];
                        o[q4 * 8 + 0] = fmaf(sij, bflo(w.x), o[q4 * 8 + 0]); o[q4 * 8 + 1] = fmaf(sij, bfhi(w.x), o[q4 * 8 + 1]);
                        o[q4 * 8 + 2] = fmaf(sij, bflo(w.y), o[q4 * 8 + 2]); o[q4 * 8 + 3] = fmaf(sij, bfhi(w.y), o[q4 * 8 + 3]);
                        o[q4 * 8 + 4] = fmaf(sij, bflo(w.z), o[q4 * 8 + 4]); o[q4 * 8 + 5] = fmaf(sij, bfhi(w.z), o[q4 * 8 + 5]);
                        o[q4 * 8 + 6] = fmaf(sij, bflo(w.w), o[q4 * 8 + 6]); o[q4 * 8 + 7] = fmaf(sij, bfhi(w.w), o[q4 * 8 + 7]); } }
                const float dq = exp2f((float)(i + 1) * l2g);
                const GAS unsigned short* qrow = (const GAS unsigned short*)(PROJ + (rb + i) * NPROJ + C_RQ + h * 128);
#pragma unroll 2
                for (int d = 0; d < 128; ++d) { const float qd = bf2f(qrow[d]) * dq; const LAS float* sp = ST + d * 128 + vq * 32;
#pragma unroll
                    for (int v = 0; v < 32; ++v) o[v] = fmaf(qd, sp[v], o[v]); }
                float sm = 0.f;
#pragma unroll
                for (int v = 0; v < 32; ++v) sm += o[v];
                sm += __shfl_xor(sm, 1); sm += __shfl_xor(sm, 2);
                const float mu = sm * (1.f / 128.f); float q2 = 0.f;
#pragma unroll
                for (int v = 0; v < 32; ++v) { const float dlt = o[v] - mu; q2 += dlt * dlt; }
                q2 += __shfl_xor(q2, 1); q2 += __shfl_xor(q2, 2);
                const float rstd = 1.f / sqrtf(q2 * (1.f / 128.f) + LN_EPS);
                const GAS unsigned short* grow = (const GAS unsigned short*)(PROJ + (rb + i) * NPROJ + C_RG + h * 128 + vq * 32);
                GAS unsigned short* mrow = (GAS unsigned short*)(MIX + (rb + i) * D + h * 128 + vq * 32);
#pragma unroll
                for (int v = 0; v < 32; ++v) { const int ch = h * 128 + vq * 32 + v; const float r = bf2f(grow[v]) * ((o[v] - mu) * rstd * gn_g[ch] + gn_b[ch]); mrow[v] = (unsigned short)f2bf(r); }
            }
            __syncthreads();
            {
                const int d = t >> 2, vq = t & 3;
                float a[32];
                const float dc = exp2f(128.f * l2g);
                LAS float* sp = ST + d * 128 + vq * 32;
#pragma unroll
                for (int v = 0; v < 32; ++v) a[v] = sp[v] * dc;
#pragma unroll 2
                for (int j = 0; j < 128; ++j) { const float kd = bf2f(((const GAS unsigned short*)PROJ)[(rb + j) * NPROJ + C_RK + h * 128 + d]) * exp2f((float)(127 - j) * l2g);
                    const GAS v4u* vp = (const GAS v4u*)(PROJ + (rb + j) * NPROJ + C_RV + h * 128 + vq * 32);
#pragma unroll
                    for (int q4 = 0; q4 < 4; ++q4) { const v4u w = vp[q4];
                        a[q4 * 8 + 0] = fmaf(kd, bflo(w.x), a[q4 * 8 + 0]); a[q4 * 8 + 1] = fmaf(kd, bfhi(w.x), a[q4 * 8 + 1]);
                        a[q4 * 8 + 2] = fmaf(kd, bflo(w.y), a[q4 * 8 + 2]); a[q4 * 8 + 3] = fmaf(kd, bfhi(w.y), a[q4 * 8 + 3]);
                        a[q4 * 8 + 4] = fmaf(kd, bflo(w.z), a[q4 * 8 + 4]); a[q4 * 8 + 5] = fmaf(kd, bfhi(w.z), a[q4 * 8 + 5]);
                        a[q4 * 8 + 6] = fmaf(kd, bflo(w.w), a[q4 * 8 + 6]); a[q4 * 8 + 7] = fmaf(kd, bfhi(w.w), a[q4 * 8 + 7]); } }
#pragma unroll
                for (int v = 0; v < 32; ++v) sp[v] = a[v];
            }
            __syncthreads();
        }
    }
}

__device__ __forceinline__ float diff_lambda(Frame& F) {
    const float a = wave_sum(F.in[4][F.lane] * F.in[5][F.lane]); const float b = wave_sum(F.in[6][F.lane] * F.in[7][F.lane]);
    return expf(a) - expf(b) + LAMBDA_INIT;
}
__device__ __forceinline__ void p2_diffattn_naive(Frame& F) {
    const bf16* PROJ = (const bf16*)(F.ws + WS_PROJ); bf16* MIX = (bf16*)(F.ws + WS_MIX);
    LAS float* sb = (LAS float*)(F.lds + RING_OFF) + F.wave * 2048;
    const float lam = diff_lambda(F);
    const float* sg = F.in[8];
    const int gw = (int)blockIdx.x * NWAVES + F.wave, NGW = F.G * NWAVES;
    const int lane = F.lane;
    for (int task = gw; task < BATCH * 4 * SEQ; task += NGW) {
        const int i = task >> 6, bh = task & 63, b = bh >> 2, h = bh & 3;
        const size_t rb = (size_t)b * SEQ;
        float oc[2][2];
#pragma unroll
        for (int c = 0; c < 2; ++c) {
            const GAS v4u* qp = (const GAS v4u*)(PROJ + (rb + i) * NPROJ + C_DQ + h * 128 + c * 64);
            v4u q[8];
#pragma unroll
            for (int d = 0; d < 8; ++d) q[d] = qp[d];
            float mx = -INFINITY;
#pragma unroll 1
            for (int j0 = 0; j0 <= i; j0 += 64) { const int j = j0 + lane;
                if (j <= i) { const GAS v4u* kp = (const GAS v4u*)(PROJ + (rb + j) * NPROJ + C_DK + h * 128 + c * 64); float s = 0.f;
#pragma unroll
                    for (int d = 0; d < 8; ++d) s = dot8(q[d], kp[d], s);
                    sb[j] = s; mx = fmaxf(mx, s); } }
            mx = wave_max(mx);
            float l = 0.f;
            for (int j0 = 0; j0 <= i; j0 += 64) { const int j = j0 + lane; if (j <= i) { const float p = exp2f(sb[j] - mx); sb[j] = p; l += p; } }
            l = wave_sum(l);
            LDS_WAIT(); asm volatile("" ::: "memory");
            float o0 = 0.f, o1 = 0.f;
            const GAS unsigned* vp = (const GAS unsigned*)(PROJ + rb * NPROJ + C_DV + h * 128) + lane;
#pragma unroll 4
            for (int j = 0; j <= i; ++j) { const float p = sb[j]; const unsigned w = vp[(size_t)j * (NPROJ / 2)]; o0 = fmaf(p, bflo(w), o0); o1 = fmaf(p, bfhi(w), o1); }
            const float rl = 1.f / l; oc[c][0] = o0 * rl; oc[c][1] = o1 * rl;
            LDS_WAIT(); asm volatile("" ::: "memory");
        }
        const float d0 = oc[0][0] - lam * oc[1][0], d1 = oc[0][1] - lam * oc[1][1];
        const float ms = wave_sum(d0 * d0 + d1 * d1) * (1.f / 128.f);
        const float rs = (1.f - LAMBDA_INIT) / sqrtf(ms + LN_EPS);
        const int ch = h * 128 + 2 * lane;
        ((GAS unsigned*)(MIX + (rb + i) * D + 512 + h * 128))[lane] = pk2(d0 * rs * sg[ch], d1 * rs * sg[ch + 1]);
    }
}

__device__ __forceinline__ void p3_ln1_rows(Frame& F) {
    const float* Y = F.out; bf16* X1 = (bf16*)(F.ws + WS_X1); const float* g = F.in[10]; const float* bb = F.in[11];
    const int gw = (int)blockIdx.x * NWAVES + F.wave, NGW = F.G * NWAVES;
    for (int m = gw; m < M; m += NGW) {
        const GAS f32x4* xr = (const GAS f32x4*)(Y + (size_t)m * D) + F.lane;
        f32x4 v[4]; float s = 0.f;
#pragma unroll
        for (int j = 0; j < 4; ++j) { v[j] = xr[64 * j]; s += (v[j].x + v[j].y) + (v[j].z + v[j].w); }
        const float mean = wave_sum(s) * (1.f / D); float s2 = 0.f;
#pragma unroll
        for (int j = 0; j < 4; ++j) { v[j] = v[j] - mean; s2 += (v[j].x * v[j].x + v[j].y * v[j].y) + (v[j].z * v[j].z + v[j].w * v[j].w); }
        const float rstd = 1.f / sqrtf(wave_sum(s2) * (1.f / D) + LN_EPS);
        GAS unsigned long long* o8 = (GAS unsigned long long*)(X1 + (size_t)m * D) + F.lane;
#pragma unroll
        for (int j = 0; j < 4; ++j) { const f32x4 gg = ((const GAS f32x4*)g)[F.lane + 64 * j], bv = ((const GAS f32x4*)bb)[F.lane + 64 * j]; const f32x4 r = v[j] * rstd * gg + bv;
            o8[64 * j] = (unsigned long long)pk2(r.x, r.y) | ((unsigned long long)pk2(r.z, r.w) << 32); }
    }
}

__device__ __forceinline__ void argmax_step(float& v, int& i) {
#pragma unroll
    for (int o = 1; o < 64; o <<= 1) { const float ov = __shfl_xor(v, o); const int oi = __shfl_xor(i, o); if (ov > v || (ov == v && oi < i)) { v = ov; i = oi; } }
}
__device__ __forceinline__ void p5_topk_naive(Frame& F) {
    const bf16* QP = (const bf16*)(F.ws + WS_QP); const bf16* SK = (const bf16*)(F.ws + WS_SK);
    int* IDX = (int*)(F.ws + WS_IDX); float* GATE = (float*)(F.ws + WS_GATE);
    const int gw = (int)blockIdx.x * NWAVES + F.wave, NGW = F.G * NWAVES; const int lane = F.lane;
    for (int task = gw; task < M * 8; task += NGW) {
        const int t = task >> 3, h = task & 7;
        float ts[2]; int ti[2];
#pragma unroll
        for (int c = 0; c < 2; ++c) {
            const GAS v4u* qp = (const GAS v4u*)(QP + (size_t)t * NQ + h * 256 + c * 128);
            const GAS v4u* k0p = (const GAS v4u*)(SK + ((size_t)(h * 2 + c) * 128 + lane) * 128);
            const GAS v4u* k1p = (const GAS v4u*)(SK + ((size_t)(h * 2 + c) * 128 + lane + 64) * 128);
            float s0 = 0.f, s1 = 0.f;
#pragma unroll
            for (int d = 0; d < 16; ++d) { const v4u q = qp[d]; s0 = dot8(q, k0p[d], s0); s1 = dot8(q, k1p[d], s1); }
            float mys = 0.f; int myi = 0;
            for (int r = 0; r < 16; ++r) {
                float v = fmaxf(s0, s1); int ix = (s0 >= s1) ? lane : lane + 64;
                argmax_step(v, ix);
                if (lane == r) { mys = v; myi = ix; }
                if ((ix & 63) == lane) { if (ix < 64) s0 = -INFINITY; else s1 = -INFINITY; }
            }
            ts[c] = mys; ti[c] = myi;
        }
        float cs[4]; int ci[4];
#pragma unroll
        for (int q = 0; q < 4; ++q) { const int a = (lane >> 4) + 4 * q, bq = lane & 15; cs[q] = __shfl(ts[0], a) + __shfl(ts[1], bq); ci[q] = __shfl(ti[0], a) * 128 + __shfl(ti[1], bq); }
        float bs = 0.f; int be = 0;
        for (int r = 0; r < 16; ++r) {
            float v = cs[0]; int n = lane;
#pragma unroll
            for (int q = 1; q < 4; ++q) if (cs[q] > v) { v = cs[q]; n = lane + 64 * q; }
            argmax_step(v, n);
            const int owner = n & 63, q = n >> 6;
            const int mine = (q == 0) ? ci[0] : (q == 1) ? ci[1] : (q == 2) ? ci[2] : ci[3];
            const int e = __shfl(mine, owner);
            if (lane == r) { bs = v; be = e; }
            if (lane == owner) { if (q == 0) cs[0] = -INFINITY; else if (q == 1) cs[1] = -INFINITY; else if (q == 2) cs[2] = -INFINITY; else cs[3] = -INFINITY; }
        }
        const float mx = __shfl(bs, 0);
        float ex = expf(bs - mx); float sm = ex;
        sm += __shfl_xor(sm, 1); sm += __shfl_xor(sm, 2); sm += __shfl_xor(sm, 4); sm += __shfl_xor(sm, 8);
        if (lane < 16) { IDX[(size_t)t * NSEL + h * 16 + lane] = be; GATE[(size_t)t * NSEL + h * 16 + lane] = ex / sm; }
    }
}

__device__ __forceinline__ void unpack8(v4u w, float* f) { f[0] = bflo(w.x); f[1] = bfhi(w.x); f[2] = bflo(w.y); f[3] = bfhi(w.y); f[4] = bflo(w.z); f[5] = bfhi(w.z); f[6] = bflo(w.w); f[7] = bfhi(w.w); }
__device__ __forceinline__ void p6_experts_naive(Frame& F) {
    const bf16* X1 = (const bf16*)(F.ws + WS_X1); const bf16* PU = (const bf16*)(F.ws + WS_PU); const bf16* PV = (const bf16*)(F.ws + WS_PV);
    const int* IDX = (const int*)(F.ws + WS_IDX); const float* GATE = (const float*)(F.ws + WS_GATE);
    const float* g2 = F.in[16]; const float* b2 = F.in[17];
    const int gw = (int)blockIdx.x * NWAVES + F.wave, NGW = F.G * NWAVES; const int lane = F.lane;
    for (int t = gw; t < M; t += NGW) {
        float x[16], acc[16];
        { const GAS v4u* xp = (const GAS v4u*)(X1 + (size_t)t * D); unpack8(xp[lane], x); unpack8(xp[64 + lane], x + 8); }
#pragma unroll
        for (int k = 0; k < 16; ++k) acc[k] = 0.f;
#pragma unroll 2
        for (int e = 0; e < NSEL; ++e) {
            const int idx = IDX[(size_t)t * NSEL + e]; const float gt = GATE[(size_t)t * NSEL + e];
            const GAS v4u* up = (const GAS v4u*)(PU + (size_t)idx * D); const GAS v4u* vp = (const GAS v4u*)(PV + (size_t)idx * D);
            const v4u u0 = up[lane], u1 = up[64 + lane], v0 = vp[lane], v1 = vp[64 + lane];
            float uf[16]; unpack8(u0, uf); unpack8(u1, uf + 8);
            float s = 0.f;
#pragma unroll
            for (int k = 0; k < 16; ++k) s = fmaf(x[k], uf[k], s);
            s = wave_sum(s);
            const float w = gt * 0.5f * s * (1.f + erff(s * 0.7071067811865476f));
            float vf[16]; unpack8(v0, vf); unpack8(v1, vf + 8);
#pragma unroll
            for (int k = 0; k < 16; ++k) acc[k] = fmaf(w, vf[k], acc[k]);
        }
        float sm = 0.f;
#pragma unroll
        for (int k = 0; k < 16; ++k) { acc[k] = fmaf(ALPHA, x[k], acc[k]); sm += acc[k]; }
        const float mean = wave_sum(sm) * (1.f / D); float q2 = 0.f;
#pragma unroll
        for (int k = 0; k < 16; ++k) { acc[k] -= mean; q2 += acc[k] * acc[k]; }
        const float rstd = 1.f / sqrtf(wave_sum(q2) * (1.f / D) + LN_EPS);
        GAS f32x4* op = (GAS f32x4*)(F.out + (size_t)t * D);
#pragma unroll
        for (int hf = 0; hf < 2; ++hf)
#pragma unroll
            for (int q4 = 0; q4 < 2; ++q4) { const int c0 = hf * 512 + lane * 8 + q4 * 4; const f32x4 gg = *(const GAS f32x4*)(g2 + c0), bv = *(const GAS f32x4*)(b2 + c0);
                f32x4 r; r.x = acc[hf * 8 + q4 * 4 + 0] * rstd * gg.x + bv.x; r.y = acc[hf * 8 + q4 * 4 + 1] * rstd * gg.y + bv.y; r.z = acc[hf * 8 + q4 * 4 + 2] * rstd * gg.z + bv.z; r.w = acc[hf * 8 + q4 * 4 + 3] * rstd * gg.w + bv.w;
                op[c0 / 4] = r; }
    }
}

#ifndef MK_N_LAUNCHES
#define MK_N_LAUNCHES 1
#endif
constexpr int N_PHASES = 8;
struct Args { const float* in[18]; float* out; unsigned char* ws; int ph_lo, ph_hi, li, pad; };
__global__ void __launch_bounds__(NWAVES * 64, 2) hymba_fwd(Args args) {
    extern __shared__ __attribute__((aligned(16))) unsigned char lds[];
    Frame F;
    F.lds = (LAS unsigned char*)lds;
    F.MISC = (volatile LAS unsigned*)(F.lds + MISC_OFF);
    F.tid = threadIdx.x; F.lane = F.tid & 63; F.wave = __builtin_amdgcn_readfirstlane(F.tid >> 6);
    F.G = gridDim.x; { const int bx = blockIdx.x; F.vcu = (F.G % 8 == 0) ? (bx % 8) * (F.G / 8) + bx / 8 : bx; }
    unsigned char* ws = args.ws; F.ws = ws; F.out = args.out;
    F.ctl = (gu32*)(ws + WS_CTL);
    F.in = args.in;
    for (int u = F.tid; u < (LDS_BYTES - LDSCTL_OFF) / 4; u += NWAVES * 64) ((LAS unsigned*)(F.lds + LDSCTL_OFF))[u] = 0u;
    __syncthreads();
    XcdBarrier bar; bar.bar = (unsigned*)(F.ctl + CW_BAR) + args.li * XCD_BAR_WORDS; bar.x = 0; bar.st = nullptr;
    if (MK_N_LAUNCHES != N_PHASES) bar = xcd_barrier_post((unsigned*)(F.ctl + CW_BAR) + args.li * XCD_BAR_WORDS, F.MISC + 8);
    const int lo = args.ph_lo, hi = args.ph_hi;
#ifndef PHASE_MASK
#define PHASE_MASK 0xffff
#endif
#define IN(k) (((PHASE_MASK >> (k)) & 1) && lo <= (k) && (k) < hi)
#define BOTH(k) (IN(k) && IN((k) + 1))
#define GRID_BAR() xcd_barrier(bar)

    if (IN(0)) { p0_prologue(F); if (BOTH(0)) GRID_BAR(); }
    if (IN(1)) {
        pg8::Gemm g{(const bf16*)(ws + WS_XB), (const bf16*)(ws + WS_WIN), M, NPROJ, D}; pg8::StaticOrder S; S.init(M, NPROJ, F.G, (int)blockIdx.x);
        pg8::EpiProj E{(bf16*)(ws + WS_PROJ), NPROJ, (const float*)(ws + WS_ROPE), KSCALE, QSCALE};
        pg8::gemm_phase<pg8::EpiProj, pg8::StaticOrder, PG8_ALIGN, PG8_SP2>(F.lds + RING_OFF, g, S, E);
        if (BOTH(1)) GRID_BAR();
    }
    if (IN(2)) { p2_retention_naive(F); __syncthreads(); p2_diffattn_naive(F); if (BOTH(2)) GRID_BAR(); }
    if (IN(3)) {
        pg8::Gemm g{(const bf16*)(ws + WS_MIX), (const bf16*)(ws + WS_WOUT), M, D, D}; pg8::StaticOrder S; S.init(M, D, F.G, (int)blockIdx.x);
        pg8::EpiResF32 E{F.in[0], F.out, D, ALPHA};
        pg8::gemm_phase<pg8::EpiResF32, pg8::StaticOrder, PG8_ALIGN, PG8_SP2>(F.lds + RING_OFF, g, S, E);
        if (BOTH(3)) GRID_BAR();
    }
    if (IN(4)) { p3_ln1_rows(F); if (BOTH(4)) GRID_BAR(); }
    if (IN(5)) {
        pg8::Gemm g{(const bf16*)(ws + WS_X1), (const bf16*)(ws + WS_WQ), M, NQ, D}; pg8::StaticOrder S; S.init(M, NQ, F.G, (int)blockIdx.x);
        pg8::EpiPlainBf16 E{(bf16*)(ws + WS_QP), NQ};
        pg8::gemm_phase<pg8::EpiPlainBf16, pg8::StaticOrder, PG8_ALIGN, PG8_SP2>(F.lds + RING_OFF, g, S, E);
        if (BOTH(5)) GRID_BAR();
    }
    if (IN(6)) { p5_topk_naive(F); if (BOTH(6)) GRID_BAR(); }
    if (IN(7)) { p6_experts_naive(F); }
#undef IN
#undef BOTH
}

extern "C" void kernel_launch(void* const* d_in, const int* in_sizes, int n_in, void* d_out, int out_size, void* d_ws, size_t ws_size, hipStream_t stream) {
    static int grid = 0;
    if (grid == 0) {
        if (n_in != 18 || in_sizes[0] != M * D || out_size != M * D || ws_size < WS_END) { fprintf(stderr, "kernel_launch: unexpected shapes / workspace (n_in %d, in0 %d, out %d, ws %zu, need %zu); nothing launched\n", n_in, n_in > 0 ? in_sizes[0] : -1, out_size, ws_size, (size_t)WS_END); grid = -1; return; }
        int dev = 0, cus = 0, per_cu = 0;
        if (hipGetDevice(&dev) != hipSuccess || hipDeviceGetAttribute(&cus, hipDeviceAttributeMultiprocessorCount, dev) != hipSuccess) { fprintf(stderr, "kernel_launch: device query failed\n"); grid = -1; return; }
        if (hipFuncSetAttribute((const void*)hymba_fwd, hipFuncAttributeMaxDynamicSharedMemorySize, LDS_BYTES) != hipSuccess) { fprintf(stderr, "kernel_launch: hipFuncSetAttribute failed\n"); grid = -1; return; }
        if (hipOccupancyMaxActiveBlocksPerMultiprocessor(&per_cu, (const void*)hymba_fwd, NWAVES * 64, LDS_BYTES) != hipSuccess || per_cu < 1)
            fprintf(stderr, "kernel_launch: note: occupancy query reports %d workgroups per CU\n", per_cu);
        (void)hipGetLastError();
        grid = cus;
        if (grid != 256) fprintf(stderr, "kernel_launch: note: %d CUs (tuned for 256)\n", grid);
    }
    if (grid < 0) return;
    if (hipMemsetAsync((char*)d_ws + WS_CTL, 0, CTL_ZERO_BYTES, stream) != hipSuccess) { fprintf(stderr, "kernel_launch: memset failed\n"); return; }
    Args a{};
    for (int i = 0; i < 18; ++i) a.in[i] = (const float*)d_in[i];
    a.out = (float*)d_out; a.ws = (unsigned char*)d_ws;
    constexpr int NL = MK_N_LAUNCHES;
    for (int li = 0; li < NL; ++li) {
        a.ph_lo = (NL == N_PHASES) ? li : (li * N_PHASES) / NL; a.ph_hi = (NL == N_PHASES) ? li + 1 : ((li + 1) * N_PHASES) / NL; a.li = li;
        hipLaunchKernelGGL(hymba_fwd, dim3(grid), dim3(NWAVES * 64), LDS_BYTES, stream, a);
        const hipError_t le = hipPeekAtLastError();
        if (le != hipSuccess) { fprintf(stderr, "kernel_launch: launch %d failed: %s\n", li, hipGetErrorName(le)); break; }
    }
}
```

```cpp
#include <hip/hip_runtime.h>
#include <cstdio>
#include <cstdint>
#include <cmath>
namespace pg8 {
#define PG8_LAS __attribute__((address_space(3)))
typedef unsigned short bf16_t;
typedef short bf16x8 __attribute__((ext_vector_type(8)));
typedef float f32x4 __attribute__((ext_vector_type(4)));
typedef unsigned u32x4 __attribute__((ext_vector_type(4)));
constexpr int BM = 256, BK = 64, HALF = 128, HTB = HALF * BK * 2  , STAGE_BYTES = 8 * HTB, NXCD = 8, WGM = 8;

__host__ __device__ __forceinline__ int lds_byte(int r, int c) { const int st = (r >> 4) * 2 + (c >> 5), rr = r & 15, cc = c & 31, ob = rr * 64 + cc * 2; return st * 1024 + (ob ^ (((ob >> 9) & 1) << 5)); }
__host__ __device__ __forceinline__ void stage_rc(int b, int& R, int& C) { const int st = b / 1024, sb = b % 1024, swz = sb ^ (((sb >> 9) & 1) << 5); R = (st >> 1) * 16 + swz / 64; C = (st & 1) * 32 + (swz % 64) / 2; }
__host__ __device__ __forceinline__ int perm32(int rho) { const int n = rho >> 4, i = rho & 15; return 8 * (i >> 2) + 4 * n + (i & 3); }

struct Unit { int pm, pn; };
struct Gemm { const bf16_t* A; const bf16_t* Bt; int M, N, K; };

struct StaticOrder {
    int nM, nN, nwg, G, c;
    __host__ __device__ void init(int M, int N, int G_, int c_) { nM = M / BM; nN = N / BM; nwg = nM * nN; G = G_; c = c_; }
    __host__ __device__ bool next(int i, Unit& u) const {
        const long L = (long)i * G + c; if (L >= nwg) return false;
        int wgid = (int)L; { const int q = nwg / NXCD, r = nwg % NXCD, xcd = wgid % NXCD, off = wgid / NXCD; wgid = (xcd < r ? xcd * (q + 1) : r * (q + 1) + (xcd - r) * q) + off; }
        const int nig = WGM * nN, gid = wgid / nig, fm = gid * WGM, gsz = (nM - fm) < WGM ? (nM - fm) : WGM;
        u.pm = fm + ((wgid % nig) % gsz); u.pn = (wgid % nig) / gsz; return true;
    }
    __device__ __forceinline__ void a_ready(const Unit&) const {}
    __device__ __forceinline__ void done(const Unit&) const {}
};

__device__ __forceinline__ unsigned cvt_pk_bf16(float lo, float hi) { unsigned r; asm volatile("v_cvt_pk_bf16_f32 %0, %1, %2" : "=v"(r) : "v"(lo), "v"(hi)); return r; }
typedef float f32x2 __attribute__((ext_vector_type(2)));
__device__ __forceinline__ f32x2 gelu_pk(f32x2 v) {
    const f32x2 av = __builtin_elementwise_abs(v), d = av * 0.2316418882f + 1.0f;
    f32x2 t; t.x = __builtin_amdgcn_rcpf(d.x); t.y = __builtin_amdgcn_rcpf(d.y);
    f32x2 q = t * 0.5307027145f + (-0.7265760135f); q = q * t + 0.7107068705f; q = q * t + (-0.142248368f); q = q * t + 0.127414796f; q = q * t;
    const f32x2 s = (v * v) * (-0.72134752044f);
    f32x2 e; e.x = __builtin_amdgcn_exp2f(s.x); e.y = __builtin_amdgcn_exp2f(s.y);
    const f32x2 m = v * (q * e), r = v - m;
    f32x2 o; o.x = v.x < 0.f ? m.x : r.x; o.y = v.y < 0.f ? m.y : r.y; return o;
}

struct EpiProj {
    static constexpr bool PERM = true, AFTER_DRAIN = false;
    bf16_t* O; int ldc; const float* rope; float kscale, qscale;
    __device__ __forceinline__ void operator()(const f32x4 (&acc)[2][2][4][2], const Unit& u, int wr, int wc, int fr, int fq) const {
        const int row0 = u.pm * BM + wr * 64 + fr; const int col0 = u.pn * BM + wc * 32 + 8 * fq;
        const int pn = u.pn;
        const bool rot = pn < 4; const bool gate = (pn == 6 || pn == 7);
        const float sc = (pn == 2 || pn == 3) ? kscale : ((pn == 8 || pn == 9) ? qscale : 1.f);
#pragma unroll
        for (int ai = 0; ai < 2; ++ai)
#pragma unroll
            for (int m = 0; m < 4; ++m) {
                const int row = row0 + ai * HALF + m * 16;
                bf16_t* rowp = O + (size_t)row * ldc + col0;
                f32x4 cs0 = (f32x4){1.f, 0.f, 1.f, 0.f}, cs1 = cs0;
                if (rot) { const float* rp = rope + ((size_t)(row & 2047) * 64 + 16 * wc + 4 * fq) * 2; cs0 = *(const f32x4*)rp; cs1 = *(const f32x4*)(rp + 4); }
#pragma unroll
                for (int bj = 0; bj < 2; ++bj) {
                    f32x4 v0 = acc[ai][bj][m][0], v1 = acc[ai][bj][m][1];
                    if (rot) {
                        f32x4 r0, r1;
                        r0[0] = v0[0] * cs0[0] - v0[1] * cs0[1]; r0[1] = v0[0] * cs0[1] + v0[1] * cs0[0];
                        r0[2] = v0[2] * cs0[2] - v0[3] * cs0[3]; r0[3] = v0[2] * cs0[3] + v0[3] * cs0[2];
                        r1[0] = v1[0] * cs1[0] - v1[1] * cs1[1]; r1[1] = v1[0] * cs1[1] + v1[1] * cs1[0];
                        r1[2] = v1[2] * cs1[2] - v1[3] * cs1[3]; r1[3] = v1[2] * cs1[3] + v1[3] * cs1[2];
                        v0 = r0; v1 = r1;
                    }
                    if (gate) {
#pragma unroll
                        for (int j = 0; j < 4; ++j) { v0[j] = v0[j] * __builtin_amdgcn_rcpf(1.f + __builtin_amdgcn_exp2f(-1.4426950408889634f * v0[j])); v1[j] = v1[j] * __builtin_amdgcn_rcpf(1.f + __builtin_amdgcn_exp2f(-1.4426950408889634f * v1[j])); }
                    }
                    v0 = v0 * sc; v1 = v1 * sc;
                    u32x4 w; w.x = cvt_pk_bf16(v0[0], v0[1]); w.y = cvt_pk_bf16(v0[2], v0[3]); w.z = cvt_pk_bf16(v1[0], v1[1]); w.w = cvt_pk_bf16(v1[2], v1[3]);
                    *(u32x4*)(rowp + bj * HALF) = w;
                }
            }
    }
};
struct EpiPlainBf16 {
    static constexpr bool PERM = true, AFTER_DRAIN = false;
    bf16_t* O; int ldc;
    __device__ __forceinline__ void operator()(const f32x4 (&acc)[2][2][4][2], const Unit& u, int wr, int wc, int fr, int fq) const {
        const int row0 = u.pm * BM + wr * 64 + fr; const int col0 = u.pn * BM + wc * 32 + 8 * fq;
#pragma unroll
        for (int ai = 0; ai < 2; ++ai)
#pragma unroll
            for (int m = 0; m < 4; ++m) { bf16_t* rowp = O + (size_t)(row0 + ai * HALF + m * 16) * ldc + col0;
#pragma unroll
                for (int bj = 0; bj < 2; ++bj) { const f32x4 v0 = acc[ai][bj][m][0], v1 = acc[ai][bj][m][1];
                    u32x4 w; w.x = cvt_pk_bf16(v0[0], v0[1]); w.y = cvt_pk_bf16(v0[2], v0[3]); w.z = cvt_pk_bf16(v1[0], v1[1]); w.w = cvt_pk_bf16(v1[2], v1[3]);
                    *(u32x4*)(rowp + bj * HALF) = w; } }
    }
};
struct EpiResF32 {
    static constexpr bool PERM = false, AFTER_DRAIN = false;
    const float* base; float* out; int ldc; float alpha;
    __device__ __forceinline__ void operator()(const f32x4 (&acc)[2][2][4][2], const Unit& u, int wr, int wc, int fr, int fq) const {
        const int row0 = u.pm * BM + wr * 64 + fr; const int col0 = u.pn * BM + wc * 32 + 4 * fq;
#pragma unroll
        for (int ai = 0; ai < 2; ++ai)
#pragma unroll
            for (int m = 0; m < 4; ++m) { const size_t off = (size_t)(row0 + ai * HALF + m * 16) * ldc + col0;
#pragma unroll
                for (int bj = 0; bj < 2; ++bj)
#pragma unroll
                    for (int n = 0; n < 2; ++n) { const f32x4 bs = *(const f32x4*)(base + off + bj * HALF + n * 16); *(f32x4*)(out + off + bj * HALF + n * 16) = bs * alpha + acc[ai][bj][m][n]; } }
    }
};

template <class Epi, class Sched, bool ALIGN_EPI = false, bool SP2 = false>
__device__ __forceinline__ void gemm_phase(PG8_LAS unsigned char* lds, const Gemm g, const Sched& S, const Epi& E) {
    const int tid = threadIdx.x, wid = __builtin_amdgcn_readfirstlane(tid >> 6), lane = tid & 63, wr = wid >> 2, wc = wid & 3, fr = lane & 15, fq = lane >> 4;
    const int K = g.K, nt = K / BK;
    unsigned voffA[2], voffB[2];
#pragma unroll
    for (int i = 0; i < 2; ++i) { int R, C; stage_rc(tid * 16 + i * 8192, R, C); const int Rb = Epi::PERM ? ((R & ~31) + perm32(R & 31)) : R;
        voffA[i] = (unsigned)(R * K + C) * 2u; voffB[i] = (unsigned)(Rb * K + C) * 2u; }
    const size_t kstep = (size_t)(BK * 2);
    const size_t hstep = (size_t)HALF * K * 2;
    const size_t tstep = 2 * hstep;
    const unsigned ldsw = (unsigned)wid * 1024u;
    const int aoff = lds_byte(wr * 64 + fr, fq * 8), boff = lds_byte(wc * 32 + fr, fq * 8);
#define PG8_SA(b, h) (((b) * 2 + (h)) * HTB)
#define PG8_SB(b, h) ((4 + (b) * 2 + (h)) * HTB)
#define PG8_STAGE(bufoff, gbase, voff) do { _Pragma("unroll") for (int _i = 0; _i < 2; ++_i) \
        __builtin_amdgcn_global_load_lds((const unsigned*)((const char*)(gbase) + (voff)[_i]), (PG8_LAS unsigned*)(lds + (bufoff) + ldsw + _i * 8192), 16, 0, 0); } while (0)
#define PG8_LDA(dst, b, h) do { _Pragma("unroll") for (int m = 0; m < 4; ++m) _Pragma("unroll") for (int k = 0; k < 2; ++k) dst[m][k] = *(const PG8_LAS bf16x8*)(lds + PG8_SA(b, h) + aoff + m * 2048 + k * 1024); } while (0)
#define PG8_LDB(dst, b, h) do { _Pragma("unroll") for (int n = 0; n < 2; ++n) _Pragma("unroll") for (int k = 0; k < 2; ++k) dst[n][k] = *(const PG8_LAS bf16x8*)(lds + PG8_SB(b, h) + boff + n * 2048 + k * 1024); } while (0)
#define PG8_MMA(ai, bj, At, Bt) do { __builtin_amdgcn_s_setprio(1); _Pragma("unroll") for (int m = 0; m < 4; ++m) _Pragma("unroll") for (int n = 0; n < 2; ++n) _Pragma("unroll") for (int k = 0; k < 2; ++k) \
        acc[ai][bj][m][n] = __builtin_amdgcn_mfma_f32_16x16x32_bf16(Bt[n][k], At[m][k], acc[ai][bj][m][n], 0, 0, 0); __builtin_amdgcn_s_setprio(0); } while (0)
#define PG8_WAIT_V(n) asm volatile("s_waitcnt vmcnt(" #n ")" ::: "memory")
#define PG8_WAIT_L(n) asm volatile("s_waitcnt lgkmcnt(" #n ")" ::: "memory")
#define PG8_BAR __builtin_amdgcn_s_barrier()
#define PG8_SCHED __builtin_amdgcn_sched_barrier(0)
    Unit cur, nxt; int ui = 0;
    if (!S.next(0, cur)) return;
    f32x4 acc[2][2][4][2];
#pragma unroll
    for (int a = 0; a < 2; ++a)
#pragma unroll
        for (int b = 0; b < 2; ++b)
#pragma unroll
            for (int m = 0; m < 4; ++m)
#pragma unroll
                for (int n = 0; n < 2; ++n) acc[a][b][m][n] = (f32x4){0.f, 0.f, 0.f, 0.f};
    bf16x8 At[4][2], B0[2][2], B1[2][2];
    const char* cA = (const char*)g.A + (size_t)cur.pm * tstep; const char* cB = (const char*)g.Bt + (size_t)cur.pn * tstep;
    S.a_ready(cur);
    if constexpr (SP2) {
        PG8_STAGE(PG8_SB(0, 0), cB, voffB); PG8_STAGE(PG8_SB(0, 1), cB + hstep, voffB); PG8_STAGE(PG8_SA(0, 0), cA, voffA); PG8_STAGE(PG8_SA(0, 1), cA + hstep, voffA);
        if (wr == 1) PG8_BAR;
        PG8_WAIT_V(2); PG8_BAR;
        PG8_STAGE(PG8_SB(1, 0), cB + kstep, voffB); PG8_STAGE(PG8_SA(1, 0), cA + kstep, voffA); PG8_STAGE(PG8_SB(1, 1), cB + hstep + kstep, voffB);
        PG8_WAIT_V(6); PG8_BAR;
    } else {
        PG8_STAGE(PG8_SB(0, 0), cB, voffB); PG8_STAGE(PG8_SA(0, 0), cA, voffA); PG8_STAGE(PG8_SB(0, 1), cB + hstep, voffB); PG8_STAGE(PG8_SA(0, 1), cA + hstep, voffA);
        if (wr == 1) PG8_BAR;
        PG8_WAIT_V(4); PG8_BAR;
        PG8_STAGE(PG8_SB(1, 0), cB + kstep, voffB); PG8_STAGE(PG8_SA(1, 0), cA + kstep, voffA); PG8_STAGE(PG8_SB(1, 1), cB + hstep + kstep, voffB);
        PG8_WAIT_V(6); PG8_BAR;
    }
    for (;;) {
        const bool has_next = S.next(ui + 1, nxt);
        const char* nA = has_next ? (const char*)g.A + (size_t)nxt.pm * tstep : cA; const char* nB = has_next ? (const char*)g.Bt + (size_t)nxt.pn * tstep : cB;
        for (int t = 0; t < nt; t += 2) {
            const bool last = (t == nt - 2);
            const char* a1 = cA + (size_t)(t + 1) * kstep;
            const char* a2 = last ? nA : cA + (size_t)(t + 2) * kstep; const char* b2 = last ? nB : cB + (size_t)(t + 2) * kstep;
            const char* a3 = a2 + kstep; const char* b3 = b2 + kstep;
            if (last && has_next) S.a_ready(nxt);
            if constexpr (SP2) {
            PG8_LDB(B0, 0, 0); PG8_LDB(B1, 0, 1); PG8_SCHED; PG8_LDA(At, 0, 0); PG8_STAGE(PG8_SA(1, 1), a1 + hstep, voffA);
            PG8_WAIT_V(8); PG8_WAIT_L(0); PG8_BAR; PG8_MMA(0, 0, At, B0); PG8_MMA(0, 1, At, B1); PG8_BAR; PG8_SCHED;
            PG8_LDA(At, 0, 1); PG8_STAGE(PG8_SB(0, 0), b2, voffB); PG8_STAGE(PG8_SB(0, 1), b2 + hstep, voffB); PG8_STAGE(PG8_SA(0, 0), a2, voffA);
            PG8_WAIT_V(8); PG8_WAIT_L(0); PG8_BAR; PG8_MMA(1, 0, At, B0); PG8_MMA(1, 1, At, B1); PG8_BAR; PG8_SCHED;
            PG8_LDB(B0, 1, 0); PG8_LDB(B1, 1, 1); PG8_SCHED; PG8_LDA(At, 1, 0); PG8_STAGE(PG8_SA(0, 1), a2 + hstep, voffA);
            PG8_WAIT_V(8); PG8_WAIT_L(0); PG8_BAR; PG8_MMA(0, 0, At, B0); PG8_MMA(0, 1, At, B1); PG8_BAR; PG8_SCHED;
            PG8_LDA(At, 1, 1); PG8_STAGE(PG8_SB(1, 0), b3, voffB); PG8_STAGE(PG8_SB(1, 1), b3 + hstep, voffB); PG8_STAGE(PG8_SA(1, 0), a3, voffA);
            PG8_WAIT_V(8); PG8_WAIT_L(0); PG8_BAR; PG8_MMA(1, 0, At, B0); PG8_MMA(1, 1, At, B1); PG8_BAR; PG8_SCHED;
            } else {
            PG8_LDB(B0, 0, 0); PG8_SCHED; PG8_LDA(At, 0, 0); PG8_STAGE(PG8_SA(1, 1), a1 + hstep, voffA);
            PG8_WAIT_L(8); PG8_BAR; PG8_WAIT_L(0); PG8_MMA(0, 0, At, B0); PG8_BAR; PG8_SCHED;
            PG8_LDB(B1, 0, 1); PG8_STAGE(PG8_SB(0, 0), b2, voffB);
            PG8_BAR; PG8_WAIT_L(0); PG8_MMA(0, 1, At, B1); PG8_BAR;
            PG8_LDA(At, 0, 1); PG8_STAGE(PG8_SA(0, 0), a2, voffA);
            PG8_BAR; PG8_WAIT_L(0); PG8_MMA(1, 0, At, B0); PG8_BAR; PG8_SCHED;
            PG8_STAGE(PG8_SB(0, 1), b2 + hstep, voffB);
            PG8_WAIT_V(6); PG8_BAR; PG8_MMA(1, 1, At, B1); PG8_BAR;
            PG8_LDB(B0, 1, 0); PG8_SCHED; PG8_LDA(At, 1, 0); PG8_STAGE(PG8_SA(0, 1), a2 + hstep, voffA);
            PG8_WAIT_L(8); PG8_BAR; PG8_WAIT_L(0); PG8_MMA(0, 0, At, B0); PG8_BAR; PG8_SCHED;
            PG8_LDB(B1, 1, 1); PG8_STAGE(PG8_SB(1, 0), b3, voffB);
            PG8_BAR; PG8_WAIT_L(0); PG8_MMA(0, 1, At, B1); PG8_BAR;
            PG8_LDA(At, 1, 1); PG8_STAGE(PG8_SA(1, 0), a3, voffA);
            PG8_BAR; PG8_WAIT_L(0); PG8_MMA(1, 0, At, B0); PG8_BAR; PG8_SCHED;
            PG8_STAGE(PG8_SB(1, 1), b3 + hstep, voffB);
            PG8_WAIT_V(6); PG8_BAR; PG8_MMA(1, 1, At, B1); PG8_BAR;
            }
        }
        if constexpr (ALIGN_EPI) { if (wr == 0) PG8_BAR; }
        if constexpr (!Epi::AFTER_DRAIN) { E(acc, cur, wr, wc, fr, fq); S.done(cur); }
        if (!has_next) break;
#pragma unroll
        for (int a = 0; a < 2; ++a)
#pragma unroll
            for (int b = 0; b < 2; ++b)
#pragma unroll
                for (int m = 0; m < 4; ++m)
#pragma unroll
                    for (int n = 0; n < 2; ++n) acc[a][b][m][n] = (f32x4){0.f, 0.f, 0.f, 0.f};
        cur = nxt; cA = nA; cB = nB; ++ui;
        if constexpr (ALIGN_EPI) { if (wr == 1) PG8_BAR; }
    }
    PG8_WAIT_V(0);
    if constexpr (!ALIGN_EPI) { if (wr == 0) PG8_BAR; }
    PG8_BAR;
    if constexpr (Epi::AFTER_DRAIN) { E.fused(acc, cur, wr, wc, fr, fq, lds, wid, lane); S.done(cur); }
#undef PG8_SA
#undef PG8_SB
#undef PG8_STAGE
#undef PG8_LDA
#undef PG8_LDB
#undef PG8_MMA
#undef PG8_WAIT_V
#undef PG8_WAIT_L
#undef PG8_BAR
#undef PG8_SCHED
}
}

#ifndef PG8_SP2
#define PG8_SP2 true
#endif
#ifndef PG8_ALIGN
#define PG8_ALIGN true
#endif
#include <hip/hip_bf16.h>
#include <cmath>
namespace attn_body {
using bf16=__hip_bfloat16;
using bf16x8=__attribute__((ext_vector_type(8)))short;
using s16x4=__attribute__((ext_vector_type(4)))short;
using f32x16=__attribute__((ext_vector_type(16)))float;
using u32x4=__attribute__((ext_vector_type(4)))unsigned;
constexpr int BATCH=16,SEQ=2048,D=64,PIN=3584,POUT=1024;
constexpr int NW=8,QBLK=32,QB=QBLK*NW,KVBLK=64,NQB=SEQ/QB;
constexpr int ATTN_UNIT_ROWS=QB;
__device__ __forceinline__ int crow(int r,int hi){return (r&3)+8*(r>>2)+4*hi;}
#define SBAR() __builtin_amdgcn_sched_barrier(0)
__device__ __forceinline__ void cmask(f32x16&p0,f32x16&p1,int jb,int qrel,int hi){
  const float NEG=-INFINITY; int kb=64*jb+4*hi;
  #pragma unroll
  for(int r=0;r<16;++r){int kv=kb+(r&3)+8*(r>>2); if(kv>qrel)p0[r]=NEG; if(kv+32>qrel)p1[r]=NEG;}
}

constexpr int NSLOT=3, SLOTB=8192;
constexpr int LDS_K=0, LDS_V=NSLOT*SLOTB, LDS_WS=2*NSLOT*SLOTB, LDS_OST=LDS_WS+NW*64*4, LDS_BYTES=LDS_OST+NW*4096;
constexpr float C2=0.125f*1.4426950408889634f;
__device__ __forceinline__ void glds16(const void*gsrc,unsigned lds_dst){unsigned keep;
  asm volatile("s_mov_b32 %0, m0\n\ts_mov_b32 m0, %2\n\ts_nop 0\n\tglobal_load_lds_dwordx4 %1, off\n\ts_mov_b32 m0, %0":"=&s"(keep):"v"(gsrc),"s"(lds_dst):"memory");}
__device__ __forceinline__ float max3f(float a,float b,float c){float r;asm("v_max3_f32 %0, %1, %2, %3":"=v"(r):"v"(a),"v"(b),"v"(c));return r;}
__device__ __forceinline__ float max2f(float a,float b){float r;asm("v_max_f32_e32 %0, %1, %2":"=v"(r):"v"(a),"v"(b));return r;}
__device__ __forceinline__ float fadd_s(float a,float b){float r;asm("v_add_f32_e32 %0, %1, %2":"=v"(r):"v"(a),"v"(b));return r;}
__device__ __forceinline__ float fsub_s(float a,float b){float r;asm("v_sub_f32_e32 %0, %1, %2":"=v"(r):"v"(a),"v"(b));return r;}
typedef float f32x2_t __attribute__((ext_vector_type(2))); typedef __bf16 bf16x2_t __attribute__((ext_vector_type(2)));
__device__ __forceinline__ unsigned cvtpk_s(float lo,float hi){f32x2_t v={lo,hi};bf16x2_t b=__builtin_convertvector(v,bf16x2_t);return __builtin_bit_cast(unsigned,b);}
#define WAIT_BAR(N) asm volatile("s_waitcnt vmcnt(" #N ") lgkmcnt(0)\n\ts_barrier":::"memory")

__device__ __forceinline__ void qkt(f32x16&p0,f32x16&p1,const char*Kslot,const bf16x8*qr,const f32x16&negm,int r32,int hi){
  const char*kb=Kslot+hi*1024+r32*16;
  #pragma unroll
  for(int d0=0;d0<4;++d0){
    const bf16x8 b0=*reinterpret_cast<const bf16x8*>(kb+d0*2048);
    const bf16x8 b1=*reinterpret_cast<const bf16x8*>(kb+d0*2048+512);
    if(d0==0){p0=__builtin_amdgcn_mfma_f32_32x32x16_bf16(b0,qr[0],negm,0,0,0);p1=__builtin_amdgcn_mfma_f32_32x32x16_bf16(b1,qr[0],negm,0,0,0);}
    else{p0=__builtin_amdgcn_mfma_f32_32x32x16_bf16(b0,qr[d0],p0,0,0,0);p1=__builtin_amdgcn_mfma_f32_32x32x16_bf16(b1,qr[d0],p1,0,0,0);}}
}
typedef __attribute__((address_space(3))) const char* lds_cptr;
typedef short v4i16_t __attribute__((ext_vector_type(4)));
__device__ __forceinline__ void kload8(bf16x8*kf,lds_cptr kp){
  kf[0]=*(const __attribute__((address_space(3))) bf16x8*)(kp);      kf[1]=*(const __attribute__((address_space(3))) bf16x8*)(kp+512);
  kf[2]=*(const __attribute__((address_space(3))) bf16x8*)(kp+2048); kf[3]=*(const __attribute__((address_space(3))) bf16x8*)(kp+2560);
  kf[4]=*(const __attribute__((address_space(3))) bf16x8*)(kp+4096); kf[5]=*(const __attribute__((address_space(3))) bf16x8*)(kp+4608);
  kf[6]=*(const __attribute__((address_space(3))) bf16x8*)(kp+6144); kf[7]=*(const __attribute__((address_space(3))) bf16x8*)(kp+6656);
}
__device__ __forceinline__ void kload2(bf16x8*kf,lds_cptr kp,int j){ kf[2*j]=*(const __attribute__((address_space(3))) bf16x8*)(kp+j*2048); kf[2*j+1]=*(const __attribute__((address_space(3))) bf16x8*)(kp+j*2048+512); }
__device__ __forceinline__ s16x4 vtr(lds_cptr p){ return __builtin_bit_cast(s16x4,__builtin_amdgcn_ds_read_tr16_b64_v4i16((__attribute__((address_space(3))) v4i16_t*)p)); }
__device__ __forceinline__ float rowmax(const f32x16&p0,const f32x16&p1){
  float a=max3f(p0[0],p0[1],p1[0]),b=max3f(p0[2],p0[3],p1[1]);a=max3f(a,p1[2],p1[3]);
  #pragma unroll
  for(int r=4;r<16;r+=4){a=max3f(a,p0[r],p0[r+1]);b=max3f(b,p0[r+2],p0[r+3]);a=max3f(a,p1[r],p1[r+1]);b=max3f(b,p1[r+2],p1[r+3]);}
  const float m=max2f(a,b);
  auto rr=__builtin_amdgcn_permlane32_swap(__float_as_uint(m),__float_as_uint(m),false,false);
  return max2f(__uint_as_float(rr[0]),__uint_as_float(rr[1]));
}
__device__ __forceinline__ void pv(f32x16*o,int vb,bf16x8 pa0,bf16x8 pa1,bf16x8 pa2,bf16x8 pa3){
  #pragma unroll
  for(int d0=0;d0<2;++d0){s16x4 lo[4],hi[4];
    #pragma unroll
    for(int ks=0;ks<4;++ks){
      asm volatile("ds_read_b64_tr_b16 %0,%1 offset:%c2":"=&v"(lo[ks]):"v"(vb),"i"(d0*4096+ks*1024):"memory");
      asm volatile("ds_read_b64_tr_b16 %0,%1 offset:%c2":"=&v"(hi[ks]):"v"(vb),"i"(d0*4096+ks*1024+512):"memory");}
    asm volatile("s_waitcnt lgkmcnt(0)":::"memory");SBAR();
    #define PK(k) (bf16x8){lo[k][0],lo[k][1],lo[k][2],lo[k][3],hi[k][0],hi[k][1],hi[k][2],hi[k][3]}
    o[d0]=__builtin_amdgcn_mfma_f32_32x32x16_bf16(pa0,PK(0),o[d0],0,0,0);
    o[d0]=__builtin_amdgcn_mfma_f32_32x32x16_bf16(pa1,PK(1),o[d0],0,0,0);
    o[d0]=__builtin_amdgcn_mfma_f32_32x32x16_bf16(pa2,PK(2),o[d0],0,0,0);
    o[d0]=__builtin_amdgcn_mfma_f32_32x32x16_bf16(pa3,PK(3),o[d0],0,0,0);
    #undef PK
  }
}

#ifndef ATTN_STORE16
#define ATTN_STORE16(p,v) (*(u32x4*)(p)=(v))
#endif
template<int THRL> __device__ __forceinline__ void attn_unit(int b,int qb,const bf16*Q,const bf16*__restrict__ K,const bf16*__restrict__ V,bf16*O,char*shm){
  const int tid=threadIdx.x,lane=tid&63,r32=lane&31,hi=lane>>5; const int wid=__builtin_amdgcn_readfirstlane(tid>>6);
  const long rowbase=(long)b*SEQ; const int q0=qb*QB;
  const bf16*Qw=Q+(rowbase+q0+wid*QBLK)*PIN;
  const bf16*Kh=K+rowbase*PIN,*Vh=V+rowbase*PIN;
  const unsigned lds0=(unsigned)(uintptr_t)shm;
  float*wsf=(float*)(shm+LDS_WS)+wid*64;
  const bf16*ksrc=Kh+(long)lane*PIN+wid*8;
  const bf16*vsrc=Vh+(long)(16*(wid&3)+(lane>>2))*PIN+(wid>>2)*32+(lane&3)*8;
  const unsigned kdst=lds0+LDS_K+wid*1024, vdst=lds0+LDS_V+wid*1024;
  #define DMA_K(t,slot) glds16(ksrc+(long)(t)*KVBLK*PIN,(unsigned)__builtin_amdgcn_readfirstlane(kdst+(slot)))
  #define DMA_V(t,slot) glds16(vsrc+(long)(t)*KVBLK*PIN,(unsigned)__builtin_amdgcn_readfirstlane(vdst+(slot)))
  const int vb0=(int)(lds0+LDS_V)+((lane>>4)&1)*32+(lane&3)*8+(4*hi+((lane&15)>>2))*64;
  const char*Kbase=shm+LDS_K; bf16x8 kf[8];
  const lds_cptr shm3=(lds_cptr)shm; const lds_cptr kp0=shm3+LDS_K+hi*1024+r32*16; const lds_cptr vp0=shm3+LDS_V+((lane>>4)&1)*32+(lane&3)*8+(4*hi+((lane&15)>>2))*64;
  const int NT=(q0+QB)/KVBLK;
  DMA_K(0,0);DMA_V(0,0);DMA_K(1,SLOTB);
  bf16x8 qr[4];
  #pragma unroll
  for(int d0=0;d0<4;++d0)qr[d0]=*reinterpret_cast<const bf16x8*>(&Qw[(long)r32*PIN+d0*16+hi*8]);
  float mhat=0.f,l_reg=0.f;f32x16 o[2];o[0]=f32x16{};o[1]=f32x16{};f32x16 negm=f32x16{};asm volatile("":"+v"(negm));
  const int qrel=wid*QBLK+r32;
  #define CMASK(P0,P1,t) do{int jb_=(t)-(NT-4); if(jb_>=0)cmask(P0,P1,jb_,qrel,hi);}while(0)
  bool resc=false;
  #define START(P0,P1) do{ const float rm=rowmax(P0,P1); resc=false; \
    { const float dl=rm; mhat=fadd_s(mhat,dl); \
      _Pragma("unroll") for(int r=0;r<16;++r){P0[r]=fsub_s(P0[r],dl);P1[r]=fsub_s(P1[r],dl);} \
      _Pragma("unroll") for(int r=0;r<16;++r)negm[r]=-mhat; asm volatile("":"+v"(negm)); } \
    _Pragma("unroll") for(int r=0;r<16;++r)P0[r]=__builtin_amdgcn_exp2f(P0[r]); }while(0)
  #define RESC() do{ if(resc){ asm volatile("s_waitcnt lgkmcnt(0)":::"memory"); \
      _Pragma("unroll") for(int d_=0;d_<2;++d_) _Pragma("unroll") for(int r=0;r<16;++r)o[d_][r]*=wsf[crow(r,hi)]; } }while(0)
  f32x16 pA0,pA1,pB0,pB1;
  int sl_prev=0,sl_cur=0,sl_next=SLOTB;
  #define ROT() do{sl_prev=sl_cur;sl_cur=sl_next;sl_next=(sl_next==(NSLOT-1)*SLOTB)?0:sl_next+SLOTB;}while(0)
  DMA_K(2,2*SLOTB);
  WAIT_BAR(3);
  qkt(pA0,pA1,Kbase,qr,negm,r32,hi);asm volatile("s_nop 15\n\ts_nop 7":"+v"(pA0),"+v"(pA1));CMASK(pA0,pA1,0);
  START(pA0,pA1);
  _Pragma("unroll") for(int r=0;r<16;++r)pA1[r]=__builtin_amdgcn_exp2f(pA1[r]);
  WAIT_BAR(0);
  DMA_K(3,0);DMA_V(1,SLOTB);
  ROT();
  kload8(kf,kp0+sl_cur);
  WAIT_BAR(2);
  s16x4 vlo[8],vhi[8]; u32x4 pw0,pw1,pw2,pw3;
  #define PKW(P,B) cvtpk_s(P[B],P[B+1])
  #define PAF(k) __builtin_bit_cast(bf16x8,pw##k)
  #define VFR(i) (bf16x8){vlo[i][0],vlo[i][1],vlo[i][2],vlo[i][3],vhi[i][0],vhi[i][1],vhi[i][2],vhi[i][3]}
  #define PIN(x) asm volatile("":"+v"(x))
  #define MX3(a,b,c) __builtin_fmaxf(__builtin_fmaxf((a),(b)),(c))
  #define GAPA(MF,A0,A1,A2,A3,W0,W1,PW) do{ MF; sacc+=A0; sacc+=A1; sacc+=A2; sacc+=A3; PIN(sacc); W0; W1; PIN(PW); SBAR(); }while(0)
  #define EX(v) __builtin_amdgcn_exp2f(v)
  #define GAPB(MF,X,B) do{ MF; X[B]=EX(X[B]); X[B+1]=EX(X[B+1]); X[B+2]=EX(X[B+2]); X[B+3]=EX(X[B+3]); PIN(X); SBAR(); }while(0)
  #define VRD(i) do{ vlo[i]=vtr(vp_+(((i)>>2)*4096+((i)&3)*1024)); vhi[i]=vtr(vp_+(((i)>>2)*4096+((i)&3)*1024+512)); }while(0)
  #define KRD(G,j) do{ if(G){ kload2(kf,kp0+sl_next,j); SBAR(); } }while(0)
  #define STEP(C0,C1,P0,P1,t,GK,GV,GL) do{ SBAR(); \
    const lds_cptr vp_=vp0+sl_prev; \
    VRD(0); SBAR(); float sacc=(P0[0]+P0[1]); \
    GAPA(C0=__builtin_amdgcn_mfma_f32_32x32x16_bf16(kf[0],qr[0],negm,0,0,0), P0[2],P0[3],P0[4],P0[5],     pw0[0]=PKW(P0,0), pw0[1]=PKW(P0,2), pw0); \
    VRD(4); SBAR(); GAPA(C1=__builtin_amdgcn_mfma_f32_32x32x16_bf16(kf[1],qr[0],negm,0,0,0), P0[6],P0[7],P0[8],P0[9],     pw0[2]=PKW(P0,4), pw0[3]=PKW(P0,6), pw0); \
    VRD(1); SBAR(); GAPA(C0=__builtin_amdgcn_mfma_f32_32x32x16_bf16(kf[2],qr[1],C0,0,0,0),   P0[10],P0[11],P0[12],P0[13], pw1[0]=PKW(P0,8), pw1[1]=PKW(P0,10), pw1); \
    VRD(5); SBAR(); GAPA(C1=__builtin_amdgcn_mfma_f32_32x32x16_bf16(kf[3],qr[1],C1,0,0,0),   P0[14],P0[15],P1[0],P1[1],   pw1[2]=PKW(P0,12),pw1[3]=PKW(P0,14), pw1); \
    VRD(2); SBAR(); GAPA(C0=__builtin_amdgcn_mfma_f32_32x32x16_bf16(kf[4],qr[2],C0,0,0,0),   P1[2],P1[3],P1[4],P1[5],     pw2[0]=PKW(P1,0), pw2[1]=PKW(P1,2), pw2); \
    VRD(6); SBAR(); GAPA(C1=__builtin_amdgcn_mfma_f32_32x32x16_bf16(kf[5],qr[2],C1,0,0,0),   P1[6],P1[7],P1[8],P1[9],     pw2[2]=PKW(P1,4), pw2[3]=PKW(P1,6), pw2); \
    VRD(3); SBAR(); GAPA(C0=__builtin_amdgcn_mfma_f32_32x32x16_bf16(kf[6],qr[3],C0,0,0,0),   P1[10],P1[11],P1[12],P1[13], pw3[0]=PKW(P1,8), pw3[1]=PKW(P1,10), pw3); \
    VRD(7); SBAR(); GAPA(C1=__builtin_amdgcn_mfma_f32_32x32x16_bf16(kf[7],qr[3],C1,0,0,0),   P1[14],P1[15],0.f,0.f,       pw3[2]=PKW(P1,12),pw3[3]=PKW(P1,14), pw3); \
    l_reg+=sacc; \
    if(GK){DMA_K((t)+3,sl_cur);} if(GV){DMA_V((t)+1,sl_next);} \
    CMASK(C0,C1,t); \
    { float a=MX3(C0[0],C0[1],C1[0]),b=MX3(C0[2],C0[3],C1[1]); a=MX3(a,C1[2],C1[3]); \
      _Pragma("unroll") for(int r=4;r<16;r+=4){a=MX3(a,C0[r],C0[r+1]);b=MX3(b,C0[r+2],C0[r+3]);a=MX3(a,C1[r],C1[r+1]);b=MX3(b,C1[r+2],C1[r+3]);} \
      float rm=__builtin_fmaxf(a,b); { auto rr=__builtin_amdgcn_permlane32_swap(__float_as_uint(rm),__float_as_uint(rm),false,false); rm=__builtin_fmaxf(__uint_as_float(rr[0]),__uint_as_float(rr[1])); } \
      resc=false; \
      if(__builtin_expect(__any(rm>(float)THRL),0)){ const float dl=__builtin_fmaxf(rm,0.f); mhat+=dl; \
        _Pragma("unroll") for(int r=0;r<16;++r){C0[r]-=dl;C1[r]-=dl;} \
        _Pragma("unroll") for(int r=0;r<16;++r)negm[r]=-mhat; asm volatile("":"+v"(negm)); \
        const float f=__builtin_amdgcn_exp2f(-dl); l_reg*=f; if(hi==0)wsf[r32]=f; resc=true; } } \
    SBAR(); \
    GAPB(o[0]=__builtin_amdgcn_mfma_f32_32x32x16_bf16(PAF(0),VFR(0),o[0],0,0,0), C0,0); \
    GAPB(o[1]=__builtin_amdgcn_mfma_f32_32x32x16_bf16(PAF(0),VFR(4),o[1],0,0,0), C0,4); \
    KRD(GL,0); GAPB(o[0]=__builtin_amdgcn_mfma_f32_32x32x16_bf16(PAF(1),VFR(1),o[0],0,0,0), C0,8); \
    KRD(GL,1); GAPB(o[1]=__builtin_amdgcn_mfma_f32_32x32x16_bf16(PAF(1),VFR(5),o[1],0,0,0), C0,12); \
    KRD(GL,2); GAPB(o[0]=__builtin_amdgcn_mfma_f32_32x32x16_bf16(PAF(2),VFR(2),o[0],0,0,0), C1,0); \
    KRD(GL,3); GAPB(o[1]=__builtin_amdgcn_mfma_f32_32x32x16_bf16(PAF(2),VFR(6),o[1],0,0,0), C1,4); \
    GAPB(o[0]=__builtin_amdgcn_mfma_f32_32x32x16_bf16(PAF(3),VFR(3),o[0],0,0,0), C1,8); \
    GAPB(o[1]=__builtin_amdgcn_mfma_f32_32x32x16_bf16(PAF(3),VFR(7),o[1],0,0,0), C1,12); \
    }while(0)
  int t=1;
  #undef CMASK
  #define CMASK(P0,P1,t) do{}while(0)
  for(;t+5<NT;t+=2){
    STEP(pB0,pB1,pA0,pA1,t,true,true,true);     WAIT_BAR(2); RESC(); ROT();
    STEP(pA0,pA1,pB0,pB1,t+1,true,true,true);   WAIT_BAR(2); RESC(); ROT();
  }
  #undef CMASK
  #define CMASK(P0,P1,t) do{int jb_=(t)-(NT-4); if(jb_>=0)cmask(P0,P1,jb_,qrel,hi);}while(0)
  #define ENDW(tt) do{ if((tt)+3<NT){WAIT_BAR(2);} else if((tt)+2<NT){WAIT_BAR(1);} else {WAIT_BAR(0);} }while(0)
  for(;t+1<NT;t+=2){
    STEP(pB0,pB1,pA0,pA1,t,(t+3<NT),(t+1<NT),(t+1<NT));       ENDW(t);   RESC(); ROT();
    STEP(pA0,pA1,pB0,pB1,t+1,(t+4<NT),(t+2<NT),(t+2<NT));     ENDW(t+1); RESC(); ROT();
  }
  STEP(pB0,pB1,pA0,pA1,NT-1,false,false,false); RESC();
  { float sacc=pB0[0]+pB0[1]; _Pragma("unroll") for(int r=2;r<16;++r)sacc+=pB0[r]; _Pragma("unroll") for(int r=0;r<16;++r)sacc+=pB1[r]; l_reg+=sacc;
    pw0=(u32x4){PKW(pB0,0),PKW(pB0,2),PKW(pB0,4),PKW(pB0,6)};pw1=(u32x4){PKW(pB0,8),PKW(pB0,10),PKW(pB0,12),PKW(pB0,14)};pw2=(u32x4){PKW(pB1,0),PKW(pB1,2),PKW(pB1,4),PKW(pB1,6)};pw3=(u32x4){PKW(pB1,8),PKW(pB1,10),PKW(pB1,12),PKW(pB1,14)};
    SBAR(); pv(o,vb0+sl_cur,PAF(0),PAF(1),PAF(2),PAF(3)); }
  #undef PKW
  #undef PAF
  #undef VFR
  #undef PIN
  #undef MX3
  #undef GAPA
  #undef GAPB
  #undef EX
  #undef VRD
  #undef KRD
  #undef STEP
  #undef ENDW
  {auto rr=__builtin_amdgcn_permlane32_swap(__float_as_uint(l_reg),__float_as_uint(l_reg),false,false);l_reg=__uint_as_float(rr[0])+__uint_as_float(rr[1]);}
  if(hi==0)wsf[32+r32]=l_reg;asm volatile("s_waitcnt lgkmcnt(0)":::"memory");
  float rli[16];
  #pragma unroll
  for(int r=0;r<16;++r)rli[r]=__builtin_amdgcn_rcpf(wsf[32+crow(r,hi)]);
  bf16*Ow=O+(rowbase+q0+wid*QBLK)*POUT;
  { bf16*stg=(bf16*)(shm+LDS_OST)+wid*2048;
    #pragma unroll
    for(int r=0;r<16;++r){const int orow=crow(r,hi);
      #pragma unroll
      for(int d0=0;d0<2;++d0)stg[orow*64+d0*32+r32]=__float2bfloat16(o[d0][r]*rli[r]);}
    asm volatile("s_waitcnt lgkmcnt(0)":::"memory");
    #pragma unroll
    for(int i=0;i<4;++i){const int row=i*8+(lane>>3),ch=lane&7; const u32x4 v=*(const u32x4*)(stg+row*64+ch*8); ATTN_STORE16(Ow+(long)row*POUT+ch*8,v);} }
  asm volatile("s_waitcnt lgkmcnt(0)\n\ts_barrier":::"memory");
  #undef DMA_K
  #undef DMA_V
  #undef CMASK
  #undef START
  #undef RESC
  #undef ROT
}
constexpr int ATTN_LDS_BYTES=LDS_BYTES;
#undef SBAR
#undef WAIT_BAR
}

#define GAS __attribute__((address_space(1)))
#define LAS __attribute__((address_space(3)))
typedef unsigned short bf16;
typedef unsigned v4u __attribute__((ext_vector_type(4)));
typedef float f32x4 __attribute__((ext_vector_type(4)));
typedef short bf16x8 __attribute__((ext_vector_type(8)));
typedef GAS unsigned gu32;
typedef GAS unsigned long long gu64;
#define RLX_AGENT __ATOMIC_RELAXED, __HIP_MEMORY_SCOPE_AGENT
#define LDS_WAIT() asm volatile("s_waitcnt lgkmcnt(0)" ::: "memory")
#define VM_WAIT() asm volatile("s_waitcnt vmcnt(0)" ::: "memory")
__device__ __forceinline__ unsigned long long rt() { return __builtin_amdgcn_s_memrealtime(); }
__device__ __forceinline__ unsigned f2bf(float f) { unsigned u = __builtin_bit_cast(unsigned, f); return (u + 0x7fffu + ((u >> 16) & 1u)) >> 16; }
__device__ __forceinline__ unsigned pk2(float lo, float hi) { return f2bf(lo) | (f2bf(hi) << 16); }

#define XB_TMO      128
#define XB_XCNT(j)  (256  + 64 * (j))
#define XB_XSUB(j)  (1280 + 64 * (j))
#define XB_XGEN(j)  (2304 + 64 * (j))
#define XB_TOP      3328
#define XB_TOPGEN   3392
#define XCD_BAR_WORDS 3456
#define XB_SPIN_CAP (1u << 18)

__device__ __forceinline__ unsigned xb_ld(unsigned* p)              { return __hip_atomic_load(p, __ATOMIC_RELAXED, __HIP_MEMORY_SCOPE_AGENT); }
__device__ __forceinline__ unsigned xb_add(unsigned* p, unsigned v) { return __hip_atomic_fetch_add(p, v, __ATOMIC_RELAXED, __HIP_MEMORY_SCOPE_AGENT); }
__device__ __forceinline__ unsigned xb_xcc_id() { return (unsigned)__builtin_amdgcn_s_getreg((3 << 11) | 20) & 0xFu; }
#define XB_SPIN(cond, bar) do { unsigned _sp = 0; while (cond) { __builtin_amdgcn_s_sleep(1); \
    if ((++_sp & 255u) == 0u) { if (xb_ld(&(bar)[XB_TMO])) break; if (_sp > XB_SPIN_CAP) { atomicAdd(&(bar)[XB_TMO], 1u); break; } } } } while (0)

struct XcdBarrier {
    unsigned* bar; unsigned x;
    volatile LAS unsigned* st;
};

__device__ __forceinline__ XcdBarrier xcd_barrier_post(unsigned* bar, volatile LAS unsigned* st) {
    XcdBarrier b; b.bar = bar; b.x = xb_xcc_id(); b.st = st;
    if (threadIdx.x == 0) (void)xb_add(&bar[XB_XCNT(b.x)], 1u);
    return b;
}
__device__ __forceinline__ void xcd_barrier_complete(unsigned* bar, unsigned x, unsigned& nloc, unsigned& nx) {
    const unsigned G = gridDim.x * gridDim.y * gridDim.z;
    unsigned sum, cnt, mine, sp = 0u;
    for (;;) {
        sum = 0u; cnt = 0u; mine = 0u;
#pragma unroll
        for (unsigned j = 0; j < 16; ++j) { const unsigned c = xb_ld(&bar[XB_XCNT(j)]); sum += c; cnt += (c > 0u) ? 1u : 0u; mine = (j == x) ? c : mine; }
        if (sum == G) break;
        __builtin_amdgcn_s_sleep(1);
        if ((++sp & 255u) == 0u) { if (xb_ld(&bar[XB_TMO])) break; if (sp > XB_SPIN_CAP) { atomicAdd(&bar[XB_TMO], 1u); break; } }
    }
    nloc = mine > 0u ? mine : 1u; nx = cnt > 0u ? cnt : 1u;
}

__device__ __forceinline__ void xcd_barrier(const XcdBarrier& b) {
    asm volatile("s_waitcnt vmcnt(0)" ::: "memory");
    __syncthreads();
    if (threadIdx.x == 0) {
        unsigned* bar = b.bar;
        __builtin_amdgcn_s_waitcnt(0);
        unsigned nloc = b.st[0], nx = b.st[1];
        if (nloc == 0u) { xcd_barrier_complete(bar, b.x, nloc, nx); b.st[0] = nloc; b.st[1] = nx; }
        const unsigned old = xb_add(&bar[XB_XSUB(b.x)], 1u);
        const unsigned gen = old / nloc;
        if (old + 1u == (gen + 1u) * nloc) {
            __builtin_amdgcn_fence(__ATOMIC_RELEASE, "agent");
            asm volatile("s_waitcnt vmcnt(0)" ::: "memory");
            const unsigned og = xb_add(&bar[XB_TOP], 1u);
            const unsigned tg = og / nx;
            if (og + 1u == (tg + 1u) * nx) xb_add(&bar[XB_TOPGEN], 1u);
            else XB_SPIN(xb_ld(&bar[XB_TOPGEN]) == tg, bar);
            __builtin_amdgcn_fence(__ATOMIC_ACQUIRE, "agent");
            xb_add(&bar[XB_XGEN(b.x)], 1u);
            asm volatile("s_waitcnt vmcnt(0)" ::: "memory");
        } else {
            XB_SPIN(xb_ld(&bar[XB_XGEN(b.x)]) == gen, bar);
            __builtin_amdgcn_fence(__ATOMIC_ACQUIRE, "agent");
            asm volatile("s_waitcnt vmcnt(0)" ::: "memory");
        }
    }
    __syncthreads();
}

constexpr int NWAVES = 8;
constexpr int BATCH = 16, SEQ = 2048, D = 1024, M = BATCH * SEQ;
constexpr int NPROJ = 3584;
constexpr int C_RQ = 0, C_RK = 512, C_RV = 1024, C_RG = 1536, C_DQ = 2048, C_DK = 2560, C_DV = 3072;
constexpr int NQ = 2048, NEXP = 16384, NSEL = 128;
constexpr float ALPHA = 1.189207115002721f, LN_EPS = 1e-5f, LAMBDA_INIT = 0.2f;
constexpr float QSCALE = 0.125f * 1.4426950408889634f;
constexpr float KSCALE = 0.08838834764831845f;

constexpr size_t MiB = 1u << 20;
constexpr size_t WS_CTL = 0, CTL_ZERO_BYTES = 1 * MiB;
constexpr size_t WS_WIN = 2 * MiB, WS_WOUT = 10 * MiB, WS_WQ = 12 * MiB, WS_SK = 16 * MiB, WS_ROPE = 17 * MiB, WS_MISC = 18 * MiB;
constexpr size_t WS_XB = 32 * MiB;
constexpr size_t WS_DOUT = 32 * MiB;
constexpr size_t WS_PU = 96 * MiB, WS_PV = 128 * MiB;
constexpr size_t WS_PROJ = 160 * MiB;
constexpr size_t WS_X1 = 160 * MiB, WS_IDX = 224 * MiB, WS_GATE = 240 * MiB, WS_QP = 256 * MiB;
constexpr size_t WS_MIX = 400 * MiB;
constexpr size_t WS_END = 464 * MiB;
constexpr int CW_TMO = 0, CW_CODE = 1, CW_BAR = 4096;

constexpr int RING_OFF = 0, RING_BYTES = 131072;
constexpr int LDSCTL_OFF = RING_BYTES, MISC_OFF = LDSCTL_OFF + 320;
constexpr int LDS_BYTES = 147456;

struct Frame {
    LAS unsigned char* lds;
    volatile LAS unsigned* MISC;
    gu32* ctl;
    int tid, lane, wave;
    int vcu, G;
    const float* const* in; float* out; unsigned char* ws;
};

__device__ __forceinline__ float bf2f(unsigned short b) { return __builtin_bit_cast(float, (unsigned)b << 16); }
__device__ __forceinline__ float bflo(unsigned w) { return __builtin_bit_cast(float, w << 16); }
__device__ __forceinline__ float bfhi(unsigned w) { return __builtin_bit_cast(float, w & 0xffff0000u); }
__device__ __forceinline__ float wave_sum(float v) {
#pragma unroll
    for (int o = 1; o < 64; o <<= 1) v += __shfl_xor(v, o);
    return v;
}
__device__ __forceinline__ float wave_max(float v) {
#pragma unroll
    for (int o = 1; o < 64; o <<= 1) v = fmaxf(v, __shfl_xor(v, o));
    return v;
}
__device__ __forceinline__ float dot8(v4u a, v4u b, float s) {
    s = fmaf(bflo(a.x), bflo(b.x), s); s = fmaf(bfhi(a.x), bfhi(b.x), s);
    s = fmaf(bflo(a.y), bflo(b.y), s); s = fmaf(bfhi(a.y), bfhi(b.y), s);
    s = fmaf(bflo(a.z), bflo(b.z), s); s = fmaf(bfhi(a.z), bfhi(b.z), s);
    s = fmaf(bflo(a.w), bflo(b.w), s); s = fmaf(bfhi(a.w), bfhi(b.w), s);
    return s;
}

__device__ __forceinline__ int phys_col(int L) { if (L >= 1024) return L; const int hd = L >> 7, l = L & 127; return hd * 128 + (l < 64 ? 2 * l : 2 * (l - 64) + 1); }
template <bool PERMQK>
__device__ __forceinline__ void p0_transpose_item(const float* W, int K, int N, bf16* WT, LAS float* scr, int item, int lane) {
    const int nblk = N / 32, kb = item / nblk, nb = item % nblk, k0 = 64 * kb, n0 = 32 * nb;
#pragma unroll 8
    for (int i = 0; i < 32; ++i) { const int kk = 2 * i + (lane >> 5); scr[kk * 33 + (lane & 31)] = W[(size_t)(k0 + kk) * N + n0 + (lane & 31)]; }
    LDS_WAIT(); asm volatile("" ::: "memory");
    const int c = lane & 7;
#pragma unroll
    for (int j = 0; j < 4; ++j) { const int n = (lane >> 3) + 8 * j; const LAS float* s = scr + (8 * c) * 33 + n;
        v4u o; o.x = pk2(s[0 * 33], s[1 * 33]); o.y = pk2(s[2 * 33], s[3 * 33]); o.z = pk2(s[4 * 33], s[5 * 33]); o.w = pk2(s[6 * 33], s[7 * 33]);
        const int orow = PERMQK ? phys_col(n0 + n) : (n0 + n);
        *(GAS v4u*)(WT + (size_t)orow * K + k0 + 8 * c) = o; }
    LDS_WAIT(); asm volatile("" ::: "memory");
}
__device__ __forceinline__ void cvt_bf16_stream(const float* src, bf16* dst, size_t n4, int gt, int ngt) {
    for (size_t i = gt; i < n4; i += ngt) { const f32x4 v = ((const GAS f32x4*)src)[i]; typedef unsigned u2 __attribute__((ext_vector_type(2))); u2 o; o.x = pk2(v.x, v.y); o.y = pk2(v.z, v.w); ((GAS u2*)dst)[i] = o; }
}
__device__ __forceinline__ void p0_prologue(Frame& F) {
    LAS float* scr = (LAS float*)(F.lds + RING_OFF + F.wave * 16384);
    const int gw = F.vcu * NWAVES + F.wave, NGW = F.G * NWAVES;
    const int gt = (int)blockIdx.x * (NWAVES * 64) + F.tid, ngt = F.G * NWAVES * 64;
    constexpr int I_IN = (D / 64) * (NPROJ / 32), I_OUT = (D / 64) * (D / 32), I_Q = (D / 64) * (NQ / 32);
    constexpr int NITEMS = I_IN + I_OUT + I_Q;
    for (int it = gw; it < NITEMS; it += NGW) {
        int r = it;
        if (r < I_IN) { p0_transpose_item<true>(F.in[1], D, NPROJ, (bf16*)(F.ws + WS_WIN), scr, r, F.lane); continue; } r -= I_IN;
        if (r < I_OUT) { p0_transpose_item<false>(F.in[9], D, D, (bf16*)(F.ws + WS_WOUT), scr, r, F.lane); continue; } r -= I_OUT;
        p0_transpose_item<false>(F.in[12], D, NQ, (bf16*)(F.ws + WS_WQ), scr, r, F.lane);
    }
    cvt_bf16_stream(F.in[13], (bf16*)(F.ws + WS_SK), (size_t)8 * 2 * 128 * 128 / 4, gt, ngt);
    cvt_bf16_stream(F.in[14], (bf16*)(F.ws + WS_PU), (size_t)NEXP * D / 4, gt, ngt);
    cvt_bf16_stream(F.in[15], (bf16*)(F.ws + WS_PV), (size_t)NEXP * D / 4, gt, ngt);
    cvt_bf16_stream(F.in[0], (bf16*)(F.ws + WS_XB), (size_t)M * D / 4, gt, ngt);
    float* rope = (float*)(F.ws + WS_ROPE);
    for (int e = gt; e < SEQ * 64; e += ngt) {
        const int pos = e >> 6, i = e & 63;
        const float inv = exp2f(-(float)i * (13.287712379549449f / 64.f));
        const float ang = (float)pos * inv;
        const float k = rintf(ang * 0.15915494309189535f);
        float r = fmaf(-k, 6.2831854820251465f, ang); r = fmaf(-k, -1.7484555314695172e-07f, r);
        rope[2 * e] = cosf(r); rope[2 * e + 1] = sinf(r);
    }
}

__device__ __forceinline__ void p2_retention_naive(Frame& F) {
    const bf16* PROJ = (const bf16*)(F.ws + WS_PROJ); bf16* MIX = (bf16*)(F.ws + WS_MIX);
    LAS float* S = (LAS float*)(F.lds + RING_OFF); LAS float* ST = S + 128 * 128;
    const float* gn_g = F.in[2]; const float* gn_b = F.in[3];
    const int t = F.tid;
    for (int u = (int)blockIdx.x; u < BATCH * 4; u += F.G) {
        const int b = u >> 2, h = u & 3;
        const float gam = 1.f - exp2f(-5.f - (float)h); const float l2g = log2f(gam);
        for (int e = t; e < 128 * 128; e += NWAVES * 64) ST[e] = 0.f;
        __syncthreads();
        for (int c = 0; c < 16; ++c) {
            const size_t rb = (size_t)b * SEQ + c * 128;
            {
                const int i = t >> 2, jq = t & 3;
                const GAS v4u* qp = (const GAS v4u*)(PROJ + (rb + i) * NPROJ + C_RQ + h * 128);
#pragma unroll 1
                for (int jj = 0; jj < 32; ++jj) { const int j = jq * 32 + jj; float s = 0.f;
                    if (j <= i) { const GAS v4u* kp = (const GAS v4u*)(PROJ + (rb + j) * NPROJ + C_RK + h * 128);
#pragma unroll
                        for (int d = 0; d < 16; ++d) s = dot8(qp[d], kp[d], s);
                        s *= exp2f((float)(i - j) * l2g); }
                    S[i * 128 + j] = s; }
            }
            __syncthreads();
            {
                const int i = t >> 2, vq = t & 3;
                float o[32];
#pragma unroll
                for (int v = 0; v < 32; ++v) o[v] = 0.f;
#pragma unroll 2
                for (int j = 0; j <= i; ++j) { const float sij = S[i * 128 + j];
                    const GAS v4u* vp = (const GAS v4u*)(PROJ + (rb + j) * NPROJ + C_RV + h * 128 + vq * 32);
#pragma unroll
                    for (int q4 = 0; q4 < 4; ++q4) { const v4u w = vp[q4];
                        o[q4 * 8 + 0] = fmaf(sij, bflo(w.x), o[q4 * 8 + 0]); o[q4 * 8 + 1] = fmaf(sij, bfhi(w.x), o[q4 * 8 + 1]);
                        o[q4 * 8 + 2] = fmaf(sij, bflo(w.y), o[q4 * 8 + 2]); o[q4 * 8 + 3] = fmaf(sij, bfhi(w.y), o[q4 * 8 + 3]);
                        o[q4 * 8 + 4] = fmaf(sij, bflo(w.z), o[q4 * 8 + 4]); o[q4 * 8 + 5] = fmaf(sij, bfhi(w.z), o[q4 * 8 + 5]);
                        o[q4 * 8 + 6] = fmaf(sij, bflo(w.w), o[q4 * 8 + 6]); o[q4 * 8 + 7] = fmaf(sij, bfhi(w.w), o[q4 * 8 + 7]); } }
                const float dq = exp2f((float)(i + 1) * l2g);
                const GAS unsigned short* qrow = (const GAS unsigned short*)(PROJ + (rb + i) * NPROJ + C_RQ + h * 128);
#pragma unroll 2
                for (int d = 0; d < 128; ++d) { const float qd = bf2f(qrow[d]) * dq; const LAS float* sp = ST + d * 128 + vq * 32;
#pragma unroll
                    for (int v = 0; v < 32; ++v) o[v] = fmaf(qd, sp[v], o[v]); }
                float sm = 0.f;
#pragma unroll
                for (int v = 0; v < 32; ++v) sm += o[v];
                sm += __shfl_xor(sm, 1); sm += __shfl_xor(sm, 2);
                const float mu = sm * (1.f / 128.f); float q2 = 0.f;
#pragma unroll
                for (int v = 0; v < 32; ++v) { const float dlt = o[v] - mu; q2 += dlt * dlt; }
                q2 += __shfl_xor(q2, 1); q2 += __shfl_xor(q2, 2);
                const float rstd = 1.f / sqrtf(q2 * (1.f / 128.f) + LN_EPS);
                const GAS unsigned short* grow = (const GAS unsigned short*)(PROJ + (rb + i) * NPROJ + C_RG + h * 128 + vq * 32);
                GAS unsigned short* mrow = (GAS unsigned short*)(MIX + (rb + i) * D + h * 128 + vq * 32);
#pragma unroll
                for (int v = 0; v < 32; ++v) { const int ch = h * 128 + vq * 32 + v; const float r = bf2f(grow[v]) * ((o[v] - mu) * rstd * gn_g[ch] + gn_b[ch]); mrow[v] = (unsigned short)f2bf(r); }
            }
            __syncthreads();
            {
                const int d = t >> 2, vq = t & 3;
                float a[32];
                const float dc = exp2f(128.f * l2g);
                LAS float* sp = ST + d * 128 + vq * 32;
#pragma unroll
                for (int v = 0; v < 32; ++v) a[v] = sp[v] * dc;
#pragma unroll 2
                for (int j = 0; j < 128; ++j) { const float kd = bf2f(((const GAS unsigned short*)PROJ)[(rb + j) * NPROJ + C_RK + h * 128 + d]) * exp2f((float)(127 - j) * l2g);
                    const GAS v4u* vp = (const GAS v4u*)(PROJ + (rb + j) * NPROJ + C_RV + h * 128 + vq * 32);
#pragma unroll
                    for (int q4 = 0; q4 < 4; ++q4) { const v4u w = vp[q4];
                        a[q4 * 8 + 0] = fmaf(kd, bflo(w.x), a[q4 * 8 + 0]); a[q4 * 8 + 1] = fmaf(kd, bfhi(w.x), a[q4 * 8 + 1]);
                        a[q4 * 8 + 2] = fmaf(kd, bflo(w.y), a[q4 * 8 + 2]); a[q4 * 8 + 3] = fmaf(kd, bfhi(w.y), a[q4 * 8 + 3]);
                        a[q4 * 8 + 4] = fmaf(kd, bflo(w.z), a[q4 * 8 + 4]); a[q4 * 8 + 5] = fmaf(kd, bfhi(w.z), a[q4 * 8 + 5]);
                        a[q4 * 8 + 6] = fmaf(kd, bflo(w.w), a[q4 * 8 + 6]); a[q4 * 8 + 7] = fmaf(kd, bfhi(w.w), a[q4 * 8 + 7]); } }
#pragma unroll
                for (int v = 0; v < 32; ++v) sp[v] = a[v];
            }
            __syncthreads();
        }
    }
}

__device__ __forceinline__ float diff_lambda(Frame& F) {
    const float a = wave_sum(F.in[4][F.lane] * F.in[5][F.lane]); const float b = wave_sum(F.in[6][F.lane] * F.in[7][F.lane]);
    return expf(a) - expf(b) + LAMBDA_INIT;
}
__device__ __forceinline__ void p2_diffattn_naive(Frame& F) {
    const bf16* PROJ = (const bf16*)(F.ws + WS_PROJ); bf16* MIX = (bf16*)(F.ws + WS_MIX);
    LAS float* sb = (LAS float*)(F.lds + RING_OFF) + F.wave * 2048;
    const float lam = diff_lambda(F);
    const float* sg = F.in[8];
    const int gw = (int)blockIdx.x * NWAVES + F.wave, NGW = F.G * NWAVES;
    const int lane = F.lane;
    for (int task = gw; task < BATCH * 4 * SEQ; task += NGW) {
        const int i = task >> 6, bh = task & 63, b = bh >> 2, h = bh & 3;
        const size_t rb = (size_t)b * SEQ;
        float oc[2][2];
#pragma unroll
        for (int c = 0; c < 2; ++c) {
            const GAS v4u* qp = (const GAS v4u*)(PROJ + (rb + i) * NPROJ + C_DQ + h * 128 + c * 64);
            v4u q[8];
#pragma unroll
            for (int d = 0; d < 8; ++d) q[d] = qp[d];
            float mx = -INFINITY;
#pragma unroll 1
            for (int j0 = 0; j0 <= i; j0 += 64) { const int j = j0 + lane;
                if (j <= i) { const GAS v4u* kp = (const GAS v4u*)(PROJ + (rb + j) * NPROJ + C_DK + h * 128 + c * 64); float s = 0.f;
#pragma unroll
                    for (int d = 0; d < 8; ++d) s = dot8(q[d], kp[d], s);
                    sb[j] = s; mx = fmaxf(mx, s); } }
            mx = wave_max(mx);
            float l = 0.f;
            for (int j0 = 0; j0 <= i; j0 += 64) { const int j = j0 + lane; if (j <= i) { const float p = exp2f(sb[j] - mx); sb[j] = p; l += p; } }
            l = wave_sum(l);
            LDS_WAIT(); asm volatile("" ::: "memory");
            float o0 = 0.f, o1 = 0.f;
            const GAS unsigned* vp = (const GAS unsigned*)(PROJ + rb * NPROJ + C_DV + h * 128) + lane;
#pragma unroll 4
            for (int j = 0; j <= i; ++j) { const float p = sb[j]; const unsigned w = vp[(size_t)j * (NPROJ / 2)]; o0 = fmaf(p, bflo(w), o0); o1 = fmaf(p, bfhi(w), o1); }
            const float rl = 1.f / l; oc[c][0] = o0 * rl; oc[c][1] = o1 * rl;
            LDS_WAIT(); asm volatile("" ::: "memory");
        }
        const float d0 = oc[0][0] - lam * oc[1][0], d1 = oc[0][1] - lam * oc[1][1];
        const float ms = wave_sum(d0 * d0 + d1 * d1) * (1.f / 128.f);
        const float rs = (1.f - LAMBDA_INIT) / sqrtf(ms + LN_EPS);
        const int ch = h * 128 + 2 * lane;
        ((GAS unsigned*)(MIX + (rb + i) * D + 512 + h * 128))[lane] = pk2(d0 * rs * sg[ch], d1 * rs * sg[ch + 1]);
    }
}


struct DiffUnit { int b, h, qb, c, hf; };
struct DiffOrder {
    int pu;
    __device__ __forceinline__ bool next(int i, DiffUnit& u) const { if (i >= 8) return false; const int bh = pu >> 2, s = pu & 3; u.b = bh >> 2; u.h = bh & 3; u.qb = (i >> 2) ? s : 7 - s; u.c = (i >> 1) & 1; u.hf = i & 1; return true; }
};
__device__ __forceinline__ void diff_combine(Frame& F, const DiffUnit& u) {
    VM_WAIT();
    const float lam = diff_lambda(F);
    const float* sg = F.in[8] + u.h * 128 + 2 * F.lane;
    const float g0 = sg[0], g1 = sg[1];
    const size_t row0 = (size_t)u.b * SEQ + u.qb * 256 + F.wave * 32;
    const GAS unsigned* op = (const GAS unsigned*)((const bf16*)(F.ws + WS_DOUT) + row0 * 1024 + u.h * 256) + F.lane;
    GAS unsigned* mp = (GAS unsigned*)((bf16*)(F.ws + WS_MIX) + row0 * D + 512 + u.h * 128) + F.lane;
#pragma unroll 4
    for (int r = 0; r < 32; ++r) {
        const unsigned w1 = op[r * 512], w2 = op[r * 512 + 64];
        const float d0 = bflo(w1) - lam * bflo(w2), d1 = bfhi(w1) - lam * bfhi(w2);
        const float ms = wave_sum(d0 * d0 + d1 * d1) * (1.f / 128.f);
        const float rs = (1.f - LAMBDA_INIT) / sqrtf(ms + LN_EPS);
        mp[r * 512] = pk2(d0 * rs * g0, d1 * rs * g1);
    }
}
template <class Sched> __device__ __forceinline__ void diff_phase(Frame& F, char* lds, const attn_body::bf16* P, attn_body::bf16* O, const Sched& S) {
    DiffUnit u;
    for (int i = 0; S.next(i, u); ++i) { const attn_body::bf16* Ph = P + u.h * 128;
        attn_body::attn_unit<8>(u.b, u.qb, Ph + C_DQ + u.c * 64, Ph + C_DK + u.c * 64, Ph + C_DV + u.hf * 64, O + u.h * 256 + u.c * 128 + u.hf * 64, lds);
    }
}
__device__ __forceinline__ void p2_diffattn(Frame& F, char* lds_generic) {
    const DiffOrder S{F.vcu};
    diff_phase<DiffOrder>(F, lds_generic, (const attn_body::bf16*)(F.ws + WS_PROJ), (attn_body::bf16*)(F.ws + WS_DOUT), S);
    DiffUnit u;
    S.next(3, u); diff_combine(F, u);
    S.next(7, u); diff_combine(F, u);
}
__device__ __forceinline__ void p3_ln1_rows(Frame& F) {
    const float* Y = F.out; bf16* X1 = (bf16*)(F.ws + WS_X1); const float* g = F.in[10]; const float* bb = F.in[11];
    const int gw = (int)blockIdx.x * NWAVES + F.wave, NGW = F.G * NWAVES;
    for (int m = gw; m < M; m += NGW) {
        const GAS f32x4* xr = (const GAS f32x4*)(Y + (size_t)m * D) + F.lane;
        f32x4 v[4]; float s = 0.f;
#pragma unroll
        for (int j = 0; j < 4; ++j) { v[j] = xr[64 * j]; s += (v[j].x + v[j].y) + (v[j].z + v[j].w); }
        const float mean = wave_sum(s) * (1.f / D); float s2 = 0.f;
#pragma unroll
        for (int j = 0; j < 4; ++j) { v[j] = v[j] - mean; s2 += (v[j].x * v[j].x + v[j].y * v[j].y) + (v[j].z * v[j].z + v[j].w * v[j].w); }
        const float rstd = 1.f / sqrtf(wave_sum(s2) * (1.f / D) + LN_EPS);
        GAS unsigned long long* o8 = (GAS unsigned long long*)(X1 + (size_t)m * D) + F.lane;
#pragma unroll
        for (int j = 0; j < 4; ++j) { const f32x4 gg = ((const GAS f32x4*)g)[F.lane + 64 * j], bv = ((const GAS f32x4*)bb)[F.lane + 64 * j]; const f32x4 r = v[j] * rstd * gg + bv;
            o8[64 * j] = (unsigned long long)pk2(r.x, r.y) | ((unsigned long long)pk2(r.z, r.w) << 32); }
    }
}

__device__ __forceinline__ void argmax_step(float& v, int& i) {
#pragma unroll
    for (int o = 1; o < 64; o <<= 1) { const float ov = __shfl_xor(v, o); const int oi = __shfl_xor(i, o); if (ov > v || (ov == v && oi < i)) { v = ov; i = oi; } }
}
__device__ __forceinline__ void p5_topk_naive(Frame& F) {
    const bf16* QP = (const bf16*)(F.ws + WS_QP); const bf16* SK = (const bf16*)(F.ws + WS_SK);
    int* IDX = (int*)(F.ws + WS_IDX); float* GATE = (float*)(F.ws + WS_GATE);
    const int gw = (int)blockIdx.x * NWAVES + F.wave, NGW = F.G * NWAVES; const int lane = F.lane;
    for (int task = gw; task < M * 8; task += NGW) {
        const int t = task >> 3, h = task & 7;
        float ts[2]; int ti[2];
#pragma unroll
        for (int c = 0; c < 2; ++c) {
            const GAS v4u* qp = (const GAS v4u*)(QP + (size_t)t * NQ + h * 256 + c * 128);
            const GAS v4u* k0p = (const GAS v4u*)(SK + ((size_t)(h * 2 + c) * 128 + lane) * 128);
            const GAS v4u* k1p = (const GAS v4u*)(SK + ((size_t)(h * 2 + c) * 128 + lane + 64) * 128);
            float s0 = 0.f, s1 = 0.f;
#pragma unroll
            for (int d = 0; d < 16; ++d) { const v4u q = qp[d]; s0 = dot8(q, k0p[d], s0); s1 = dot8(q, k1p[d], s1); }
            float mys = 0.f; int myi = 0;
            for (int r = 0; r < 16; ++r) {
                float v = fmaxf(s0, s1); int ix = (s0 >= s1) ? lane : lane + 64;
                argmax_step(v, ix);
                if (lane == r) { mys = v; myi = ix; }
                if ((ix & 63) == lane) { if (ix < 64) s0 = -INFINITY; else s1 = -INFINITY; }
            }
            ts[c] = mys; ti[c] = myi;
        }
        float cs[4]; int ci[4];
#pragma unroll
        for (int q = 0; q < 4; ++q) { const int a = (lane >> 4) + 4 * q, bq = lane & 15; cs[q] = __shfl(ts[0], a) + __shfl(ts[1], bq); ci[q] = __shfl(ti[0], a) * 128 + __shfl(ti[1], bq); }
        float bs = 0.f; int be = 0;
        {
            LAS float* bsl = (LAS float*)(F.lds + RING_OFF) + F.wave * 32; LAS int* bel = (LAS int*)(bsl + 16);
            int rk[4] = {0, 0, 0, 0};
            for (int k = 0; k < 64; ++k) {
#pragma unroll
                for (int qq = 0; qq < 4; ++qq) { const float av = __shfl(cs[qq], k); const int an = k + 64 * qq;
#pragma unroll
                    for (int q = 0; q < 4; ++q) { const int n = lane + 64 * q; rk[q] += (av > cs[q] || (av == cs[q] && an < n)) ? 1 : 0; } } }
#pragma unroll
            for (int q = 0; q < 4; ++q) if (rk[q] < 16) { bsl[rk[q]] = cs[q]; bel[rk[q]] = ci[q]; }
            LDS_WAIT(); asm volatile("" ::: "memory");
            bs = bsl[lane & 15]; be = bel[lane & 15];
            LDS_WAIT(); asm volatile("" ::: "memory");
        }
        const float mx = __shfl(bs, 0);
        float ex = expf(bs - mx); float sm = ex;
        sm += __shfl_xor(sm, 1); sm += __shfl_xor(sm, 2); sm += __shfl_xor(sm, 4); sm += __shfl_xor(sm, 8);
        if (lane < 16) { IDX[(size_t)t * NSEL + h * 16 + lane] = be; GATE[(size_t)t * NSEL + h * 16 + lane] = ex / sm; }
    }
}

__device__ __forceinline__ void unpack8(v4u w, float* f) { f[0] = bflo(w.x); f[1] = bfhi(w.x); f[2] = bflo(w.y); f[3] = bfhi(w.y); f[4] = bflo(w.z); f[5] = bfhi(w.z); f[6] = bflo(w.w); f[7] = bfhi(w.w); }
__device__ __forceinline__ void p6_experts_naive(Frame& F) {
    const bf16* X1 = (const bf16*)(F.ws + WS_X1); const bf16* PU = (const bf16*)(F.ws + WS_PU); const bf16* PV = (const bf16*)(F.ws + WS_PV);
    const int* IDX = (const int*)(F.ws + WS_IDX); const float* GATE = (const float*)(F.ws + WS_GATE);
    const float* g2 = F.in[16]; const float* b2 = F.in[17];
    const int gw = (int)blockIdx.x * NWAVES + F.wave, NGW = F.G * NWAVES; const int lane = F.lane;
    for (int t = gw; t < M; t += NGW) {
        float x[16], acc[16];
        { const GAS v4u* xp = (const GAS v4u*)(X1 + (size_t)t * D); unpack8(xp[lane], x); unpack8(xp[64 + lane], x + 8); }
#pragma unroll
        for (int k = 0; k < 16; ++k) acc[k] = 0.f;
#pragma unroll 2
        for (int e = 0; e < NSEL; ++e) {
            const int idx = IDX[(size_t)t * NSEL + e]; const float gt = GATE[(size_t)t * NSEL + e];
            const GAS v4u* up = (const GAS v4u*)(PU + (size_t)idx * D); const GAS v4u* vp = (const GAS v4u*)(PV + (size_t)idx * D);
            const v4u u0 = up[lane], u1 = up[64 + lane], v0 = vp[lane], v1 = vp[64 + lane];
            float uf[16]; unpack8(u0, uf); unpack8(u1, uf + 8);
            float s = 0.f;
#pragma unroll
            for (int k = 0; k < 16; ++k) s = fmaf(x[k], uf[k], s);
            s = wave_sum(s);
            const float w = gt * 0.5f * s * (1.f + erff(s * 0.7071067811865476f));
            float vf[16]; unpack8(v0, vf); unpack8(v1, vf + 8);
#pragma unroll
            for (int k = 0; k < 16; ++k) acc[k] = fmaf(w, vf[k], acc[k]);
        }
        float sm = 0.f;
#pragma unroll
        for (int k = 0; k < 16; ++k) { acc[k] = fmaf(ALPHA, x[k], acc[k]); sm += acc[k]; }
        const float mean = wave_sum(sm) * (1.f / D); float q2 = 0.f;
#pragma unroll
        for (int k = 0; k < 16; ++k) { acc[k] -= mean; q2 += acc[k] * acc[k]; }
        const float rstd = 1.f / sqrtf(wave_sum(q2) * (1.f / D) + LN_EPS);
        GAS f32x4* op = (GAS f32x4*)(F.out + (size_t)t * D);
#pragma unroll
        for (int hf = 0; hf < 2; ++hf)
#pragma unroll
            for (int q4 = 0; q4 < 2; ++q4) { const int c0 = hf * 512 + lane * 8 + q4 * 4; const f32x4 gg = *(const GAS f32x4*)(g2 + c0), bv = *(const GAS f32x4*)(b2 + c0);
                f32x4 r; r.x = acc[hf * 8 + q4 * 4 + 0] * rstd * gg.x + bv.x; r.y = acc[hf * 8 + q4 * 4 + 1] * rstd * gg.y + bv.y; r.z = acc[hf * 8 + q4 * 4 + 2] * rstd * gg.z + bv.z; r.w = acc[hf * 8 + q4 * 4 + 3] * rstd * gg.w + bv.w;
                op[c0 / 4] = r; }
    }
}


typedef __bf16 bf16x2_t __attribute__((ext_vector_type(2)));
__device__ __forceinline__ float dot2bf(unsigned a, unsigned b, float c) { return __builtin_amdgcn_fdot2_f32_bf16(__builtin_bit_cast(bf16x2_t, a), __builtin_bit_cast(bf16x2_t, b), c, false); }
__device__ __forceinline__ float dot8p(v4u a, v4u b, float s) { s = dot2bf(a.x, b.x, s); s = dot2bf(a.y, b.y, s); s = dot2bf(a.z, b.z, s); return dot2bf(a.w, b.w, s); }
__device__ __forceinline__ float gelu_erf(float v) {
    const float av = fabsf(v), t = __builtin_amdgcn_rcpf(fmaf(av, 0.2316418882f, 1.0f));
    float q = fmaf(t, 0.5307027145f, -0.7265760135f); q = fmaf(q, t, 0.7107068705f); q = fmaf(q, t, -0.142248368f); q = fmaf(q, t, 0.127414796f); q = q * t;
    const float e = __builtin_amdgcn_exp2f(v * v * -0.72134752044f);
    const float m = v * (q * e);
    return v < 0.f ? m : v - m;
}
#define ACC8(A, W, S, O) do { A[O + 0] = fmaf(S, bflo(W.x), A[O + 0]); A[O + 1] = fmaf(S, bfhi(W.x), A[O + 1]); A[O + 2] = fmaf(S, bflo(W.y), A[O + 2]); A[O + 3] = fmaf(S, bfhi(W.y), A[O + 3]); \
                               A[O + 4] = fmaf(S, bflo(W.z), A[O + 4]); A[O + 5] = fmaf(S, bfhi(W.z), A[O + 5]); A[O + 6] = fmaf(S, bflo(W.w), A[O + 6]); A[O + 7] = fmaf(S, bfhi(W.w), A[O + 7]); } while (0)
__device__ __forceinline__ void p6_experts(Frame& F) {
    const bf16* X1 = (const bf16*)(F.ws + WS_X1); const bf16* PU = (const bf16*)(F.ws + WS_PU); const bf16* PV = (const bf16*)(F.ws + WS_PV);
    const int* IDX = (const int*)(F.ws + WS_IDX); const float* GATE = (const float*)(F.ws + WS_GATE);
    const float* g2 = F.in[16]; const float* b2 = F.in[17];
    const int gw = (int)blockIdx.x * NWAVES + F.wave, NGW = F.G * NWAVES;
    const int e_of_lane = (F.lane >> 3) & 7; const bool h5 = F.lane >= 32, h4 = (F.lane >> 4) & 1, h3 = (F.lane >> 3) & 1;
#pragma unroll 1
    for (int t = gw; t < M; t += NGW) {
        int lane = F.lane; asm volatile("" : "+v"(lane));
        const GAS v4u* xp = (const GAS v4u*)(X1 + (size_t)t * D); const v4u xa = xp[lane], xb = xp[64 + lane];
        const int ilo = IDX[(size_t)t * NSEL + lane], ihi = IDX[(size_t)t * NSEL + 64 + lane];
        const float glo = GATE[(size_t)t * NSEL + lane], ghi = GATE[(size_t)t * NSEL + 64 + lane];
        float acc[16];
#pragma unroll
        for (int k = 0; k < 16; ++k) acc[k] = 0.f;
        v4u ua[8], ub[8], va[8], vb[8];
#pragma unroll
        for (int k = 0; k < 8; ++k) { const int idx = __builtin_amdgcn_readlane(ilo, k); const GAS v4u* up = (const GAS v4u*)(PU + (size_t)idx * D); ua[k] = up[lane]; ub[k] = up[64 + lane];
            const GAS v4u* vp = (const GAS v4u*)(PV + (size_t)idx * D); va[k] = vp[lane]; vb[k] = vp[64 + lane]; }
#pragma unroll 1
        for (int bb = 0; bb < 16; ++bb) {
            float s[8];
#pragma unroll
            for (int k = 0; k < 8; ++k) { s[k] = dot8p(xb, ub[k], dot8p(xa, ua[k], 0.f)); __builtin_amdgcn_sched_barrier(0); }
            const int nb = bb + 1; const int isrc_n = nb < 8 ? ilo : ihi;
            if (nb < 16) {
#pragma unroll
                for (int k = 0; k < 8; ++k) { const int idx = __builtin_amdgcn_readlane(isrc_n, (nb & 7) * 8 + k); const GAS v4u* up = (const GAS v4u*)(PU + (size_t)idx * D); ua[k] = up[lane]; ub[k] = up[64 + lane]; }
            }
            float r4[4], r2[2], z;
#pragma unroll
            for (int i = 0; i < 4; ++i) { const float send = h5 ? s[i] : s[i + 4], keep = h5 ? s[i + 4] : s[i]; r4[i] = keep + __shfl_xor(send, 32); }
#pragma unroll
            for (int i = 0; i < 2; ++i) { const float send = h4 ? r4[i] : r4[i + 2], keep = h4 ? r4[i + 2] : r4[i]; r2[i] = keep + __shfl_xor(send, 16); }
            { const float send = h3 ? r2[0] : r2[1], keep = h3 ? r2[1] : r2[0]; z = keep + __shfl_xor(send, 8); }
            z += __shfl_xor(z, 4); z += __shfl_xor(z, 2); z += __shfl_xor(z, 1);
            const float gsrc = bb < 8 ? glo : ghi;
            const float w = __shfl(gsrc, (bb & 7) * 8 + e_of_lane) * gelu_erf(z);
#pragma unroll
            for (int k = 0; k < 8; ++k) { const float wk = __builtin_bit_cast(float, __builtin_amdgcn_readlane(__builtin_bit_cast(int, w), 8 * k)); ACC8(acc, va[k], wk, 0); ACC8(acc, vb[k], wk, 8); __builtin_amdgcn_sched_barrier(0); }
            if (nb < 16) {
#pragma unroll
                for (int k = 0; k < 8; ++k) { const int idx = __builtin_amdgcn_readlane(isrc_n, (nb & 7) * 8 + k); const GAS v4u* vp = (const GAS v4u*)(PV + (size_t)idx * D); va[k] = vp[lane]; vb[k] = vp[64 + lane]; }
            }
        }
        float x[16]; unpack8(xa, x); unpack8(xb, x + 8);
        float sm = 0.f;
#pragma unroll
        for (int k = 0; k < 16; ++k) { acc[k] = fmaf(ALPHA, x[k], acc[k]); sm += acc[k]; }
        const float mean = wave_sum(sm) * (1.f / D); float q2 = 0.f;
#pragma unroll
        for (int k = 0; k < 16; ++k) { acc[k] -= mean; q2 += acc[k] * acc[k]; }
        const float rstd = 1.f / sqrtf(wave_sum(q2) * (1.f / D) + LN_EPS);
        GAS f32x4* op = (GAS f32x4*)(F.out + (size_t)t * D);
#pragma unroll
        for (int hf = 0; hf < 2; ++hf)
#pragma unroll
            for (int q4 = 0; q4 < 2; ++q4) { const int c0 = hf * 512 + lane * 8 + q4 * 4; const f32x4 gg = *(const GAS f32x4*)(g2 + c0), bv = *(const GAS f32x4*)(b2 + c0);
                f32x4 r; r.x = acc[hf * 8 + q4 * 4 + 0] * rstd * gg.x + bv.x; r.y = acc[hf * 8 + q4 * 4 + 1] * rstd * gg.y + bv.y; r.z = acc[hf * 8 + q4 * 4 + 2] * rstd * gg.z + bv.z; r.w = acc[hf * 8 + q4 * 4 + 3] * rstd * gg.w + bv.w;
                op[c0 / 4] = r; }
    }
}
#ifndef MK_N_LAUNCHES
#define MK_N_LAUNCHES 1
#endif
constexpr int N_PHASES = 8;
struct Args { const float* in[18]; float* out; unsigned char* ws; int ph_lo, ph_hi, li, pad; };
__global__ void __launch_bounds__(NWAVES * 64, 2) hymba_fwd(Args args) {
    extern __shared__ __attribute__((aligned(16))) unsigned char lds[];
    Frame F;
    F.lds = (LAS unsigned char*)lds;
    F.MISC = (volatile LAS unsigned*)(F.lds + MISC_OFF);
    F.tid = threadIdx.x; F.lane = F.tid & 63; F.wave = __builtin_amdgcn_readfirstlane(F.tid >> 6);
    F.G = gridDim.x; { const int bx = blockIdx.x; F.vcu = (F.G % 8 == 0) ? (bx % 8) * (F.G / 8) + bx / 8 : bx; }
    unsigned char* ws = args.ws; F.ws = ws; F.out = args.out;
    F.ctl = (gu32*)(ws + WS_CTL);
    F.in = args.in;
    for (int u = F.tid; u < (LDS_BYTES - LDSCTL_OFF) / 4; u += NWAVES * 64) ((LAS unsigned*)(F.lds + LDSCTL_OFF))[u] = 0u;
    __syncthreads();
    XcdBarrier bar; bar.bar = (unsigned*)(F.ctl + CW_BAR) + args.li * XCD_BAR_WORDS; bar.x = 0; bar.st = nullptr;
    if (MK_N_LAUNCHES != N_PHASES) bar = xcd_barrier_post((unsigned*)(F.ctl + CW_BAR) + args.li * XCD_BAR_WORDS, F.MISC + 8);
    const int lo = args.ph_lo, hi = args.ph_hi;
#ifndef PHASE_MASK
#define PHASE_MASK 0xffff
#endif
#define IN(k) (((PHASE_MASK >> (k)) & 1) && lo <= (k) && (k) < hi)
#define BOTH(k) (IN(k) && IN((k) + 1))
#define GRID_BAR() xcd_barrier(bar)

    if (IN(0)) { p0_prologue(F); if (BOTH(0)) GRID_BAR(); }
    if (IN(1)) {
        pg8::Gemm g{(const bf16*)(ws + WS_XB), (const bf16*)(ws + WS_WIN), M, NPROJ, D}; pg8::StaticOrder S; S.init(M, NPROJ, F.G, (int)blockIdx.x);
        pg8::EpiProj E{(bf16*)(ws + WS_PROJ), NPROJ, (const float*)(ws + WS_ROPE), KSCALE, QSCALE};
        pg8::gemm_phase<pg8::EpiProj, pg8::StaticOrder, PG8_ALIGN, PG8_SP2>(F.lds + RING_OFF, g, S, E);
        if (BOTH(1)) GRID_BAR();
    }
    if (IN(2)) { p2_retention_naive(F); __syncthreads(); p2_diffattn(F, (char*)lds + RING_OFF); if (BOTH(2)) GRID_BAR(); }
    if (IN(3)) {
        pg8::Gemm g{(const bf16*)(ws + WS_MIX), (const bf16*)(ws + WS_WOUT), M, D, D}; pg8::StaticOrder S; S.init(M, D, F.G, (int)blockIdx.x);
        pg8::EpiResF32 E{F.in[0], F.out, D, ALPHA};
        pg8::gemm_phase<pg8::EpiResF32, pg8::StaticOrder, PG8_ALIGN, PG8_SP2>(F.lds + RING_OFF, g, S, E);
        if (BOTH(3)) GRID_BAR();
    }
    if (IN(4)) { p3_ln1_rows(F); if (BOTH(4)) GRID_BAR(); }
    if (IN(5)) {
        pg8::Gemm g{(const bf16*)(ws + WS_X1), (const bf16*)(ws + WS_WQ), M, NQ, D}; pg8::StaticOrder S; S.init(M, NQ, F.G, (int)blockIdx.x);
        pg8::EpiPlainBf16 E{(bf16*)(ws + WS_QP), NQ};
        pg8::gemm_phase<pg8::EpiPlainBf16, pg8::StaticOrder, PG8_ALIGN, PG8_SP2>(F.lds + RING_OFF, g, S, E);
        if (BOTH(5)) GRID_BAR();
    }
    if (IN(6)) { p5_topk_naive(F); if (BOTH(6)) GRID_BAR(); }
    if (IN(7)) { p6_experts(F); }
#undef IN
#undef BOTH
}

extern "C" void kernel_launch(void* const* d_in, const int* in_sizes, int n_in, void* d_out, int out_size, void* d_ws, size_t ws_size, hipStream_t stream) {
    static int grid = 0;
    if (grid == 0) {
        if (n_in != 18 || in_sizes[0] != M * D || out_size != M * D || ws_size < WS_END) { fprintf(stderr, "kernel_launch: unexpected shapes / workspace (n_in %d, in0 %d, out %d, ws %zu, need %zu); nothing launched\n", n_in, n_in > 0 ? in_sizes[0] : -1, out_size, ws_size, (size_t)WS_END); grid = -1; return; }
        int dev = 0, cus = 0, per_cu = 0;
        if (hipGetDevice(&dev) != hipSuccess || hipDeviceGetAttribute(&cus, hipDeviceAttributeMultiprocessorCount, dev) != hipSuccess) { fprintf(stderr, "kernel_launch: device query failed\n"); grid = -1; return; }
        if (hipFuncSetAttribute((const void*)hymba_fwd, hipFuncAttributeMaxDynamicSharedMemorySize, LDS_BYTES) != hipSuccess) { fprintf(stderr, "kernel_launch: hipFuncSetAttribute failed\n"); grid = -1; return; }
        if (hipOccupancyMaxActiveBlocksPerMultiprocessor(&per_cu, (const void*)hymba_fwd, NWAVES * 64, LDS_BYTES) != hipSuccess || per_cu < 1)
            fprintf(stderr, "kernel_launch: note: occupancy query reports %d workgroups per CU\n", per_cu);
        (void)hipGetLastError();
        grid = cus;
        if (grid != 256) fprintf(stderr, "kernel_launch: note: %d CUs (tuned for 256)\n", grid);
    }
    if (grid < 0) return;
    if (hipMemsetAsync((char*)d_ws + WS_CTL, 0, CTL_ZERO_BYTES, stream) != hipSuccess) { fprintf(stderr, "kernel_launch: memset failed\n"); return; }
    Args a{};
    for (int i = 0; i < 18; ++i) a.in[i] = (const float*)d_in[i];
    a.out = (float*)d_out; a.ws = (unsigned char*)d_ws;
    constexpr int NL = MK_N_LAUNCHES;
    for (int li = 0; li < NL; ++li) {
        a.ph_lo = (NL == N_PHASES) ? li : (li * N_PHASES) / NL; a.ph_hi = (NL == N_PHASES) ? li + 1 : ((li + 1) * N_PHASES) / NL; a.li = li;
        hipLaunchKernelGGL(hymba_fwd, dim3(grid), dim3(NWAVES * 64), LDS_BYTES, stream, a);
        const hipError_t le = hipPeekAtLastError();
        if (le != hipSuccess) { fprintf(stderr, "kernel_launch: launch %d failed: %s\n", li, hipGetErrorName(le)); break; }
    }
}
```

```cpp
#include <hip/hip_runtime.h>
#include <cstdio>
#include <cstdint>
#include <cmath>
namespace pg8 {
#define PG8_LAS __attribute__((address_space(3)))
typedef unsigned short bf16_t;
typedef short bf16x8 __attribute__((ext_vector_type(8)));
typedef float f32x4 __attribute__((ext_vector_type(4)));
typedef unsigned u32x4 __attribute__((ext_vector_type(4)));
constexpr int BM = 256, BK = 64, HALF = 128, HTB = HALF * BK * 2  , STAGE_BYTES = 8 * HTB, NXCD = 8, WGM = 8;

__host__ __device__ __forceinline__ int lds_byte(int r, int c) { const int st = (r >> 4) * 2 + (c >> 5), rr = r & 15, cc = c & 31, ob = rr * 64 + cc * 2; return st * 1024 + (ob ^ (((ob >> 9) & 1) << 5)); }
__host__ __device__ __forceinline__ void stage_rc(int b, int& R, int& C) { const int st = b / 1024, sb = b % 1024, swz = sb ^ (((sb >> 9) & 1) << 5); R = (st >> 1) * 16 + swz / 64; C = (st & 1) * 32 + (swz % 64) / 2; }
__host__ __device__ __forceinline__ int perm32(int rho) { const int n = rho >> 4, i = rho & 15; return 8 * (i >> 2) + 4 * n + (i & 3); }

struct Unit { int pm, pn; };
struct Gemm { const bf16_t* A; const bf16_t* Bt; int M, N, K; };

struct StaticOrder {
    int nM, nN, nwg, G, c;
    __host__ __device__ void init(int M, int N, int G_, int c_) { nM = M / BM; nN = N / BM; nwg = nM * nN; G = G_; c = c_; }
    __host__ __device__ bool next(int i, Unit& u) const {
        const long L = (long)i * G + c; if (L >= nwg) return false;
        int wgid = (int)L; { const int q = nwg / NXCD, r = nwg % NXCD, xcd = wgid % NXCD, off = wgid / NXCD; wgid = (xcd < r ? xcd * (q + 1) : r * (q + 1) + (xcd - r) * q) + off; }
        const int nig = WGM * nN, gid = wgid / nig, fm = gid * WGM, gsz = (nM - fm) < WGM ? (nM - fm) : WGM;
        u.pm = fm + ((wgid % nig) % gsz); u.pn = (wgid % nig) / gsz; return true;
    }
    __device__ __forceinline__ void a_ready(const Unit&) const {}
    __device__ __forceinline__ void done(const Unit&) const {}
};

__device__ __forceinline__ unsigned cvt_pk_bf16(float lo, float hi) { unsigned r; asm volatile("v_cvt_pk_bf16_f32 %0, %1, %2" : "=v"(r) : "v"(lo), "v"(hi)); return r; }
typedef float f32x2 __attribute__((ext_vector_type(2)));
__device__ __forceinline__ f32x2 gelu_pk(f32x2 v) {
    const f32x2 av = __builtin_elementwise_abs(v), d = av * 0.2316418882f + 1.0f;
    f32x2 t; t.x = __builtin_amdgcn_rcpf(d.x); t.y = __builtin_amdgcn_rcpf(d.y);
    f32x2 q = t * 0.5307027145f + (-0.7265760135f); q = q * t + 0.7107068705f; q = q * t + (-0.142248368f); q = q * t + 0.127414796f; q = q * t;
    const f32x2 s = (v * v) * (-0.72134752044f);
    f32x2 e; e.x = __builtin_amdgcn_exp2f(s.x); e.y = __builtin_amdgcn_exp2f(s.y);
    const f32x2 m = v * (q * e), r = v - m;
    f32x2 o; o.x = v.x < 0.f ? m.x : r.x; o.y = v.y < 0.f ? m.y : r.y; return o;
}

struct EpiProj {
    static constexpr bool PERM = true, AFTER_DRAIN = false;
    bf16_t* O; int ldc; const float* rope; float kscale, qscale;
    __device__ __forceinline__ void operator()(const f32x4 (&acc)[2][2][4][2], const Unit& u, int wr, int wc, int fr, int fq) const {
        const int row0 = u.pm * BM + wr * 64 + fr; const int col0 = u.pn * BM + wc * 32 + 8 * fq;
        const int pn = u.pn;
        const bool rot = pn < 4; const bool gate = (pn == 6 || pn == 7);
        const float sc = (pn == 2 || pn == 3) ? kscale : ((pn == 8 || pn == 9) ? qscale : 1.f);
#pragma unroll
        for (int ai = 0; ai < 2; ++ai)
#pragma unroll
            for (int m = 0; m < 4; ++m) {
                const int row = row0 + ai * HALF + m * 16;
                bf16_t* rowp = O + (size_t)row * ldc + col0;
                f32x4 cs0 = (f32x4){1.f, 0.f, 1.f, 0.f}, cs1 = cs0;
                if (rot) { const float* rp = rope + ((size_t)(row & 2047) * 64 + 16 * wc + 4 * fq) * 2; cs0 = *(const f32x4*)rp; cs1 = *(const f32x4*)(rp + 4); }
#pragma unroll
                for (int bj = 0; bj < 2; ++bj) {
                    f32x4 v0 = acc[ai][bj][m][0], v1 = acc[ai][bj][m][1];
                    if (rot) {
                        f32x4 r0, r1;
                        r0[0] = v0[0] * cs0[0] - v0[1] * cs0[1]; r0[1] = v0[0] * cs0[1] + v0[1] * cs0[0];
                        r0[2] = v0[2] * cs0[2] - v0[3] * cs0[3]; r0[3] = v0[2] * cs0[3] + v0[3] * cs0[2];
                        r1[0] = v1[0] * cs1[0] - v1[1] * cs1[1]; r1[1] = v1[0] * cs1[1] + v1[1] * cs1[0];
                        r1[2] = v1[2] * cs1[2] - v1[3] * cs1[3]; r1[3] = v1[2] * cs1[3] + v1[3] * cs1[2];
                        v0 = r0; v1 = r1;
                    }
                    if (gate) {
#pragma unroll
                        for (int j = 0; j < 4; ++j) { v0[j] = v0[j] * __builtin_amdgcn_rcpf(1.f + __builtin_amdgcn_exp2f(-1.4426950408889634f * v0[j])); v1[j] = v1[j] * __builtin_amdgcn_rcpf(1.f + __builtin_amdgcn_exp2f(-1.4426950408889634f * v1[j])); }
                    }
                    v0 = v0 * sc; v1 = v1 * sc;
                    u32x4 w; w.x = cvt_pk_bf16(v0[0], v0[1]); w.y = cvt_pk_bf16(v0[2], v0[3]); w.z = cvt_pk_bf16(v1[0], v1[1]); w.w = cvt_pk_bf16(v1[2], v1[3]);
                    *(u32x4*)(rowp + bj * HALF) = w;
                }
            }
    }
};
struct EpiPlainBf16 {
    static constexpr bool PERM = true, AFTER_DRAIN = false;
    bf16_t* O; int ldc;
    __device__ __forceinline__ void operator()(const f32x4 (&acc)[2][2][4][2], const Unit& u, int wr, int wc, int fr, int fq) const {
        const int row0 = u.pm * BM + wr * 64 + fr; const int col0 = u.pn * BM + wc * 32 + 8 * fq;
#pragma unroll
        for (int ai = 0; ai < 2; ++ai)
#pragma unroll
            for (int m = 0; m < 4; ++m) { bf16_t* rowp = O + (size_t)(row0 + ai * HALF + m * 16) * ldc + col0;
#pragma unroll
                for (int bj = 0; bj < 2; ++bj) { const f32x4 v0 = acc[ai][bj][m][0], v1 = acc[ai][bj][m][1];
                    u32x4 w; w.x = cvt_pk_bf16(v0[0], v0[1]); w.y = cvt_pk_bf16(v0[2], v0[3]); w.z = cvt_pk_bf16(v1[0], v1[1]); w.w = cvt_pk_bf16(v1[2], v1[3]);
                    *(u32x4*)(rowp + bj * HALF) = w; } }
    }
};
struct EpiResF32 {
    static constexpr bool PERM = false, AFTER_DRAIN = false;
    const float* base; float* out; int ldc; float alpha;
    __device__ __forceinline__ void operator()(const f32x4 (&acc)[2][2][4][2], const Unit& u, int wr, int wc, int fr, int fq) const {
        const int row0 = u.pm * BM + wr * 64 + fr; const int col0 = u.pn * BM + wc * 32 + 4 * fq;
#pragma unroll
        for (int ai = 0; ai < 2; ++ai)
#pragma unroll
            for (int m = 0; m < 4; ++m) { const size_t off = (size_t)(row0 + ai * HALF + m * 16) * ldc + col0;
#pragma unroll
                for (int bj = 0; bj < 2; ++bj)
#pragma unroll
                    for (int n = 0; n < 2; ++n) { const f32x4 bs = *(const f32x4*)(base + off + bj * HALF + n * 16); *(f32x4*)(out + off + bj * HALF + n * 16) = bs * alpha + acc[ai][bj][m][n]; } }
    }
};

template <class Epi, class Sched, bool ALIGN_EPI = false, bool SP2 = false>
__device__ __forceinline__ void gemm_phase(PG8_LAS unsigned char* lds, const Gemm g, const Sched& S, const Epi& E) {
    int tid_ = threadIdx.x; asm volatile("" : "+v"(tid_));
    const int tid = tid_, wid = __builtin_amdgcn_readfirstlane(tid >> 6), lane = tid & 63, wr = wid >> 2, wc = wid & 3, fr = lane & 15, fq = lane >> 4;
    const int K = g.K, nt = K / BK;
    unsigned voffA[2], voffB[2];
#pragma unroll
    for (int i = 0; i < 2; ++i) { int R, C; stage_rc(tid * 16 + i * 8192, R, C); const int Rb = Epi::PERM ? ((R & ~31) + perm32(R & 31)) : R;
        voffA[i] = (unsigned)(R * K + C) * 2u; voffB[i] = (unsigned)(Rb * K + C) * 2u; }
    const size_t kstep = (size_t)(BK * 2);
    const size_t hstep = (size_t)HALF * K * 2;
    const size_t tstep = 2 * hstep;
    const unsigned ldsw = (unsigned)wid * 1024u;
    const int aoff = lds_byte(wr * 64 + fr, fq * 8), boff = lds_byte(wc * 32 + fr, fq * 8);
#define PG8_SA(b, h) (((b) * 2 + (h)) * HTB)
#define PG8_SB(b, h) ((4 + (b) * 2 + (h)) * HTB)
#define PG8_STAGE(bufoff, gbase, voff) do { _Pragma("unroll") for (int _i = 0; _i < 2; ++_i) \
        __builtin_amdgcn_global_load_lds((const unsigned*)((const char*)(gbase) + (voff)[_i]), (PG8_LAS unsigned*)(lds + (bufoff) + ldsw + _i * 8192), 16, 0, 0); } while (0)
#define PG8_LDA(dst, b, h) do { _Pragma("unroll") for (int m = 0; m < 4; ++m) _Pragma("unroll") for (int k = 0; k < 2; ++k) dst[m][k] = *(const PG8_LAS bf16x8*)(lds + PG8_SA(b, h) + aoff + m * 2048 + k * 1024); } while (0)
#define PG8_LDB(dst, b, h) do { _Pragma("unroll") for (int n = 0; n < 2; ++n) _Pragma("unroll") for (int k = 0; k < 2; ++k) dst[n][k] = *(const PG8_LAS bf16x8*)(lds + PG8_SB(b, h) + boff + n * 2048 + k * 1024); } while (0)
#define PG8_MMA(ai, bj, At, Bt) do { __builtin_amdgcn_s_setprio(1); _Pragma("unroll") for (int m = 0; m < 4; ++m) _Pragma("unroll") for (int n = 0; n < 2; ++n) _Pragma("unroll") for (int k = 0; k < 2; ++k) \
        acc[ai][bj][m][n] = __builtin_amdgcn_mfma_f32_16x16x32_bf16(Bt[n][k], At[m][k], acc[ai][bj][m][n], 0, 0, 0); __builtin_amdgcn_s_setprio(0); } while (0)
#define PG8_WAIT_V(n) asm volatile("s_waitcnt vmcnt(" #n ")" ::: "memory")
#define PG8_WAIT_L(n) asm volatile("s_waitcnt lgkmcnt(" #n ")" ::: "memory")
#define PG8_BAR __builtin_amdgcn_s_barrier()
#define PG8_SCHED __builtin_amdgcn_sched_barrier(0)
    Unit cur, nxt; int ui = 0;
    if (!S.next(0, cur)) return;
    f32x4 acc[2][2][4][2];
#pragma unroll
    for (int a = 0; a < 2; ++a)
#pragma unroll
        for (int b = 0; b < 2; ++b)
#pragma unroll
            for (int m = 0; m < 4; ++m)
#pragma unroll
                for (int n = 0; n < 2; ++n) acc[a][b][m][n] = (f32x4){0.f, 0.f, 0.f, 0.f};
    bf16x8 At[4][2], B0[2][2], B1[2][2];
    const char* cA = (const char*)g.A + (size_t)cur.pm * tstep; const char* cB = (const char*)g.Bt + (size_t)cur.pn * tstep;
    S.a_ready(cur);
    if constexpr (SP2) {
        PG8_STAGE(PG8_SB(0, 0), cB, voffB); PG8_STAGE(PG8_SB(0, 1), cB + hstep, voffB); PG8_STAGE(PG8_SA(0, 0), cA, voffA); PG8_STAGE(PG8_SA(0, 1), cA + hstep, voffA);
        if (wr == 1) PG8_BAR;
        PG8_WAIT_V(2); PG8_BAR;
        PG8_STAGE(PG8_SB(1, 0), cB + kstep, voffB); PG8_STAGE(PG8_SA(1, 0), cA + kstep, voffA); PG8_STAGE(PG8_SB(1, 1), cB + hstep + kstep, voffB);
        PG8_WAIT_V(6); PG8_BAR;
    } else {
        PG8_STAGE(PG8_SB(0, 0), cB, voffB); PG8_STAGE(PG8_SA(0, 0), cA, voffA); PG8_STAGE(PG8_SB(0, 1), cB + hstep, voffB); PG8_STAGE(PG8_SA(0, 1), cA + hstep, voffA);
        if (wr == 1) PG8_BAR;
        PG8_WAIT_V(4); PG8_BAR;
        PG8_STAGE(PG8_SB(1, 0), cB + kstep, voffB); PG8_STAGE(PG8_SA(1, 0), cA + kstep, voffA); PG8_STAGE(PG8_SB(1, 1), cB + hstep + kstep, voffB);
        PG8_WAIT_V(6); PG8_BAR;
    }
    for (;;) {
        const bool has_next = S.next(ui + 1, nxt);
        const char* nA = has_next ? (const char*)g.A + (size_t)nxt.pm * tstep : cA; const char* nB = has_next ? (const char*)g.Bt + (size_t)nxt.pn * tstep : cB;
        for (int t = 0; t < nt; t += 2) {
            const bool last = (t == nt - 2);
            const char* a1 = cA + (size_t)(t + 1) * kstep;
            const char* a2 = last ? nA : cA + (size_t)(t + 2) * kstep; const char* b2 = last ? nB : cB + (size_t)(t + 2) * kstep;
            const char* a3 = a2 + kstep; const char* b3 = b2 + kstep;
            if (last && has_next) S.a_ready(nxt);
            if constexpr (SP2) {
            PG8_LDB(B0, 0, 0); PG8_LDB(B1, 0, 1); PG8_SCHED; PG8_LDA(At, 0, 0); PG8_STAGE(PG8_SA(1, 1), a1 + hstep, voffA);
            PG8_WAIT_V(8); PG8_WAIT_L(0); PG8_BAR; PG8_MMA(0, 0, At, B0); PG8_MMA(0, 1, At, B1); PG8_BAR; PG8_SCHED;
            PG8_LDA(At, 0, 1); PG8_STAGE(PG8_SB(0, 0), b2, voffB); PG8_STAGE(PG8_SB(0, 1), b2 + hstep, voffB); PG8_STAGE(PG8_SA(0, 0), a2, voffA);
            PG8_WAIT_V(8); PG8_WAIT_L(0); PG8_BAR; PG8_MMA(1, 0, At, B0); PG8_MMA(1, 1, At, B1); PG8_BAR; PG8_SCHED;
            PG8_LDB(B0, 1, 0); PG8_LDB(B1, 1, 1); PG8_SCHED; PG8_LDA(At, 1, 0); PG8_STAGE(PG8_SA(0, 1), a2 + hstep, voffA);
            PG8_WAIT_V(8); PG8_WAIT_L(0); PG8_BAR; PG8_MMA(0, 0, At, B0); PG8_MMA(0, 1, At, B1); PG8_BAR; PG8_SCHED;
            PG8_LDA(At, 1, 1); PG8_STAGE(PG8_SB(1, 0), b3, voffB); PG8_STAGE(PG8_SB(1, 1), b3 + hstep, voffB); PG8_STAGE(PG8_SA(1, 0), a3, voffA);
            PG8_WAIT_V(8); PG8_WAIT_L(0); PG8_BAR; PG8_MMA(1, 0, At, B0); PG8_MMA(1, 1, At, B1); PG8_BAR; PG8_SCHED;
            } else {
            PG8_LDB(B0, 0, 0); PG8_SCHED; PG8_LDA(At, 0, 0); PG8_STAGE(PG8_SA(1, 1), a1 + hstep, voffA);
            PG8_WAIT_L(8); PG8_BAR; PG8_WAIT_L(0); PG8_MMA(0, 0, At, B0); PG8_BAR; PG8_SCHED;
            PG8_LDB(B1, 0, 1); PG8_STAGE(PG8_SB(0, 0), b2, voffB);
            PG8_BAR; PG8_WAIT_L(0); PG8_MMA(0, 1, At, B1); PG8_BAR;
            PG8_LDA(At, 0, 1); PG8_STAGE(PG8_SA(0, 0), a2, voffA);
            PG8_BAR; PG8_WAIT_L(0); PG8_MMA(1, 0, At, B0); PG8_BAR; PG8_SCHED;
            PG8_STAGE(PG8_SB(0, 1), b2 + hstep, voffB);
            PG8_WAIT_V(6); PG8_BAR; PG8_MMA(1, 1, At, B1); PG8_BAR;
            PG8_LDB(B0, 1, 0); PG8_SCHED; PG8_LDA(At, 1, 0); PG8_STAGE(PG8_SA(0, 1), a2 + hstep, voffA);
            PG8_WAIT_L(8); PG8_BAR; PG8_WAIT_L(0); PG8_MMA(0, 0, At, B0); PG8_BAR; PG8_SCHED;
            PG8_LDB(B1, 1, 1); PG8_STAGE(PG8_SB(1, 0), b3, voffB);
            PG8_BAR; PG8_WAIT_L(0); PG8_MMA(0, 1, At, B1); PG8_BAR;
            PG8_LDA(At, 1, 1); PG8_STAGE(PG8_SA(1, 0), a3, voffA);
            PG8_BAR; PG8_WAIT_L(0); PG8_MMA(1, 0, At, B0); PG8_BAR; PG8_SCHED;
            PG8_STAGE(PG8_SB(1, 1), b3 + hstep, voffB);
            PG8_WAIT_V(6); PG8_BAR; PG8_MMA(1, 1, At, B1); PG8_BAR;
            }
        }
        if constexpr (ALIGN_EPI) { if (wr == 0) PG8_BAR; }
        if constexpr (!Epi::AFTER_DRAIN) { E(acc, cur, wr, wc, fr, fq); S.done(cur); }
        if (!has_next) break;
#pragma unroll
        for (int a = 0; a < 2; ++a)
#pragma unroll
            for (int b = 0; b < 2; ++b)
#pragma unroll
                for (int m = 0; m < 4; ++m)
#pragma unroll
                    for (int n = 0; n < 2; ++n) acc[a][b][m][n] = (f32x4){0.f, 0.f, 0.f, 0.f};
        cur = nxt; cA = nA; cB = nB; ++ui;
        if constexpr (ALIGN_EPI) { if (wr == 1) PG8_BAR; }
    }
    PG8_WAIT_V(0);
    if constexpr (!ALIGN_EPI) { if (wr == 0) PG8_BAR; }
    PG8_BAR;
    if constexpr (Epi::AFTER_DRAIN) { E.fused(acc, cur, wr, wc, fr, fq, lds, wid, lane); S.done(cur); }
#undef PG8_SA
#undef PG8_SB
#undef PG8_STAGE
#undef PG8_LDA
#undef PG8_LDB
#undef PG8_MMA
#undef PG8_WAIT_V
#undef PG8_WAIT_L
#undef PG8_BAR
#undef PG8_SCHED
}
}

#ifndef PG8_SP2
#define PG8_SP2 true
#endif
#ifndef PG8_ALIGN
#define PG8_ALIGN true
#endif
#include <hip/hip_bf16.h>
#include <cmath>
namespace attn_body {
using bf16=__hip_bfloat16;
using bf16x8=__attribute__((ext_vector_type(8)))short;
using s16x4=__attribute__((ext_vector_type(4)))short;
using f32x16=__attribute__((ext_vector_type(16)))float;
using u32x4=__attribute__((ext_vector_type(4)))unsigned;
constexpr int BATCH=16,SEQ=2048,D=64,PIN=3584,POUT=1024;
constexpr int NW=8,QBLK=32,QB=QBLK*NW,KVBLK=64,NQB=SEQ/QB;
constexpr int ATTN_UNIT_ROWS=QB;
__device__ __forceinline__ int crow(int r,int hi){return (r&3)+8*(r>>2)+4*hi;}
#define SBAR() __builtin_amdgcn_sched_barrier(0)
__device__ __forceinline__ void cmask(f32x16&p0,f32x16&p1,int jb,int qrel,int hi){
  const float NEG=-INFINITY; int kb=64*jb+4*hi;
  #pragma unroll
  for(int r=0;r<16;++r){int kv=kb+(r&3)+8*(r>>2); if(kv>qrel)p0[r]=NEG; if(kv+32>qrel)p1[r]=NEG;}
}

constexpr int NSLOT=3, SLOTB=8192;
constexpr int LDS_K=0, LDS_V=NSLOT*SLOTB, LDS_WS=2*NSLOT*SLOTB, LDS_OST=LDS_WS+NW*64*4, LDS_BYTES=LDS_OST+NW*4096;
constexpr float C2=0.125f*1.4426950408889634f;
__device__ __forceinline__ void glds16(const void*gsrc,unsigned lds_dst){unsigned keep;
  asm volatile("s_mov_b32 %0, m0\n\ts_mov_b32 m0, %2\n\ts_nop 0\n\tglobal_load_lds_dwordx4 %1, off\n\ts_mov_b32 m0, %0":"=&s"(keep):"v"(gsrc),"s"(lds_dst):"memory");}
__device__ __forceinline__ float max3f(float a,float b,float c){float r;asm("v_max3_f32 %0, %1, %2, %3":"=v"(r):"v"(a),"v"(b),"v"(c));return r;}
__device__ __forceinline__ float max2f(float a,float b){float r;asm("v_max_f32_e32 %0, %1, %2":"=v"(r):"v"(a),"v"(b));return r;}
__device__ __forceinline__ float fadd_s(float a,float b){float r;asm("v_add_f32_e32 %0, %1, %2":"=v"(r):"v"(a),"v"(b));return r;}
__device__ __forceinline__ float fsub_s(float a,float b){float r;asm("v_sub_f32_e32 %0, %1, %2":"=v"(r):"v"(a),"v"(b));return r;}
typedef float f32x2_t __attribute__((ext_vector_type(2))); typedef __bf16 bf16x2_t __attribute__((ext_vector_type(2)));
__device__ __forceinline__ unsigned cvtpk_s(float lo,float hi){f32x2_t v={lo,hi};bf16x2_t b=__builtin_convertvector(v,bf16x2_t);return __builtin_bit_cast(unsigned,b);}
#define WAIT_BAR(N) asm volatile("s_waitcnt vmcnt(" #N ") lgkmcnt(0)\n\ts_barrier":::"memory")

__device__ __forceinline__ void qkt(f32x16&p0,f32x16&p1,const char*Kslot,const bf16x8*qr,const f32x16&negm,int r32,int hi){
  const char*kb=Kslot+hi*1024+r32*16;
  #pragma unroll
  for(int d0=0;d0<4;++d0){
    const bf16x8 b0=*reinterpret_cast<const bf16x8*>(kb+d0*2048);
    const bf16x8 b1=*reinterpret_cast<const bf16x8*>(kb+d0*2048+512);
    if(d0==0){p0=__builtin_amdgcn_mfma_f32_32x32x16_bf16(b0,qr[0],negm,0,0,0);p1=__builtin_amdgcn_mfma_f32_32x32x16_bf16(b1,qr[0],negm,0,0,0);}
    else{p0=__builtin_amdgcn_mfma_f32_32x32x16_bf16(b0,qr[d0],p0,0,0,0);p1=__builtin_amdgcn_mfma_f32_32x32x16_bf16(b1,qr[d0],p1,0,0,0);}}
}
typedef __attribute__((address_space(3))) const char* lds_cptr;
typedef short v4i16_t __attribute__((ext_vector_type(4)));
__device__ __forceinline__ void kload8(bf16x8*kf,lds_cptr kp){
  kf[0]=*(const __attribute__((address_space(3))) bf16x8*)(kp);      kf[1]=*(const __attribute__((address_space(3))) bf16x8*)(kp+512);
  kf[2]=*(const __attribute__((address_space(3))) bf16x8*)(kp+2048); kf[3]=*(const __attribute__((address_space(3))) bf16x8*)(kp+2560);
  kf[4]=*(const __attribute__((address_space(3))) bf16x8*)(kp+4096); kf[5]=*(const __attribute__((address_space(3))) bf16x8*)(kp+4608);
  kf[6]=*(const __attribute__((address_space(3))) bf16x8*)(kp+6144); kf[7]=*(const __attribute__((address_space(3))) bf16x8*)(kp+6656);
}
__device__ __forceinline__ void kload2(bf16x8*kf,lds_cptr kp,int j){ kf[2*j]=*(const __attribute__((address_space(3))) bf16x8*)(kp+j*2048); kf[2*j+1]=*(const __attribute__((address_space(3))) bf16x8*)(kp+j*2048+512); }
__device__ __forceinline__ s16x4 vtr(lds_cptr p){ return __builtin_bit_cast(s16x4,__builtin_amdgcn_ds_read_tr16_b64_v4i16((__attribute__((address_space(3))) v4i16_t*)p)); }
__device__ __forceinline__ float rowmax(const f32x16&p0,const f32x16&p1){
  float a=max3f(p0[0],p0[1],p1[0]),b=max3f(p0[2],p0[3],p1[1]);a=max3f(a,p1[2],p1[3]);
  #pragma unroll
  for(int r=4;r<16;r+=4){a=max3f(a,p0[r],p0[r+1]);b=max3f(b,p0[r+2],p0[r+3]);a=max3f(a,p1[r],p1[r+1]);b=max3f(b,p1[r+2],p1[r+3]);}
  const float m=max2f(a,b);
  auto rr=__builtin_amdgcn_permlane32_swap(__float_as_uint(m),__float_as_uint(m),false,false);
  return max2f(__uint_as_float(rr[0]),__uint_as_float(rr[1]));
}
__device__ __forceinline__ void pv(f32x16*o,int vb,bf16x8 pa0,bf16x8 pa1,bf16x8 pa2,bf16x8 pa3){
  #pragma unroll
  for(int d0=0;d0<2;++d0){s16x4 lo[4],hi[4];
    #pragma unroll
    for(int ks=0;ks<4;++ks){
      asm volatile("ds_read_b64_tr_b16 %0,%1 offset:%c2":"=&v"(lo[ks]):"v"(vb),"i"(d0*4096+ks*1024):"memory");
      asm volatile("ds_read_b64_tr_b16 %0,%1 offset:%c2":"=&v"(hi[ks]):"v"(vb),"i"(d0*4096+ks*1024+512):"memory");}
    asm volatile("s_waitcnt lgkmcnt(0)":::"memory");SBAR();
    #define PK(k) (bf16x8){lo[k][0],lo[k][1],lo[k][2],lo[k][3],hi[k][0],hi[k][1],hi[k][2],hi[k][3]}
    o[d0]=__builtin_amdgcn_mfma_f32_32x32x16_bf16(pa0,PK(0),o[d0],0,0,0);
    o[d0]=__builtin_amdgcn_mfma_f32_32x32x16_bf16(pa1,PK(1),o[d0],0,0,0);
    o[d0]=__builtin_amdgcn_mfma_f32_32x32x16_bf16(pa2,PK(2),o[d0],0,0,0);
    o[d0]=__builtin_amdgcn_mfma_f32_32x32x16_bf16(pa3,PK(3),o[d0],0,0,0);
    #undef PK
  }
}

#ifndef ATTN_STORE16
#define ATTN_STORE16(p,v) (*(u32x4*)(p)=(v))
#endif
template<int THRL> __device__ __forceinline__ void attn_unit(int b,int qb,const bf16*Q,const bf16*__restrict__ K,const bf16*__restrict__ V,bf16*O,char*shm){
  const int tid=threadIdx.x,lane=tid&63,r32=lane&31,hi=lane>>5; const int wid=__builtin_amdgcn_readfirstlane(tid>>6);
  const long rowbase=(long)b*SEQ; const int q0=qb*QB;
  const bf16*Qw=Q+(rowbase+q0+wid*QBLK)*PIN;
  const bf16*Kh=K+rowbase*PIN,*Vh=V+rowbase*PIN;
  const unsigned lds0=(unsigned)(uintptr_t)shm;
  float*wsf=(float*)(shm+LDS_WS)+wid*64;
  const bf16*ksrc=Kh+(long)lane*PIN+wid*8;
  const bf16*vsrc=Vh+(long)(16*(wid&3)+(lane>>2))*PIN+(wid>>2)*32+(lane&3)*8;
  const unsigned kdst=lds0+LDS_K+wid*1024, vdst=lds0+LDS_V+wid*1024;
  #define DMA_K(t,slot) glds16(ksrc+(long)(t)*KVBLK*PIN,(unsigned)__builtin_amdgcn_readfirstlane(kdst+(slot)))
  #define DMA_V(t,slot) glds16(vsrc+(long)(t)*KVBLK*PIN,(unsigned)__builtin_amdgcn_readfirstlane(vdst+(slot)))
  const int vb0=(int)(lds0+LDS_V)+((lane>>4)&1)*32+(lane&3)*8+(4*hi+((lane&15)>>2))*64;
  const char*Kbase=shm+LDS_K; bf16x8 kf[8];
  const lds_cptr shm3=(lds_cptr)shm; const lds_cptr kp0=shm3+LDS_K+hi*1024+r32*16; const lds_cptr vp0=shm3+LDS_V+((lane>>4)&1)*32+(lane&3)*8+(4*hi+((lane&15)>>2))*64;
  const int NT=(q0+QB)/KVBLK;
  DMA_K(0,0);DMA_V(0,0);DMA_K(1,SLOTB);
  bf16x8 qr[4];
  #pragma unroll
  for(int d0=0;d0<4;++d0)qr[d0]=*reinterpret_cast<const bf16x8*>(&Qw[(long)r32*PIN+d0*16+hi*8]);
  float mhat=0.f,l_reg=0.f;f32x16 o[2];o[0]=f32x16{};o[1]=f32x16{};f32x16 negm=f32x16{};asm volatile("":"+v"(negm));
  const int qrel=wid*QBLK+r32;
  #define CMASK(P0,P1,t) do{int jb_=(t)-(NT-4); if(jb_>=0)cmask(P0,P1,jb_,qrel,hi);}while(0)
  bool resc=false;
  #define START(P0,P1) do{ const float rm=rowmax(P0,P1); resc=false; \
    { const float dl=rm; mhat=fadd_s(mhat,dl); \
      _Pragma("unroll") for(int r=0;r<16;++r){P0[r]=fsub_s(P0[r],dl);P1[r]=fsub_s(P1[r],dl);} \
      _Pragma("unroll") for(int r=0;r<16;++r)negm[r]=-mhat; asm volatile("":"+v"(negm)); } \
    _Pragma("unroll") for(int r=0;r<16;++r)P0[r]=__builtin_amdgcn_exp2f(P0[r]); }while(0)
  #define RESC() do{ if(resc){ asm volatile("s_waitcnt lgkmcnt(0)":::"memory"); \
      _Pragma("unroll") for(int d_=0;d_<2;++d_) _Pragma("unroll") for(int r=0;r<16;++r)o[d_][r]*=wsf[crow(r,hi)]; } }while(0)
  f32x16 pA0,pA1,pB0,pB1;
  int sl_prev=0,sl_cur=0,sl_next=SLOTB;
  #define ROT() do{sl_prev=sl_cur;sl_cur=sl_next;sl_next=(sl_next==(NSLOT-1)*SLOTB)?0:sl_next+SLOTB;}while(0)
  DMA_K(2,2*SLOTB);
  WAIT_BAR(3);
  qkt(pA0,pA1,Kbase,qr,negm,r32,hi);asm volatile("s_nop 15\n\ts_nop 7":"+v"(pA0),"+v"(pA1));CMASK(pA0,pA1,0);
  START(pA0,pA1);
  _Pragma("unroll") for(int r=0;r<16;++r)pA1[r]=__builtin_amdgcn_exp2f(pA1[r]);
  WAIT_BAR(0);
  DMA_K(3,0);DMA_V(1,SLOTB);
  ROT();
  kload8(kf,kp0+sl_cur);
  WAIT_BAR(2);
  s16x4 vlo[8],vhi[8]; u32x4 pw0,pw1,pw2,pw3;
  #define PKW(P,B) cvtpk_s(P[B],P[B+1])
  #define PAF(k) __builtin_bit_cast(bf16x8,pw##k)
  #define VFR(i) (bf16x8){vlo[i][0],vlo[i][1],vlo[i][2],vlo[i][3],vhi[i][0],vhi[i][1],vhi[i][2],vhi[i][3]}
  #define PIN(x) asm volatile("":"+v"(x))
  #define MX3(a,b,c) __builtin_fmaxf(__builtin_fmaxf((a),(b)),(c))
  #define GAPA(MF,A0,A1,A2,A3,W0,W1,PW) do{ MF; sacc+=A0; sacc+=A1; sacc+=A2; sacc+=A3; PIN(sacc); W0; W1; PIN(PW); SBAR(); }while(0)
  #define EX(v) __builtin_amdgcn_exp2f(v)
  #define GAPB(MF,X,B) do{ MF; X[B]=EX(X[B]); X[B+1]=EX(X[B+1]); X[B+2]=EX(X[B+2]); X[B+3]=EX(X[B+3]); PIN(X); SBAR(); }while(0)
  #define VRD(i) do{ vlo[i]=vtr(vp_+(((i)>>2)*4096+((i)&3)*1024)); vhi[i]=vtr(vp_+(((i)>>2)*4096+((i)&3)*1024+512)); }while(0)
  #define KRD(G,j) do{ if(G){ kload2(kf,kp0+sl_next,j); SBAR(); } }while(0)
  #define STEP(C0,C1,P0,P1,t,GK,GV,GL) do{ SBAR(); \
    const lds_cptr vp_=vp0+sl_prev; \
    VRD(0); SBAR(); float sacc=(P0[0]+P0[1]); \
    GAPA(C0=__builtin_amdgcn_mfma_f32_32x32x16_bf16(kf[0],qr[0],negm,0,0,0), P0[2],P0[3],P0[4],P0[5],     pw0[0]=PKW(P0,0), pw0[1]=PKW(P0,2), pw0); \
    VRD(4); SBAR(); GAPA(C1=__builtin_amdgcn_mfma_f32_32x32x16_bf16(kf[1],qr[0],negm,0,0,0), P0[6],P0[7],P0[8],P0[9],     pw0[2]=PKW(P0,4), pw0[3]=PKW(P0,6), pw0); \
    VRD(1); SBAR(); GAPA(C0=__builtin_amdgcn_mfma_f32_32x32x16_bf16(kf[2],qr[1],C0,0,0,0),   P0[10],P0[11],P0[12],P0[13], pw1[0]=PKW(P0,8), pw1[1]=PKW(P0,10), pw1); \
    VRD(5); SBAR(); GAPA(C1=__builtin_amdgcn_mfma_f32_32x32x16_bf16(kf[3],qr[1],C1,0,0,0),   P0[14],P0[15],P1[0],P1[1],   pw1[2]=PKW(P0,12),pw1[3]=PKW(P0,14), pw1); \
    VRD(2); SBAR(); GAPA(C0=__builtin_amdgcn_mfma_f32_32x32x16_bf16(kf[4],qr[2],C0,0,0,0),   P1[2],P1[3],P1[4],P1[5],     pw2[0]=PKW(P1,0), pw2[1]=PKW(P1,2), pw2); \
    VRD(6); SBAR(); GAPA(C1=__builtin_amdgcn_mfma_f32_32x32x16_bf16(kf[5],qr[2],C1,0,0,0),   P1[6],P1[7],P1[8],P1[9],     pw2[2]=PKW(P1,4), pw2[3]=PKW(P1,6), pw2); \
    VRD(3); SBAR(); GAPA(C0=__builtin_amdgcn_mfma_f32_32x32x16_bf16(kf[6],qr[3],C0,0,0,0),   P1[10],P1[11],P1[12],P1[13], pw3[0]=PKW(P1,8), pw3[1]=PKW(P1,10), pw3); \
    VRD(7); SBAR(); GAPA(C1=__builtin_amdgcn_mfma_f32_32x32x16_bf16(kf[7],qr[3],C1,0,0,0),   P1[14],P1[15],0.f,0.f,       pw3[2]=PKW(P1,12),pw3[3]=PKW(P1,14), pw3); \
    l_reg+=sacc; \
    if(GK){DMA_K((t)+3,sl_cur);} if(GV){DMA_V((t)+1,sl_next);} \
    CMASK(C0,C1,t); \
    { float a=MX3(C0[0],C0[1],C1[0]),b=MX3(C0[2],C0[3],C1[1]); a=MX3(a,C1[2],C1[3]); \
      _Pragma("unroll") for(int r=4;r<16;r+=4){a=MX3(a,C0[r],C0[r+1]);b=MX3(b,C0[r+2],C0[r+3]);a=MX3(a,C1[r],C1[r+1]);b=MX3(b,C1[r+2],C1[r+3]);} \
      float rm=__builtin_fmaxf(a,b); { auto rr=__builtin_amdgcn_permlane32_swap(__float_as_uint(rm),__float_as_uint(rm),false,false); rm=__builtin_fmaxf(__uint_as_float(rr[0]),__uint_as_float(rr[1])); } \
      resc=false; \
      if(__builtin_expect(__any(rm>(float)THRL),0)){ const float dl=__builtin_fmaxf(rm,0.f); mhat+=dl; \
        _Pragma("unroll") for(int r=0;r<16;++r){C0[r]-=dl;C1[r]-=dl;} \
        _Pragma("unroll") for(int r=0;r<16;++r)negm[r]=-mhat; asm volatile("":"+v"(negm)); \
        const float f=__builtin_amdgcn_exp2f(-dl); l_reg*=f; if(hi==0)wsf[r32]=f; resc=true; } } \
    SBAR(); \
    GAPB(o[0]=__builtin_amdgcn_mfma_f32_32x32x16_bf16(PAF(0),VFR(0),o[0],0,0,0), C0,0); \
    GAPB(o[1]=__builtin_amdgcn_mfma_f32_32x32x16_bf16(PAF(0),VFR(4),o[1],0,0,0), C0,4); \
    KRD(GL,0); GAPB(o[0]=__builtin_amdgcn_mfma_f32_32x32x16_bf16(PAF(1),VFR(1),o[0],0,0,0), C0,8); \
    KRD(GL,1); GAPB(o[1]=__builtin_amdgcn_mfma_f32_32x32x16_bf16(PAF(1),VFR(5),o[1],0,0,0), C0,12); \
    KRD(GL,2); GAPB(o[0]=__builtin_amdgcn_mfma_f32_32x32x16_bf16(PAF(2),VFR(2),o[0],0,0,0), C1,0); \
    KRD(GL,3); GAPB(o[1]=__builtin_amdgcn_mfma_f32_32x32x16_bf16(PAF(2),VFR(6),o[1],0,0,0), C1,4); \
    GAPB(o[0]=__builtin_amdgcn_mfma_f32_32x32x16_bf16(PAF(3),VFR(3),o[0],0,0,0), C1,8); \
    GAPB(o[1]=__builtin_amdgcn_mfma_f32_32x32x16_bf16(PAF(3),VFR(7),o[1],0,0,0), C1,12); \
    }while(0)
  int t=1;
  #undef CMASK
  #define CMASK(P0,P1,t) do{}while(0)
  for(;t+5<NT;t+=2){
    STEP(pB0,pB1,pA0,pA1,t,true,true,true);     WAIT_BAR(2); RESC(); ROT();
    STEP(pA0,pA1,pB0,pB1,t+1,true,true,true);   WAIT_BAR(2); RESC(); ROT();
  }
  #undef CMASK
  #define CMASK(P0,P1,t) do{int jb_=(t)-(NT-4); if(jb_>=0)cmask(P0,P1,jb_,qrel,hi);}while(0)
  #define ENDW(tt) do{ if((tt)+3<NT){WAIT_BAR(2);} else if((tt)+2<NT){WAIT_BAR(1);} else {WAIT_BAR(0);} }while(0)
  for(;t+1<NT;t+=2){
    STEP(pB0,pB1,pA0,pA1,t,(t+3<NT),(t+1<NT),(t+1<NT));       ENDW(t);   RESC(); ROT();
    STEP(pA0,pA1,pB0,pB1,t+1,(t+4<NT),(t+2<NT),(t+2<NT));     ENDW(t+1); RESC(); ROT();
  }
  STEP(pB0,pB1,pA0,pA1,NT-1,false,false,false); RESC();
  { float sacc=pB0[0]+pB0[1]; _Pragma("unroll") for(int r=2;r<16;++r)sacc+=pB0[r]; _Pragma("unroll") for(int r=0;r<16;++r)sacc+=pB1[r]; l_reg+=sacc;
    pw0=(u32x4){PKW(pB0,0),PKW(pB0,2),PKW(pB0,4),PKW(pB0,6)};pw1=(u32x4){PKW(pB0,8),PKW(pB0,10),PKW(pB0,12),PKW(pB0,14)};pw2=(u32x4){PKW(pB1,0),PKW(pB1,2),PKW(pB1,4),PKW(pB1,6)};pw3=(u32x4){PKW(pB1,8),PKW(pB1,10),PKW(pB1,12),PKW(pB1,14)};
    SBAR(); pv(o,vb0+sl_cur,PAF(0),PAF(1),PAF(2),PAF(3)); }
  #undef PKW
  #undef PAF
  #undef VFR
  #undef PIN
  #undef MX3
  #undef GAPA
  #undef GAPB
  #undef EX
  #undef VRD
  #undef KRD
  #undef STEP
  #undef ENDW
  {auto rr=__builtin_amdgcn_permlane32_swap(__float_as_uint(l_reg),__float_as_uint(l_reg),false,false);l_reg=__uint_as_float(rr[0])+__uint_as_float(rr[1]);}
  if(hi==0)wsf[32+r32]=l_reg;asm volatile("s_waitcnt lgkmcnt(0)":::"memory");
  float rli[16];
  #pragma unroll
  for(int r=0;r<16;++r)rli[r]=__builtin_amdgcn_rcpf(wsf[32+crow(r,hi)]);
  bf16*Ow=O+(rowbase+q0+wid*QBLK)*POUT;
  { bf16*stg=(bf16*)(shm+LDS_OST)+wid*2048;
    #pragma unroll
    for(int r=0;r<16;++r){const int orow=crow(r,hi);
      #pragma unroll
      for(int d0=0;d0<2;++d0)stg[orow*64+d0*32+r32]=__float2bfloat16(o[d0][r]*rli[r]);}
    asm volatile("s_waitcnt lgkmcnt(0)":::"memory");
    #pragma unroll
    for(int i=0;i<4;++i){const int row=i*8+(lane>>3),ch=lane&7; const u32x4 v=*(const u32x4*)(stg+row*64+ch*8); ATTN_STORE16(Ow+(long)row*POUT+ch*8,v);} }
  asm volatile("s_waitcnt lgkmcnt(0)\n\ts_barrier":::"memory");
  #undef DMA_K
  #undef DMA_V
  #undef CMASK
  #undef START
  #undef RESC
  #undef ROT
}
constexpr int ATTN_LDS_BYTES=LDS_BYTES;
#undef SBAR
#undef WAIT_BAR
}

#define GAS __attribute__((address_space(1)))
#define LAS __attribute__((address_space(3)))
typedef unsigned short bf16;
typedef unsigned v4u __attribute__((ext_vector_type(4)));
typedef float f32x4 __attribute__((ext_vector_type(4)));
typedef short bf16x8 __attribute__((ext_vector_type(8)));
typedef GAS unsigned gu32;
typedef GAS unsigned long long gu64;
#define RLX_AGENT __ATOMIC_RELAXED, __HIP_MEMORY_SCOPE_AGENT
#define LDS_WAIT() asm volatile("s_waitcnt lgkmcnt(0)" ::: "memory")
#define VM_WAIT() asm volatile("s_waitcnt vmcnt(0)" ::: "memory")
__device__ __forceinline__ unsigned long long rt() { return __builtin_amdgcn_s_memrealtime(); }
__device__ __forceinline__ unsigned f2bf(float f) { unsigned u = __builtin_bit_cast(unsigned, f); return (u + 0x7fffu + ((u >> 16) & 1u)) >> 16; }
__device__ __forceinline__ unsigned pk2(float lo, float hi) { return f2bf(lo) | (f2bf(hi) << 16); }

#define XB_TMO      128
#define XB_XCNT(j)  (256  + 64 * (j))
#define XB_XSUB(j)  (1280 + 64 * (j))
#define XB_XGEN(j)  (2304 + 64 * (j))
#define XB_TOP      3328
#define XB_TOPGEN   3392
#define XCD_BAR_WORDS 3456
#define XB_SPIN_CAP (1u << 18)

__device__ __forceinline__ unsigned xb_ld(unsigned* p)              { return __hip_atomic_load(p, __ATOMIC_RELAXED, __HIP_MEMORY_SCOPE_AGENT); }
__device__ __forceinline__ unsigned xb_add(unsigned* p, unsigned v) { return __hip_atomic_fetch_add(p, v, __ATOMIC_RELAXED, __HIP_MEMORY_SCOPE_AGENT); }
__device__ __forceinline__ unsigned xb_xcc_id() { return (unsigned)__builtin_amdgcn_s_getreg((3 << 11) | 20) & 0xFu; }
#define XB_SPIN(cond, bar) do { unsigned _sp = 0; while (cond) { __builtin_amdgcn_s_sleep(1); \
    if ((++_sp & 255u) == 0u) { if (xb_ld(&(bar)[XB_TMO])) break; if (_sp > XB_SPIN_CAP) { atomicAdd(&(bar)[XB_TMO], 1u); break; } } } } while (0)

struct XcdBarrier {
    unsigned* bar; unsigned x;
    volatile LAS unsigned* st;
};

__device__ __forceinline__ XcdBarrier xcd_barrier_post(unsigned* bar, volatile LAS unsigned* st) {
    XcdBarrier b; b.bar = bar; b.x = xb_xcc_id(); b.st = st;
    if (threadIdx.x == 0) (void)xb_add(&bar[XB_XCNT(b.x)], 1u);
    return b;
}
__device__ __forceinline__ void xcd_barrier_complete(unsigned* bar, unsigned x, unsigned& nloc, unsigned& nx) {
    const unsigned G = gridDim.x * gridDim.y * gridDim.z;
    unsigned sum, cnt, mine, sp = 0u;
    for (;;) {
        sum = 0u; cnt = 0u; mine = 0u;
#pragma unroll
        for (unsigned j = 0; j < 16; ++j) { const unsigned c = xb_ld(&bar[XB_XCNT(j)]); sum += c; cnt += (c > 0u) ? 1u : 0u; mine = (j == x) ? c : mine; }
        if (sum == G) break;
        __builtin_amdgcn_s_sleep(1);
        if ((++sp & 255u) == 0u) { if (xb_ld(&bar[XB_TMO])) break; if (sp > XB_SPIN_CAP) { atomicAdd(&bar[XB_TMO], 1u); break; } }
    }
    nloc = mine > 0u ? mine : 1u; nx = cnt > 0u ? cnt : 1u;
}

__device__ __forceinline__ void xcd_barrier(const XcdBarrier& b) {
    asm volatile("s_waitcnt vmcnt(0)" ::: "memory");
    __syncthreads();
    if (threadIdx.x == 0) {
        unsigned* bar = b.bar;
        __builtin_amdgcn_s_waitcnt(0);
        unsigned nloc = b.st[0], nx = b.st[1];
        if (nloc == 0u) { xcd_barrier_complete(bar, b.x, nloc, nx); b.st[0] = nloc; b.st[1] = nx; }
        const unsigned old = xb_add(&bar[XB_XSUB(b.x)], 1u);
        const unsigned gen = old / nloc;
        if (old + 1u == (gen + 1u) * nloc) {
            __builtin_amdgcn_fence(__ATOMIC_RELEASE, "agent");
            asm volatile("s_waitcnt vmcnt(0)" ::: "memory");
            const unsigned og = xb_add(&bar[XB_TOP], 1u);
            const unsigned tg = og / nx;
            if (og + 1u == (tg + 1u) * nx) xb_add(&bar[XB_TOPGEN], 1u);
            else XB_SPIN(xb_ld(&bar[XB_TOPGEN]) == tg, bar);
            __builtin_amdgcn_fence(__ATOMIC_ACQUIRE, "agent");
            xb_add(&bar[XB_XGEN(b.x)], 1u);
            asm volatile("s_waitcnt vmcnt(0)" ::: "memory");
        } else {
            XB_SPIN(xb_ld(&bar[XB_XGEN(b.x)]) == gen, bar);
            __builtin_amdgcn_fence(__ATOMIC_ACQUIRE, "agent");
            asm volatile("s_waitcnt vmcnt(0)" ::: "memory");
        }
    }
    __syncthreads();
}

constexpr int NWAVES = 8;
constexpr int BATCH = 16, SEQ = 2048, D = 1024, M = BATCH * SEQ;
constexpr int NPROJ = 3584;
constexpr int C_RQ = 0, C_RK = 512, C_RV = 1024, C_RG = 1536, C_DQ = 2048, C_DK = 2560, C_DV = 3072;
constexpr int NQ = 2048, NEXP = 16384, NSEL = 128;
constexpr float ALPHA = 1.189207115002721f, LN_EPS = 1e-5f, LAMBDA_INIT = 0.2f;
constexpr float QSCALE = 0.125f * 1.4426950408889634f;
constexpr float KSCALE = 0.08838834764831845f;

constexpr size_t MiB = 1u << 20;
constexpr size_t WS_CTL = 0, CTL_ZERO_BYTES = 1 * MiB;
constexpr size_t WS_WIN = 2 * MiB, WS_WOUT = 10 * MiB, WS_WQ = 12 * MiB, WS_SK = 16 * MiB, WS_ROPE = 17 * MiB, WS_MISC = 18 * MiB;
constexpr size_t WS_XB = 32 * MiB;
constexpr size_t WS_DOUT = 32 * MiB;
constexpr size_t WS_PU = 96 * MiB, WS_PV = 128 * MiB;
constexpr size_t WS_PROJ = 160 * MiB;
constexpr size_t WS_X1 = 160 * MiB, WS_IDX = 224 * MiB, WS_GATE = 240 * MiB, WS_QP = 256 * MiB;
constexpr size_t WS_MIX = 400 * MiB;
constexpr size_t WS_END = 464 * MiB;
constexpr int CW_TMO = 0, CW_CODE = 1, CW_BAR = 4096;

constexpr int RING_OFF = 0, RING_BYTES = 131072;
constexpr int LDSCTL_OFF = RING_BYTES, MISC_OFF = LDSCTL_OFF + 320;
constexpr int LDS_BYTES = 147456;

struct Frame {
    LAS unsigned char* lds;
    volatile LAS unsigned* MISC;
    gu32* ctl;
    int tid, lane, wave;
    int vcu, G;
    const float* const* in; float* out; unsigned char* ws;
};

__device__ __forceinline__ float bf2f(unsigned short b) { return __builtin_bit_cast(float, (unsigned)b << 16); }
__device__ __forceinline__ float bflo(unsigned w) { return __builtin_bit_cast(float, w << 16); }
__device__ __forceinline__ float bfhi(unsigned w) { return __builtin_bit_cast(float, w & 0xffff0000u); }
__device__ __forceinline__ float wave_sum(float v) {
#pragma unroll
    for (int o = 1; o < 64; o <<= 1) v += __shfl_xor(v, o);
    return v;
}
__device__ __forceinline__ float wave_max(float v) {
#pragma unroll
    for (int o = 1; o < 64; o <<= 1) v = fmaxf(v, __shfl_xor(v, o));
    return v;
}
__device__ __forceinline__ float dot8(v4u a, v4u b, float s) {
    s = fmaf(bflo(a.x), bflo(b.x), s); s = fmaf(bfhi(a.x), bfhi(b.x), s);
    s = fmaf(bflo(a.y), bflo(b.y), s); s = fmaf(bfhi(a.y), bfhi(b.y), s);
    s = fmaf(bflo(a.z), bflo(b.z), s); s = fmaf(bfhi(a.z), bfhi(b.z), s);
    s = fmaf(bflo(a.w), bflo(b.w), s); s = fmaf(bfhi(a.w), bfhi(b.w), s);
    return s;
}

__device__ __forceinline__ int phys_col(int L) { if (L >= 1024) return L; const int hd = L >> 7, l = L & 127; return hd * 128 + (l < 64 ? 2 * l : 2 * (l - 64) + 1); }
template <bool PERMQK>
__device__ __forceinline__ void p0_transpose_item(const float* W, int K, int N, bf16* WT, LAS float* scr, int item, int lane) {
    const int nblk = N / 32, kb = item / nblk, nb = item % nblk, k0 = 64 * kb, n0 = 32 * nb;
#pragma unroll 8
    for (int i = 0; i < 32; ++i) { const int kk = 2 * i + (lane >> 5); scr[kk * 33 + (lane & 31)] = W[(size_t)(k0 + kk) * N + n0 + (lane & 31)]; }
    LDS_WAIT(); asm volatile("" ::: "memory");
    const int c = lane & 7;
#pragma unroll
    for (int j = 0; j < 4; ++j) { const int n = (lane >> 3) + 8 * j; const LAS float* s = scr + (8 * c) * 33 + n;
        v4u o; o.x = pk2(s[0 * 33], s[1 * 33]); o.y = pk2(s[2 * 33], s[3 * 33]); o.z = pk2(s[4 * 33], s[5 * 33]); o.w = pk2(s[6 * 33], s[7 * 33]);
        const int orow = PERMQK ? phys_col(n0 + n) : (n0 + n);
        *(GAS v4u*)(WT + (size_t)orow * K + k0 + 8 * c) = o; }
    LDS_WAIT(); asm volatile("" ::: "memory");
}
__device__ __forceinline__ void cvt_bf16_stream(const float* src, bf16* dst, size_t n4, int gt, int ngt) {
    for (size_t i = gt; i < n4; i += ngt) { const f32x4 v = ((const GAS f32x4*)src)[i]; typedef unsigned u2 __attribute__((ext_vector_type(2))); u2 o; o.x = pk2(v.x, v.y); o.y = pk2(v.z, v.w); ((GAS u2*)dst)[i] = o; }
}
__device__ __forceinline__ void p0_prologue(Frame& F) {
    LAS float* scr = (LAS float*)(F.lds + RING_OFF + F.wave * 16384);
    const int gw = F.vcu * NWAVES + F.wave, NGW = F.G * NWAVES;
    const int gt = (int)blockIdx.x * (NWAVES * 64) + F.tid, ngt = F.G * NWAVES * 64;
    constexpr int I_IN = (D / 64) * (NPROJ / 32), I_OUT = (D / 64) * (D / 32), I_Q = (D / 64) * (NQ / 32);
    constexpr int NITEMS = I_IN + I_OUT + I_Q;
    for (int it = gw; it < NITEMS; it += NGW) {
        int r = it;
        if (r < I_IN) { p0_transpose_item<true>(F.in[1], D, NPROJ, (bf16*)(F.ws + WS_WIN), scr, r, F.lane); continue; } r -= I_IN;
        if (r < I_OUT) { p0_transpose_item<false>(F.in[9], D, D, (bf16*)(F.ws + WS_WOUT), scr, r, F.lane); continue; } r -= I_OUT;
        p0_transpose_item<false>(F.in[12], D, NQ, (bf16*)(F.ws + WS_WQ), scr, r, F.lane);
    }
    cvt_bf16_stream(F.in[13], (bf16*)(F.ws + WS_SK), (size_t)8 * 2 * 128 * 128 / 4, gt, ngt);
    cvt_bf16_stream(F.in[14], (bf16*)(F.ws + WS_PU), (size_t)NEXP * D / 4, gt, ngt);
    cvt_bf16_stream(F.in[15], (bf16*)(F.ws + WS_PV), (size_t)NEXP * D / 4, gt, ngt);
    cvt_bf16_stream(F.in[0], (bf16*)(F.ws + WS_XB), (size_t)M * D / 4, gt, ngt);
    float* rope = (float*)(F.ws + WS_ROPE);
    for (int e = gt; e < SEQ * 64; e += ngt) {
        const int pos = e >> 6, i = e & 63;
        const float inv = exp2f(-(float)i * (13.287712379549449f / 64.f));
        const float ang = (float)pos * inv;
        const float k = rintf(ang * 0.15915494309189535f);
        float r = fmaf(-k, 6.2831854820251465f, ang); r = fmaf(-k, -1.7484555314695172e-07f, r);
        rope[2 * e] = cosf(r); rope[2 * e + 1] = sinf(r);
    }
}

__device__ __forceinline__ void p2_retention_naive(Frame& F) {
    const bf16* PROJ = (const bf16*)(F.ws + WS_PROJ); bf16* MIX = (bf16*)(F.ws + WS_MIX);
    LAS float* S = (LAS float*)(F.lds + RING_OFF); LAS float* ST = S + 128 * 128;
    const float* gn_g = F.in[2]; const float* gn_b = F.in[3];
    const int t = F.tid;
    for (int u = (int)blockIdx.x; u < BATCH * 4; u += F.G) {
        const int b = u >> 2, h = u & 3;
        const float gam = 1.f - exp2f(-5.f - (float)h); const float l2g = log2f(gam);
        for (int e = t; e < 128 * 128; e += NWAVES * 64) ST[e] = 0.f;
        __syncthreads();
        for (int c = 0; c < 16; ++c) {
            const size_t rb = (size_t)b * SEQ + c * 128;
            {
                const int i = t >> 2, jq = t & 3;
                const GAS v4u* qp = (const GAS v4u*)(PROJ + (rb + i) * NPROJ + C_RQ + h * 128);
#pragma unroll 1
                for (int jj = 0; jj < 32; ++jj) { const int j = jq * 32 + jj; float s = 0.f;
                    if (j <= i) { const GAS v4u* kp = (const GAS v4u*)(PROJ + (rb + j) * NPROJ + C_RK + h * 128);
#pragma unroll
                        for (int d = 0; d < 16; ++d) s = dot8(qp[d], kp[d], s);
                        s *= exp2f((float)(i - j) * l2g); }
                    S[i * 128 + j] = s; }
            }
            __syncthreads();
            {
                const int i = t >> 2, vq = t & 3;
                float o[32];
#pragma unroll
                for (int v = 0; v < 32; ++v) o[v] = 0.f;
#pragma unroll 2
                for (int j = 0; j <= i; ++j) { const float sij = S[i * 128 + j];
                    const GAS v4u* vp = (const GAS v4u*)(PROJ + (rb + j) * NPROJ + C_RV + h * 128 + vq * 32);
#pragma unroll
                    for (int q4 = 0; q4 < 4; ++q4) { const v4u w = vp[q4];
                        o[q4 * 8 + 0] = fmaf(sij, bflo(w.x), o[q4 * 8 + 0]); o[q4 * 8 + 1] = fmaf(sij, bfhi(w.x), o[q4 * 8 + 1]);
                        o[q4 * 8 + 2] = fmaf(sij, bflo(w.y), o[q4 * 8 + 2]); o[q4 * 8 + 3] = fmaf(sij, bfhi(w.y), o[q4 * 8 + 3]);
                        o[q4 * 8 + 4] = fmaf(sij, bflo(w.z), o[q4 * 8 + 4]); o[q4 * 8 + 5] = fmaf(sij, bfhi(w.z), o[q4 * 8 + 5]);
                        o[q4 * 8 + 6] = fmaf(sij, bflo(w.w), o[q4 * 8 + 6]); o[q4 * 8 + 7] = fmaf(sij, bfhi(w.w), o[q4 * 8 + 7]); } }
                const float dq = exp2f((float)(i + 1) * l2g);
                const GAS unsigned short* qrow = (const GAS unsigned short*)(PROJ + (rb + i) * NPROJ + C_RQ + h * 128);
#pragma unroll 2
                for (int d = 0; d < 128; ++d) { const float qd = bf2f(qrow[d]) * dq; const LAS float* sp = ST + d * 128 + vq * 32;
#pragma unroll
                    for (int v = 0; v < 32; ++v) o[v] = fmaf(qd, sp[v], o[v]); }
                float sm = 0.f;
#pragma unroll
                for (int v = 0; v < 32; ++v) sm += o[v];
                sm += __shfl_xor(sm, 1); sm += __shfl_xor(sm, 2);
                const float mu = sm * (1.f / 128.f); float q2 = 0.f;
#pragma unroll
                for (int v = 0; v < 32; ++v) { const float dlt = o[v] - mu; q2 += dlt * dlt; }
                q2 += __shfl_xor(q2, 1); q2 += __shfl_xor(q2, 2);
                const float rstd = 1.f / sqrtf(q2 * (1.f / 128.f) + LN_EPS);
                const GAS unsigned short* grow = (const GAS unsigned short*)(PROJ + (rb + i) * NPROJ + C_RG + h * 128 + vq * 32);
                GAS unsigned short* mrow = (GAS unsigned short*)(MIX + (rb + i) * D + h * 128 + vq * 32);
#pragma unroll
                for (int v = 0; v < 32; ++v) { const int ch = h * 128 + vq * 32 + v; const float r = bf2f(grow[v]) * ((o[v] - mu) * rstd * gn_g[ch] + gn_b[ch]); mrow[v] = (unsigned short)f2bf(r); }
            }
            __syncthreads();
            {
                const int d = t >> 2, vq = t & 3;
                float a[32];
                const float dc = exp2f(128.f * l2g);
                LAS float* sp = ST + d * 128 + vq * 32;
#pragma unroll
                for (int v = 0; v < 32; ++v) a[v] = sp[v] * dc;
#pragma unroll 2
                for (int j = 0; j < 128; ++j) { const float kd = bf2f(((const GAS unsigned short*)PROJ)[(rb + j) * NPROJ + C_RK + h * 128 + d]) * exp2f((float)(127 - j) * l2g);
                    const GAS v4u* vp = (const GAS v4u*)(PROJ + (rb + j) * NPROJ + C_RV + h * 128 + vq * 32);
#pragma unroll
                    for (int q4 = 0; q4 < 4; ++q4) { const v4u w = vp[q4];
                        a[q4 * 8 + 0] = fmaf(kd, bflo(w.x), a[q4 * 8 + 0]); a[q4 * 8 + 1] = fmaf(kd, bfhi(w.x), a[q4 * 8 + 1]);
                        a[q4 * 8 + 2] = fmaf(kd, bflo(w.y), a[q4 * 8 + 2]); a[q4 * 8 + 3] = fmaf(kd, bfhi(w.y), a[q4 * 8 + 3]);
                        a[q4 * 8 + 4] = fmaf(kd, bflo(w.z), a[q4 * 8 + 4]); a[q4 * 8 + 5] = fmaf(kd, bfhi(w.z), a[q4 * 8 + 5]);
                        a[q4 * 8 + 6] = fmaf(kd, bflo(w.w), a[q4 * 8 + 6]); a[q4 * 8 + 7] = fmaf(kd, bfhi(w.w), a[q4 * 8 + 7]); } }
#pragma unroll
                for (int v = 0; v < 32; ++v) sp[v] = a[v];
            }
            __syncthreads();
        }
    }
}

__device__ __forceinline__ float diff_lambda(Frame& F) {
    const float a = wave_sum(F.in[4][F.lane] * F.in[5][F.lane]); const float b = wave_sum(F.in[6][F.lane] * F.in[7][F.lane]);
    return expf(a) - expf(b) + LAMBDA_INIT;
}
__device__ __forceinline__ void p2_diffattn_naive(Frame& F) {
    const bf16* PROJ = (const bf16*)(F.ws + WS_PROJ); bf16* MIX = (bf16*)(F.ws + WS_MIX);
    LAS float* sb = (LAS float*)(F.lds + RING_OFF) + F.wave * 2048;
    const float lam = diff_lambda(F);
    const float* sg = F.in[8];
    const int gw = (int)blockIdx.x * NWAVES + F.wave, NGW = F.G * NWAVES;
    const int lane = F.lane;
    for (int task = gw; task < BATCH * 4 * SEQ; task += NGW) {
        const int i = task >> 6, bh = task & 63, b = bh >> 2, h = bh & 3;
        const size_t rb = (size_t)b * SEQ;
        float oc[2][2];
#pragma unroll
        for (int c = 0; c < 2; ++c) {
            const GAS v4u* qp = (const GAS v4u*)(PROJ + (rb + i) * NPROJ + C_DQ + h * 128 + c * 64);
            v4u q[8];
#pragma unroll
            for (int d = 0; d < 8; ++d) q[d] = qp[d];
            float mx = -INFINITY;
#pragma unroll 1
            for (int j0 = 0; j0 <= i; j0 += 64) { const int j = j0 + lane;
                if (j <= i) { const GAS v4u* kp = (const GAS v4u*)(PROJ + (rb + j) * NPROJ + C_DK + h * 128 + c * 64); float s = 0.f;
#pragma unroll
                    for (int d = 0; d < 8; ++d) s = dot8(q[d], kp[d], s);
                    sb[j] = s; mx = fmaxf(mx, s); } }
            mx = wave_max(mx);
            float l = 0.f;
            for (int j0 = 0; j0 <= i; j0 += 64) { const int j = j0 + lane; if (j <= i) { const float p = exp2f(sb[j] - mx); sb[j] = p; l += p; } }
            l = wave_sum(l);
            LDS_WAIT(); asm volatile("" ::: "memory");
            float o0 = 0.f, o1 = 0.f;
            const GAS unsigned* vp = (const GAS unsigned*)(PROJ + rb * NPROJ + C_DV + h * 128) + lane;
#pragma unroll 4
            for (int j = 0; j <= i; ++j) { const float p = sb[j]; const unsigned w = vp[(size_t)j * (NPROJ / 2)]; o0 = fmaf(p, bflo(w), o0); o1 = fmaf(p, bfhi(w), o1); }
            const float rl = 1.f / l; oc[c][0] = o0 * rl; oc[c][1] = o1 * rl;
            LDS_WAIT(); asm volatile("" ::: "memory");
        }
        const float d0 = oc[0][0] - lam * oc[1][0], d1 = oc[0][1] - lam * oc[1][1];
        const float ms = wave_sum(d0 * d0 + d1 * d1) * (1.f / 128.f);
        const float rs = (1.f - LAMBDA_INIT) / sqrtf(ms + LN_EPS);
        const int ch = h * 128 + 2 * lane;
        ((GAS unsigned*)(MIX + (rb + i) * D + 512 + h * 128))[lane] = pk2(d0 * rs * sg[ch], d1 * rs * sg[ch + 1]);
    }
}


struct DiffUnit { int b, h, qb, c, hf; };
struct DiffOrder {
    int pu;
    __device__ __forceinline__ bool next(int i, DiffUnit& u) const { if (i >= 8) return false; const int bh = pu >> 2, s = pu & 3; u.b = bh >> 2; u.h = bh & 3; u.qb = (i >> 2) ? s : 7 - s; u.c = (i >> 1) & 1; u.hf = i & 1; return true; }
};
__device__ __forceinline__ void diff_combine(Frame& F, const DiffUnit& u) {
    VM_WAIT();
    const float lam = diff_lambda(F);
    const float* sg = F.in[8] + u.h * 128 + 2 * F.lane;
    const float g0 = sg[0], g1 = sg[1];
    const size_t row0 = (size_t)u.b * SEQ + u.qb * 256 + F.wave * 32;
    const GAS unsigned* op = (const GAS unsigned*)((const bf16*)(F.ws + WS_DOUT) + row0 * 1024 + u.h * 256) + F.lane;
    GAS unsigned* mp = (GAS unsigned*)((bf16*)(F.ws + WS_MIX) + row0 * D + 512 + u.h * 128) + F.lane;
#pragma unroll 4
    for (int r = 0; r < 32; ++r) {
        const unsigned w1 = op[r * 512], w2 = op[r * 512 + 64];
        const float d0 = bflo(w1) - lam * bflo(w2), d1 = bfhi(w1) - lam * bfhi(w2);
        const float ms = wave_sum(d0 * d0 + d1 * d1) * (1.f / 128.f);
        const float rs = (1.f - LAMBDA_INIT) / sqrtf(ms + LN_EPS);
        mp[r * 512] = pk2(d0 * rs * g0, d1 * rs * g1);
    }
}
template <class Sched> __device__ __forceinline__ void diff_phase(Frame& F, char* lds, const attn_body::bf16* P, attn_body::bf16* O, const Sched& S) {
    DiffUnit u;
    for (int i = 0; S.next(i, u); ++i) { const attn_body::bf16* Ph = P + u.h * 128;
        attn_body::attn_unit<8>(u.b, u.qb, Ph + C_DQ + u.c * 64, Ph + C_DK + u.c * 64, Ph + C_DV + u.hf * 64, O + u.h * 256 + u.c * 128 + u.hf * 64, lds);
    }
}
__device__ __forceinline__ void p2_diffattn(Frame& F, char* lds_generic) {
    const DiffOrder S{F.vcu};
    diff_phase<DiffOrder>(F, lds_generic, (const attn_body::bf16*)(F.ws + WS_PROJ), (attn_body::bf16*)(F.ws + WS_DOUT), S);
    DiffUnit u;
    S.next(3, u); diff_combine(F, u);
    S.next(7, u); diff_combine(F, u);
}
__device__ __forceinline__ void p3_ln1_rows(Frame& F) {
    const float* Y = F.out; bf16* X1 = (bf16*)(F.ws + WS_X1); const float* g = F.in[10]; const float* bb = F.in[11];
    const int gw = (int)blockIdx.x * NWAVES + F.wave, NGW = F.G * NWAVES;
    for (int m = gw; m < M; m += NGW) {
        const GAS f32x4* xr = (const GAS f32x4*)(Y + (size_t)m * D) + F.lane;
        f32x4 v[4]; float s = 0.f;
#pragma unroll
        for (int j = 0; j < 4; ++j) { v[j] = xr[64 * j]; s += (v[j].x + v[j].y) + (v[j].z + v[j].w); }
        const float mean = wave_sum(s) * (1.f / D); float s2 = 0.f;
#pragma unroll
        for (int j = 0; j < 4; ++j) { v[j] = v[j] - mean; s2 += (v[j].x * v[j].x + v[j].y * v[j].y) + (v[j].z * v[j].z + v[j].w * v[j].w); }
        const float rstd = 1.f / sqrtf(wave_sum(s2) * (1.f / D) + LN_EPS);
        GAS unsigned long long* o8 = (GAS unsigned long long*)(X1 + (size_t)m * D) + F.lane;
#pragma unroll
        for (int j = 0; j < 4; ++j) { const f32x4 gg = ((const GAS f32x4*)g)[F.lane + 64 * j], bv = ((const GAS f32x4*)bb)[F.lane + 64 * j]; const f32x4 r = v[j] * rstd * gg + bv;
            o8[64 * j] = (unsigned long long)pk2(r.x, r.y) | ((unsigned long long)pk2(r.z, r.w) << 32); }
    }
}

__device__ __forceinline__ void argmax_step(float& v, int& i) {
#pragma unroll
    for (int o = 1; o < 64; o <<= 1) { const float ov = __shfl_xor(v, o); const int oi = __shfl_xor(i, o); if (ov > v || (ov == v && oi < i)) { v = ov; i = oi; } }
}
__device__ __forceinline__ void p5_topk_naive(Frame& F) {
    const bf16* QP = (const bf16*)(F.ws + WS_QP); const bf16* SK = (const bf16*)(F.ws + WS_SK);
    int* IDX = (int*)(F.ws + WS_IDX); float* GATE = (float*)(F.ws + WS_GATE);
    const int gw = (int)blockIdx.x * NWAVES + F.wave, NGW = F.G * NWAVES; const int lane = F.lane;
    for (int task = gw; task < M * 8; task += NGW) {
        const int t = task >> 3, h = task & 7;
        float ts[2]; int ti[2];
#pragma unroll
        for (int c = 0; c < 2; ++c) {
            const GAS v4u* qp = (const GAS v4u*)(QP + (size_t)t * NQ + h * 256 + c * 128);
            const GAS v4u* k0p = (const GAS v4u*)(SK + ((size_t)(h * 2 + c) * 128 + lane) * 128);
            const GAS v4u* k1p = (const GAS v4u*)(SK + ((size_t)(h * 2 + c) * 128 + lane + 64) * 128);
            float s0 = 0.f, s1 = 0.f;
#pragma unroll
            for (int d = 0; d < 16; ++d) { const v4u q = qp[d]; s0 = dot8(q, k0p[d], s0); s1 = dot8(q, k1p[d], s1); }
            float mys = 0.f; int myi = 0;
            for (int r = 0; r < 16; ++r) {
                float v = fmaxf(s0, s1); int ix = (s0 >= s1) ? lane : lane + 64;
                argmax_step(v, ix);
                if (lane == r) { mys = v; myi = ix; }
                if ((ix & 63) == lane) { if (ix < 64) s0 = -INFINITY; else s1 = -INFINITY; }
            }
            ts[c] = mys; ti[c] = myi;
        }
        float cs[4]; int ci[4];
#pragma unroll
        for (int q = 0; q < 4; ++q) { const int a = (lane >> 4) + 4 * q, bq = lane & 15; cs[q] = __shfl(ts[0], a) + __shfl(ts[1], bq); ci[q] = __shfl(ti[0], a) * 128 + __shfl(ti[1], bq); }
        float bs = 0.f; int be = 0;
        {
            LAS float* bsl = (LAS float*)(F.lds + RING_OFF) + F.wave * 32; LAS int* bel = (LAS int*)(bsl + 16);
            int rk[4] = {0, 0, 0, 0};
            for (int k = 0; k < 64; ++k) {
#pragma unroll
                for (int qq = 0; qq < 4; ++qq) { const float av = __shfl(cs[qq], k); const int an = k + 64 * qq;
#pragma unroll
                    for (int q = 0; q < 4; ++q) { const int n = lane + 64 * q; rk[q] += (av > cs[q] || (av == cs[q] && an < n)) ? 1 : 0; } } }
#pragma unroll
            for (int q = 0; q < 4; ++q) if (rk[q] < 16) { bsl[rk[q]] = cs[q]; bel[rk[q]] = ci[q]; }
            LDS_WAIT(); asm volatile("" ::: "memory");
            bs = bsl[lane & 15]; be = bel[lane & 15];
            LDS_WAIT(); asm volatile("" ::: "memory");
        }
        const float mx = __shfl(bs, 0);
        float ex = expf(bs - mx); float sm = ex;
        sm += __shfl_xor(sm, 1); sm += __shfl_xor(sm, 2); sm += __shfl_xor(sm, 4); sm += __shfl_xor(sm, 8);
        if (lane < 16) { IDX[(size_t)t * NSEL + h * 16 + lane] = be; GATE[(size_t)t * NSEL + h * 16 + lane] = ex / sm; }
    }
}

__device__ __forceinline__ void unpack8(v4u w, float* f) { f[0] = bflo(w.x); f[1] = bfhi(w.x); f[2] = bflo(w.y); f[3] = bfhi(w.y); f[4] = bflo(w.z); f[5] = bfhi(w.z); f[6] = bflo(w.w); f[7] = bfhi(w.w); }
__device__ __forceinline__ void p6_experts_naive(Frame& F) {
    const bf16* X1 = (const bf16*)(F.ws + WS_X1); const bf16* PU = (const bf16*)(F.ws + WS_PU); const bf16* PV = (const bf16*)(F.ws + WS_PV);
    const int* IDX = (const int*)(F.ws + WS_IDX); const float* GATE = (const float*)(F.ws + WS_GATE);
    const float* g2 = F.in[16]; const float* b2 = F.in[17];
    const int gw = (int)blockIdx.x * NWAVES + F.wave, NGW = F.G * NWAVES; const int lane = F.lane;
    for (int t = gw; t < M; t += NGW) {
        float x[16], acc[16];
        { const GAS v4u* xp = (const GAS v4u*)(X1 + (size_t)t * D); unpack8(xp[lane], x); unpack8(xp[64 + lane], x + 8); }
#pragma unroll
        for (int k = 0; k < 16; ++k) acc[k] = 0.f;
#pragma unroll 2
        for (int e = 0; e < NSEL; ++e) {
            const int idx = IDX[(size_t)t * NSEL + e]; const float gt = GATE[(size_t)t * NSEL + e];
            const GAS v4u* up = (const GAS v4u*)(PU + (size_t)idx * D); const GAS v4u* vp = (const GAS v4u*)(PV + (size_t)idx * D);
            const v4u u0 = up[lane], u1 = up[64 + lane], v0 = vp[lane], v1 = vp[64 + lane];
            float uf[16]; unpack8(u0, uf); unpack8(u1, uf + 8);
            float s = 0.f;
#pragma unroll
            for (int k = 0; k < 16; ++k) s = fmaf(x[k], uf[k], s);
            s = wave_sum(s);
            const float w = gt * 0.5f * s * (1.f + erff(s * 0.7071067811865476f));
            float vf[16]; unpack8(v0, vf); unpack8(v1, vf + 8);
#pragma unroll
            for (int k = 0; k < 16; ++k) acc[k] = fmaf(w, vf[k], acc[k]);
        }
        float sm = 0.f;
#pragma unroll
        for (int k = 0; k < 16; ++k) { acc[k] = fmaf(ALPHA, x[k], acc[k]); sm += acc[k]; }
        const float mean = wave_sum(sm) * (1.f / D); float q2 = 0.f;
#pragma unroll
        for (int k = 0; k < 16; ++k) { acc[k] -= mean; q2 += acc[k] * acc[k]; }
        const float rstd = 1.f / sqrtf(wave_sum(q2) * (1.f / D) + LN_EPS);
        GAS f32x4* op = (GAS f32x4*)(F.out + (size_t)t * D);
#pragma unroll
        for (int hf = 0; hf < 2; ++hf)
#pragma unroll
            for (int q4 = 0; q4 < 2; ++q4) { const int c0 = hf * 512 + lane * 8 + q4 * 4; const f32x4 gg = *(const GAS f32x4*)(g2 + c0), bv = *(const GAS f32x4*)(b2 + c0);
                f32x4 r; r.x = acc[hf * 8 + q4 * 4 + 0] * rstd * gg.x + bv.x; r.y = acc[hf * 8 + q4 * 4 + 1] * rstd * gg.y + bv.y; r.z = acc[hf * 8 + q4 * 4 + 2] * rstd * gg.z + bv.z; r.w = acc[hf * 8 + q4 * 4 + 3] * rstd * gg.w + bv.w;
                op[c0 / 4] = r; }
    }
}


typedef float f32x16_t __attribute__((ext_vector_type(16)));
__device__ __forceinline__ int enc_key(float f) { const int u = __builtin_bit_cast(int, f); return u ^ ((u >> 31) & 0x7fffffff); }
__device__ __forceinline__ float dec_key(int k) { return __builtin_bit_cast(float, k ^ ((k >> 31) & 0x7fffffff)); }
__device__ __forceinline__ int pair_max(int m) { const auto rr = __builtin_amdgcn_permlane32_swap((unsigned)m, (unsigned)m, false, false); const int a = (int)rr[0], b = (int)rr[1]; return a > b ? a : b; }
__device__ __forceinline__ unsigned offb(unsigned row, unsigned ch) { return 256u * row + 16u * (ch ^ (((row & 3u) << 2) | ((row >> 2) & 3u))); }
__device__ __forceinline__ void p5_topk_fast(Frame& F) {
    constexpr int PI[50] = {0, 0, 0, 0, 0, 0, 0, 0, 0, 0, 0, 0, 0, 0, 0, 0, 1, 1, 1, 1, 1, 1, 1, 1, 2, 2, 2, 2, 2, 3, 3, 3, 3, 4, 4, 4, 5, 5, 6, 6, 7, 7, 8, 9, 10, 11, 12, 13, 14, 15};
    constexpr int PJ[50] = {0, 1, 2, 3, 4, 5, 6, 7, 8, 9, 10, 11, 12, 13, 14, 15, 0, 1, 2, 3, 4, 5, 6, 7, 0, 1, 2, 3, 4, 0, 1, 2, 3, 0, 1, 2, 0, 1, 0, 1, 0, 1, 0, 0, 0, 0, 0, 0, 0, 0};
    const bf16* QP = (const bf16*)(F.ws + WS_QP); const bf16* SK = (const bf16*)(F.ws + WS_SK);
    int* IDX = (int*)(F.ws + WS_IDX); float* GATE = (float*)(F.ws + WS_GATE);
    LAS unsigned char* skl = F.lds + RING_OFF;
    const int h = F.vcu & 7;
    for (int n = F.tid; n < 4096; n += NWAVES * 64) { const unsigned row = (unsigned)n >> 4, ch = (unsigned)n & 15u;
        const v4u v = *(const GAS v4u*)(SK + ((size_t)h * 256 + row) * 128 + ch * 8); *(LAS v4u*)(skl + offb(row, ch)) = v; }
    __syncthreads();
    LAS int* TOP = (LAS int*)(F.lds + RING_OFF + 65536 + F.wave * 4096);
    LAS unsigned short* EIDX = (LAS unsigned short*)TOP;
    LAS int* WIN = (LAS int*)(F.lds + RING_OFF + 98304 + F.wave * 2048);
    const int lane = F.lane, tok = lane & 31, hi = lane >> 5;
    const int IMIN = (int)0x80000000;
#pragma unroll 1
    for (int tile = F.vcu >> 3; tile < M / 256; tile += F.G >> 3) {
        const size_t token = (size_t)tile * 256 + F.wave * 32 + tok;
#pragma unroll 1
        for (int c = 0; c < 2; ++c) {
            f32x16_t acc[4];
#pragma unroll
            for (int kb = 0; kb < 4; ++kb) acc[kb] = f32x16_t{};
            const bf16* qrow = QP + token * NQ + h * 256 + c * 128 + 8 * hi;
#pragma unroll
            for (int sst = 0; sst < 8; ++sst) { const bf16x8 bq = *(const GAS bf16x8*)(qrow + 16 * sst);
#pragma unroll
                for (int kb = 0; kb < 4; ++kb) { const bf16x8 a = *(const LAS bf16x8*)(skl + offb((unsigned)(c * 128 + 32 * kb + tok), (unsigned)(2 * sst + hi)));
                    acc[kb] = __builtin_amdgcn_mfma_f32_32x32x16_bf16(a, bq, acc[kb], 0, 0, 0); } }
            int k[64];
#pragma unroll
            for (int kb = 0; kb < 4; ++kb)
#pragma unroll
                for (int r = 0; r < 16; ++r) { const int kidx = 32 * kb + (r & 3) + 8 * (r >> 2) + 4 * hi; k[kb * 16 + r] = (enc_key(acc[kb][r]) & ~127) | (127 - kidx); }
            int prev = 0x7fffffff;
#pragma unroll 1
            for (int r = 0; r < 16; ++r) {
                int m = IMIN;
#pragma unroll
                for (int i = 0; i < 64; ++i) { const int t = k[i] < prev ? k[i] : IMIN; m = t > m ? t : m; }
                m = pair_max(m);
                TOP[(c * 16 + r) * 32 + tok] = m;
                prev = m;
            }
        }
        LDS_WAIT(); asm volatile("" ::: "memory");
        int a[16], b[16]; float af[16], bf_[16];
#pragma unroll
        for (int i = 0; i < 16; ++i) { a[i] = TOP[i * 32 + tok]; b[i] = TOP[(16 + i) * 32 + tok]; }
        LDS_WAIT(); asm volatile("" ::: "memory");
#pragma unroll
        for (int i = 0; i < 16; ++i) { af[i] = dec_key(a[i] & ~127); bf_[i] = dec_key(b[i] & ~127); a[i] = 127 - (a[i] & 127); b[i] = 127 - (b[i] & 127); }
        int ck[25];
#pragma unroll
        for (int n = 0; n < 25; ++n) { const int i0 = PI[2 * n], j0 = PJ[2 * n], i1 = PI[2 * n + 1], j1 = PJ[2 * n + 1];
            const float s0 = af[i0] + bf_[j0], s1 = af[i1] + bf_[j1]; const int e0 = a[i0] * 128 + b[j0], e1 = a[i1] * 128 + b[j1];
            const float sv = hi ? s1 : s0; const int ev = hi ? e1 : e0; const int id = 2 * n + hi;
            ck[n] = (enc_key(sv) & ~63) | (63 - id); EIDX[tok * 64 + id] = (unsigned short)ev; }
        int prev = 0x7fffffff;
#pragma unroll 1
        for (int r = 0; r < 16; ++r) {
            int m = IMIN;
#pragma unroll
            for (int i = 0; i < 25; ++i) { const int t = ck[i] < prev ? ck[i] : IMIN; m = t > m ? t : m; }
            m = pair_max(m);
            WIN[r * 32 + tok] = m;
            prev = m;
        }
        LDS_WAIT(); asm volatile("" ::: "memory");
        int w[16]; float e[16];
#pragma unroll
        for (int r = 0; r < 16; ++r) w[r] = WIN[r * 32 + tok];
        LDS_WAIT(); asm volatile("" ::: "memory");
        const float mx = dec_key(w[0] & ~63); float sm = 0.f;
#pragma unroll
        for (int r = 0; r < 16; ++r) { e[r] = __builtin_amdgcn_exp2f((dec_key(w[r] & ~63) - mx) * 1.4426950408889634f); sm += e[r]; }
        const float inv = 1.f / sm;
        int oi[8]; float og[8];
#pragma unroll
        for (int q = 0; q < 8; ++q) { const int wq = hi ? w[8 + q] : w[q]; const float eq = hi ? e[8 + q] : e[q]; oi[q] = (int)EIDX[tok * 64 + (63 - (wq & 63))]; og[q] = eq * inv; }
        LDS_WAIT(); asm volatile("" ::: "memory");
        int* ip = IDX + token * NSEL + h * 16 + 8 * hi; float* gp = GATE + token * NSEL + h * 16 + 8 * hi;
        typedef int i32x4 __attribute__((ext_vector_type(4)));
        *(GAS i32x4*)ip = (i32x4){oi[0], oi[1], oi[2], oi[3]}; *(GAS i32x4*)(ip + 4) = (i32x4){oi[4], oi[5], oi[6], oi[7]};
        *(GAS f32x4*)gp = (f32x4){og[0], og[1], og[2], og[3]}; *(GAS f32x4*)(gp + 4) = (f32x4){og[4], og[5], og[6], og[7]};
    }
    __syncthreads();
}
typedef __bf16 bf16x2_t __attribute__((ext_vector_type(2)));
__device__ __forceinline__ float dot2bf(unsigned a, unsigned b, float c) { return __builtin_amdgcn_fdot2_f32_bf16(__builtin_bit_cast(bf16x2_t, a), __builtin_bit_cast(bf16x2_t, b), c, false); }
__device__ __forceinline__ float dot8p(v4u a, v4u b, float s) { s = dot2bf(a.x, b.x, s); s = dot2bf(a.y, b.y, s); s = dot2bf(a.z, b.z, s); return dot2bf(a.w, b.w, s); }
__device__ __forceinline__ float gelu_erf(float v) {
    const float av = fabsf(v), t = __builtin_amdgcn_rcpf(fmaf(av, 0.2316418882f, 1.0f));
    float q = fmaf(t, 0.5307027145f, -0.7265760135f); q = fmaf(q, t, 0.7107068705f); q = fmaf(q, t, -0.142248368f); q = fmaf(q, t, 0.127414796f); q = q * t;
    const float e = __builtin_amdgcn_exp2f(v * v * -0.72134752044f);
    const float m = v * (q * e);
    return v < 0.f ? m : v - m;
}
#define ACC8(A, W, S, O) do { A[O + 0] = fmaf(S, bflo(W.x), A[O + 0]); A[O + 1] = fmaf(S, bfhi(W.x), A[O + 1]); A[O + 2] = fmaf(S, bflo(W.y), A[O + 2]); A[O + 3] = fmaf(S, bfhi(W.y), A[O + 3]); \
                               A[O + 4] = fmaf(S, bflo(W.z), A[O + 4]); A[O + 5] = fmaf(S, bfhi(W.z), A[O + 5]); A[O + 6] = fmaf(S, bflo(W.w), A[O + 6]); A[O + 7] = fmaf(S, bfhi(W.w), A[O + 7]); } while (0)
__device__ __forceinline__ void p6_experts(Frame& F) {
    const bf16* X1 = (const bf16*)(F.ws + WS_X1); const bf16* PU = (const bf16*)(F.ws + WS_PU); const bf16* PV = (const bf16*)(F.ws + WS_PV);
    const int* IDX = (const int*)(F.ws + WS_IDX); const float* GATE = (const float*)(F.ws + WS_GATE);
    const float* g2 = F.in[16]; const float* b2 = F.in[17];
    const int gw = (int)blockIdx.x * NWAVES + F.wave, NGW = F.G * NWAVES;
    const int e_of_lane = (F.lane >> 3) & 7; const bool h5 = F.lane >= 32, h4 = (F.lane >> 4) & 1, h3 = (F.lane >> 3) & 1;
#pragma unroll 1
    for (int t = gw; t < M; t += NGW) {
        int lane = F.lane; asm volatile("" : "+v"(lane));
        const GAS v4u* xp = (const GAS v4u*)(X1 + (size_t)t * D); const v4u xa = xp[lane], xb = xp[64 + lane];
        const int ilo = IDX[(size_t)t * NSEL + lane], ihi = IDX[(size_t)t * NSEL + 64 + lane];
        const float glo = GATE[(size_t)t * NSEL + lane], ghi = GATE[(size_t)t * NSEL + 64 + lane];
        float acc[16];
#pragma unroll
        for (int k = 0; k < 16; ++k) acc[k] = 0.f;
        v4u ua[8], ub[8], va[8], vb[8];
#pragma unroll
        for (int k = 0; k < 8; ++k) { const int idx = __builtin_amdgcn_readlane(ilo, k); const GAS v4u* up = (const GAS v4u*)(PU + (size_t)idx * D); ua[k] = up[lane]; ub[k] = up[64 + lane];
            const GAS v4u* vp = (const GAS v4u*)(PV + (size_t)idx * D); va[k] = vp[lane]; vb[k] = vp[64 + lane]; }
#pragma unroll 1
        for (int bb = 0; bb < 16; ++bb) {
            float s[8];
#pragma unroll
            for (int k = 0; k < 8; ++k) { s[k] = dot8p(xb, ub[k], dot8p(xa, ua[k], 0.f)); __builtin_amdgcn_sched_barrier(0); }
            const int nb = bb + 1; const int isrc_n = nb < 8 ? ilo : ihi;
            if (nb < 16) {
#pragma unroll
                for (int k = 0; k < 8; ++k) { const int idx = __builtin_amdgcn_readlane(isrc_n, (nb & 7) * 8 + k); const GAS v4u* up = (const GAS v4u*)(PU + (size_t)idx * D); ua[k] = up[lane]; ub[k] = up[64 + lane]; }
            }
            float r4[4], r2[2], z;
#pragma unroll
            for (int i = 0; i < 4; ++i) { const float send = h5 ? s[i] : s[i + 4], keep = h5 ? s[i + 4] : s[i]; r4[i] = keep + __shfl_xor(send, 32); }
#pragma unroll
            for (int i = 0; i < 2; ++i) { const float send = h4 ? r4[i] : r4[i + 2], keep = h4 ? r4[i + 2] : r4[i]; r2[i] = keep + __shfl_xor(send, 16); }
            { const float send = h3 ? r2[0] : r2[1], keep = h3 ? r2[1] : r2[0]; z = keep + __shfl_xor(send, 8); }
            z += __shfl_xor(z, 4); z += __shfl_xor(z, 2); z += __shfl_xor(z, 1);
            const float gsrc = bb < 8 ? glo : ghi;
            const float w = __shfl(gsrc, (bb & 7) * 8 + e_of_lane) * gelu_erf(z);
#pragma unroll
            for (int k = 0; k < 8; ++k) { const float wk = __builtin_bit_cast(float, __builtin_amdgcn_readlane(__builtin_bit_cast(int, w), 8 * k)); ACC8(acc, va[k], wk, 0); ACC8(acc, vb[k], wk, 8); __builtin_amdgcn_sched_barrier(0); }
            if (nb < 16) {
#pragma unroll
                for (int k = 0; k < 8; ++k) { const int idx = __builtin_amdgcn_readlane(isrc_n, (nb & 7) * 8 + k); const GAS v4u* vp = (const GAS v4u*)(PV + (size_t)idx * D); va[k] = vp[lane]; vb[k] = vp[64 + lane]; }
            }
        }
        float x[16]; unpack8(xa, x); unpack8(xb, x + 8);
        float sm = 0.f;
#pragma unroll
        for (int k = 0; k < 16; ++k) { acc[k] = fmaf(ALPHA, x[k], acc[k]); sm += acc[k]; }
        const float mean = wave_sum(sm) * (1.f / D); float q2 = 0.f;
#pragma unroll
        for (int k = 0; k < 16; ++k) { acc[k] -= mean; q2 += acc[k] * acc[k]; }
        const float rstd = 1.f / sqrtf(wave_sum(q2) * (1.f / D) + LN_EPS);
        GAS f32x4* op = (GAS f32x4*)(F.out + (size_t)t * D);
#pragma unroll
        for (int hf = 0; hf < 2; ++hf)
#pragma unroll
            for (int q4 = 0; q4 < 2; ++q4) { const int c0 = hf * 512 + lane * 8 + q4 * 4; const f32x4 gg = *(const GAS f32x4*)(g2 + c0), bv = *(const GAS f32x4*)(b2 + c0);
                f32x4 r; r.x = acc[hf * 8 + q4 * 4 + 0] * rstd * gg.x + bv.x; r.y = acc[hf * 8 + q4 * 4 + 1] * rstd * gg.y + bv.y; r.z = acc[hf * 8 + q4 * 4 + 2] * rstd * gg.z + bv.z; r.w = acc[hf * 8 + q4 * 4 + 3] * rstd * gg.w + bv.w;
                op[c0 / 4] = r; }
    }
}
struct Args { const float* in[18]; float* out; unsigned char* ws; };
__global__ void __launch_bounds__(NWAVES * 64, 2) hymba_fwd(Args args) {
    extern __shared__ __attribute__((aligned(16))) unsigned char lds[];
    Frame F;
    F.lds = (LAS unsigned char*)lds;
    F.MISC = (volatile LAS unsigned*)(F.lds + MISC_OFF);
    F.tid = threadIdx.x; F.lane = F.tid & 63; F.wave = __builtin_amdgcn_readfirstlane(F.tid >> 6);
    F.G = gridDim.x; { const int bx = blockIdx.x; F.vcu = (F.G % 8 == 0) ? (bx % 8) * (F.G / 8) + bx / 8 : bx; }
    unsigned char* ws = args.ws; F.ws = ws; F.out = args.out;
    F.ctl = (gu32*)(ws + WS_CTL);
    F.in = args.in;
    for (int u = F.tid; u < (LDS_BYTES - LDSCTL_OFF) / 4; u += NWAVES * 64) ((LAS unsigned*)(F.lds + LDSCTL_OFF))[u] = 0u;
    __syncthreads();
    (void)xcd_barrier_post((unsigned*)F.ws + CW_BAR, F.MISC + 8);
#ifndef PHASE_MASK
#define PHASE_MASK 0xffff
#endif
#define IN(k) ((PHASE_MASK >> (k)) & 1)
#define BOTH(k) (IN(k) && IN((k) + 1))
#define GRID_BAR() do { XcdBarrier b_; b_.bar = (unsigned*)F.ws + CW_BAR; b_.x = xb_xcc_id(); b_.st = F.MISC + 8; xcd_barrier(b_); PHASE_FENCE(); } while (0)
#define PHASE_FENCE() do { asm volatile("" : "+v"(F.tid)); F.lane = F.tid & 63; } while (0)

    if (IN(0)) { p0_prologue(F); if (BOTH(0)) GRID_BAR(); }
    if (IN(1)) {
        pg8::Gemm g{(const bf16*)(ws + WS_XB), (const bf16*)(ws + WS_WIN), M, NPROJ, D}; pg8::StaticOrder S; S.init(M, NPROJ, F.G, (int)blockIdx.x);
        pg8::EpiProj E{(bf16*)(ws + WS_PROJ), NPROJ, (const float*)(ws + WS_ROPE), KSCALE, QSCALE};
        pg8::gemm_phase<pg8::EpiProj, pg8::StaticOrder, PG8_ALIGN, PG8_SP2>(F.lds + RING_OFF, g, S, E);
        if (BOTH(1)) GRID_BAR();
    }
    if (IN(2)) { p2_retention_naive(F); __syncthreads(); p2_diffattn(F, (char*)lds + RING_OFF); if (BOTH(2)) GRID_BAR(); }
    if (IN(3)) {
        pg8::Gemm g{(const bf16*)(ws + WS_MIX), (const bf16*)(ws + WS_WOUT), M, D, D}; pg8::StaticOrder S; S.init(M, D, F.G, (int)blockIdx.x);
        pg8::EpiResF32 E{F.in[0], F.out, D, ALPHA};
        pg8::gemm_phase<pg8::EpiResF32, pg8::StaticOrder, PG8_ALIGN, PG8_SP2>(F.lds + RING_OFF, g, S, E);
        if (BOTH(3)) GRID_BAR();
    }
    if (IN(4)) { p3_ln1_rows(F); if (BOTH(4)) GRID_BAR(); }
    if (IN(5)) {
        pg8::Gemm g{(const bf16*)(ws + WS_X1), (const bf16*)(ws + WS_WQ), M, NQ, D}; pg8::StaticOrder S; S.init(M, NQ, F.G, (int)blockIdx.x);
        pg8::EpiPlainBf16 E{(bf16*)(ws + WS_QP), NQ};
        pg8::gemm_phase<pg8::EpiPlainBf16, pg8::StaticOrder, PG8_ALIGN, PG8_SP2>(F.lds + RING_OFF, g, S, E);
        if (BOTH(5)) GRID_BAR();
    }
    if (IN(6)) { p5_topk_fast(F); if (BOTH(6)) GRID_BAR(); }
    if (IN(7)) { p6_experts(F); }
#undef IN
#undef BOTH
}

extern "C" void kernel_launch(void* const* d_in, const int* in_sizes, int n_in, void* d_out, int out_size, void* d_ws, size_t ws_size, hipStream_t stream) {
    static int grid = 0;
    if (grid == 0) {
        if (n_in != 18 || in_sizes[0] != M * D || out_size != M * D || ws_size < WS_END) { fprintf(stderr, "kernel_launch: unexpected shapes / workspace (n_in %d, in0 %d, out %d, ws %zu, need %zu); nothing launched\n", n_in, n_in > 0 ? in_sizes[0] : -1, out_size, ws_size, (size_t)WS_END); grid = -1; return; }
        int dev = 0, cus = 0, per_cu = 0;
        if (hipGetDevice(&dev) != hipSuccess || hipDeviceGetAttribute(&cus, hipDeviceAttributeMultiprocessorCount, dev) != hipSuccess) { fprintf(stderr, "kernel_launch: device query failed\n"); grid = -1; return; }
        if (hipFuncSetAttribute((const void*)hymba_fwd, hipFuncAttributeMaxDynamicSharedMemorySize, LDS_BYTES) != hipSuccess) { fprintf(stderr, "kernel_launch: hipFuncSetAttribute failed\n"); grid = -1; return; }
        if (hipOccupancyMaxActiveBlocksPerMultiprocessor(&per_cu, (const void*)hymba_fwd, NWAVES * 64, LDS_BYTES) != hipSuccess || per_cu < 1)
            fprintf(stderr, "kernel_launch: note: occupancy query reports %d workgroups per CU\n", per_cu);
        (void)hipGetLastError();
        grid = cus;
        if (grid != 256) fprintf(stderr, "kernel_launch: note: %d CUs (tuned for 256)\n", grid);
    }
    if (grid < 0) return;
    if (hipMemsetAsync((char*)d_ws + WS_CTL, 0, CTL_ZERO_BYTES, stream) != hipSuccess) { fprintf(stderr, "kernel_launch: memset failed\n"); return; }
    Args a{};
    for (int i = 0; i < 18; ++i) a.in[i] = (const float*)d_in[i];
    a.out = (float*)d_out; a.ws = (unsigned char*)d_ws;
    hipLaunchKernelGGL(hymba_fwd, dim3(grid), dim3(NWAVES * 64), LDS_BYTES, stream, a);
    const hipError_t le = hipPeekAtLastError();
    if (le != hipSuccess) fprintf(stderr, "kernel_launch: launch failed: %s\n", hipGetErrorName(le));
}
```

```cpp
#include <hip/hip_runtime.h>
#include <cstdio>
#include <cstdint>
#include <cmath>
namespace pg8 {
#define PG8_LAS __attribute__((address_space(3)))
typedef unsigned short bf16_t;
typedef short bf16x8 __attribute__((ext_vector_type(8)));
typedef float f32x4 __attribute__((ext_vector_type(4)));
typedef unsigned u32x4 __attribute__((ext_vector_type(4)));
constexpr int BM = 256, BK = 64, HALF = 128, HTB = HALF * BK * 2  , STAGE_BYTES = 8 * HTB, NXCD = 8, WGM = 8;

__host__ __device__ __forceinline__ int lds_byte(int r, int c) { const int st = (r >> 4) * 2 + (c >> 5), rr = r & 15, cc = c & 31, ob = rr * 64 + cc * 2; return st * 1024 + (ob ^ (((ob >> 9) & 1) << 5)); }
__host__ __device__ __forceinline__ void stage_rc(int b, int& R, int& C) { const int st = b / 1024, sb = b % 1024, swz = sb ^ (((sb >> 9) & 1) << 5); R = (st >> 1) * 16 + swz / 64; C = (st & 1) * 32 + (swz % 64) / 2; }
__host__ __device__ __forceinline__ int perm32(int rho) { const int n = rho >> 4, i = rho & 15; return 8 * (i >> 2) + 4 * n + (i & 3); }

struct Unit { int pm, pn; };
struct Gemm { const bf16_t* A; const bf16_t* Bt; int M, N, K; };

struct StaticOrder {
    int nM, nN, nwg, G, c;
    __host__ __device__ void init(int M, int N, int G_, int c_) { nM = M / BM; nN = N / BM; nwg = nM * nN; G = G_; c = c_; }
    __host__ __device__ bool next(int i, Unit& u) const {
        const long L = (long)i * G + c; if (L >= nwg) return false;
        int wgid = (int)L; { const int q = nwg / NXCD, r = nwg % NXCD, xcd = wgid % NXCD, off = wgid / NXCD; wgid = (xcd < r ? xcd * (q + 1) : r * (q + 1) + (xcd - r) * q) + off; }
        const int nig = WGM * nN, gid = wgid / nig, fm = gid * WGM, gsz = (nM - fm) < WGM ? (nM - fm) : WGM;
        u.pm = fm + ((wgid % nig) % gsz); u.pn = (wgid % nig) / gsz; return true;
    }
    __device__ __forceinline__ void a_ready(const Unit&) const {}
    __device__ __forceinline__ void done(const Unit&) const {}
};

__device__ __forceinline__ unsigned cvt_pk_bf16(float lo, float hi) { unsigned r; asm volatile("v_cvt_pk_bf16_f32 %0, %1, %2" : "=v"(r) : "v"(lo), "v"(hi)); return r; }
typedef float f32x2 __attribute__((ext_vector_type(2)));
__device__ __forceinline__ f32x2 gelu_pk(f32x2 v) {
    const f32x2 av = __builtin_elementwise_abs(v), d = av * 0.2316418882f + 1.0f;
    f32x2 t; t.x = __builtin_amdgcn_rcpf(d.x); t.y = __builtin_amdgcn_rcpf(d.y);
    f32x2 q = t * 0.5307027145f + (-0.7265760135f); q = q * t + 0.7107068705f; q = q * t + (-0.142248368f); q = q * t + 0.127414796f; q = q * t;
    const f32x2 s = (v * v) * (-0.72134752044f);
    f32x2 e; e.x = __builtin_amdgcn_exp2f(s.x); e.y = __builtin_amdgcn_exp2f(s.y);
    const f32x2 m = v * (q * e), r = v - m;
    f32x2 o; o.x = v.x < 0.f ? m.x : r.x; o.y = v.y < 0.f ? m.y : r.y; return o;
}

struct EpiProj {
    static constexpr bool PERM = true, AFTER_DRAIN = false;
    bf16_t* O; int ldc; const float* rope; float kscale, qscale;
    __device__ __forceinline__ void operator()(const f32x4 (&acc)[2][2][4][2], const Unit& u, int wr, int wc, int fr, int fq) const {
        const int row0 = u.pm * BM + wr * 64 + fr; const int col0 = u.pn * BM + wc * 32 + 8 * fq;
        const int pn = u.pn;
        const bool rot = pn < 4; const bool gate = (pn == 6 || pn == 7);
        const float sc = (pn == 2 || pn == 3) ? kscale : ((pn == 8 || pn == 9) ? qscale : 1.f);
#pragma unroll
        for (int ai = 0; ai < 2; ++ai)
#pragma unroll
            for (int m = 0; m < 4; ++m) {
                const int row = row0 + ai * HALF + m * 16;
                bf16_t* rowp = O + (size_t)row * ldc + col0;
                f32x4 cs0 = (f32x4){1.f, 0.f, 1.f, 0.f}, cs1 = cs0;
                if (rot) { const float* rp = rope + ((size_t)(row & 2047) * 64 + 16 * wc + 4 * fq) * 2; cs0 = *(const f32x4*)rp; cs1 = *(const f32x4*)(rp + 4); }
#pragma unroll
                for (int bj = 0; bj < 2; ++bj) {
                    f32x4 v0 = acc[ai][bj][m][0], v1 = acc[ai][bj][m][1];
                    if (rot) {
                        f32x4 r0, r1;
                        r0[0] = v0[0] * cs0[0] - v0[1] * cs0[1]; r0[1] = v0[0] * cs0[1] + v0[1] * cs0[0];
                        r0[2] = v0[2] * cs0[2] - v0[3] * cs0[3]; r0[3] = v0[2] * cs0[3] + v0[3] * cs0[2];
                        r1[0] = v1[0] * cs1[0] - v1[1] * cs1[1]; r1[1] = v1[0] * cs1[1] + v1[1] * cs1[0];
                        r1[2] = v1[2] * cs1[2] - v1[3] * cs1[3]; r1[3] = v1[2] * cs1[3] + v1[3] * cs1[2];
                        v0 = r0; v1 = r1;
                    }
                    if (gate) {
#pragma unroll
                        for (int j = 0; j < 4; ++j) { v0[j] = v0[j] * __builtin_amdgcn_rcpf(1.f + __builtin_amdgcn_exp2f(-1.4426950408889634f * v0[j])); v1[j] = v1[j] * __builtin_amdgcn_rcpf(1.f + __builtin_amdgcn_exp2f(-1.4426950408889634f * v1[j])); }
                    }
                    v0 = v0 * sc; v1 = v1 * sc;
                    u32x4 w; w.x = cvt_pk_bf16(v0[0], v0[1]); w.y = cvt_pk_bf16(v0[2], v0[3]); w.z = cvt_pk_bf16(v1[0], v1[1]); w.w = cvt_pk_bf16(v1[2], v1[3]);
                    *(u32x4*)(rowp + bj * HALF) = w;
                }
            }
    }
};
struct EpiPlainBf16 {
    static constexpr bool PERM = true, AFTER_DRAIN = false;
    bf16_t* O; int ldc;
    __device__ __forceinline__ void operator()(const f32x4 (&acc)[2][2][4][2], const Unit& u, int wr, int wc, int fr, int fq) const {
        const int row0 = u.pm * BM + wr * 64 + fr; const int col0 = u.pn * BM + wc * 32 + 8 * fq;
#pragma unroll
        for (int ai = 0; ai < 2; ++ai)
#pragma unroll
            for (int m = 0; m < 4; ++m) { bf16_t* rowp = O + (size_t)(row0 + ai * HALF + m * 16) * ldc + col0;
#pragma unroll
                for (int bj = 0; bj < 2; ++bj) { const f32x4 v0 = acc[ai][bj][m][0], v1 = acc[ai][bj][m][1];
                    u32x4 w; w.x = cvt_pk_bf16(v0[0], v0[1]); w.y = cvt_pk_bf16(v0[2], v0[3]); w.z = cvt_pk_bf16(v1[0], v1[1]); w.w = cvt_pk_bf16(v1[2], v1[3]);
                    *(u32x4*)(rowp + bj * HALF) = w; } }
    }
};
struct EpiResF32 {
    static constexpr bool PERM = false, AFTER_DRAIN = false;
    const float* base; float* out; int ldc; float alpha;
    __device__ __forceinline__ void operator()(const f32x4 (&acc)[2][2][4][2], const Unit& u, int wr, int wc, int fr, int fq) const {
        const int row0 = u.pm * BM + wr * 64 + fr; const int col0 = u.pn * BM + wc * 32 + 4 * fq;
#pragma unroll
        for (int ai = 0; ai < 2; ++ai)
#pragma unroll
            for (int m = 0; m < 4; ++m) { const size_t off = (size_t)(row0 + ai * HALF + m * 16) * ldc + col0;
#pragma unroll
                for (int bj = 0; bj < 2; ++bj)
#pragma unroll
                    for (int n = 0; n < 2; ++n) { const f32x4 bs = *(const f32x4*)(base + off + bj * HALF + n * 16); *(f32x4*)(out + off + bj * HALF + n * 16) = bs * alpha + acc[ai][bj][m][n]; } }
    }
};

template <class Epi, class Sched, bool ALIGN_EPI = false, bool SP2 = false>
__device__ __forceinline__ void gemm_phase(PG8_LAS unsigned char* lds, const Gemm g, const Sched& S, const Epi& E) {
    int tid_ = threadIdx.x; asm volatile("" : "+v"(tid_));
    const int tid = tid_, wid = __builtin_amdgcn_readfirstlane(tid >> 6), lane = tid & 63, wr = wid >> 2, wc = wid & 3, fr = lane & 15, fq = lane >> 4;
    const int K = g.K, nt = K / BK;
    unsigned voffA[2], voffB[2];
#pragma unroll
    for (int i = 0; i < 2; ++i) { int R, C; stage_rc(tid * 16 + i * 8192, R, C); const int Rb = Epi::PERM ? ((R & ~31) + perm32(R & 31)) : R;
        voffA[i] = (unsigned)(R * K + C) * 2u; voffB[i] = (unsigned)(Rb * K + C) * 2u; }
    const size_t kstep = (size_t)(BK * 2);
    const size_t hstep = (size_t)HALF * K * 2;
    const size_t tstep = 2 * hstep;
    const unsigned ldsw = (unsigned)wid * 1024u;
    const int aoff = lds_byte(wr * 64 + fr, fq * 8), boff = lds_byte(wc * 32 + fr, fq * 8);
#define PG8_SA(b, h) (((b) * 2 + (h)) * HTB)
#define PG8_SB(b, h) ((4 + (b) * 2 + (h)) * HTB)
#define PG8_STAGE(bufoff, gbase, voff) do { _Pragma("unroll") for (int _i = 0; _i < 2; ++_i) \
        __builtin_amdgcn_global_load_lds((const unsigned*)((const char*)(gbase) + (voff)[_i]), (PG8_LAS unsigned*)(lds + (bufoff) + ldsw + _i * 8192), 16, 0, 0); } while (0)
#define PG8_LDA(dst, b, h) do { _Pragma("unroll") for (int m = 0; m < 4; ++m) _Pragma("unroll") for (int k = 0; k < 2; ++k) dst[m][k] = *(const PG8_LAS bf16x8*)(lds + PG8_SA(b, h) + aoff + m * 2048 + k * 1024); } while (0)
#define PG8_LDB(dst, b, h) do { _Pragma("unroll") for (int n = 0; n < 2; ++n) _Pragma("unroll") for (int k = 0; k < 2; ++k) dst[n][k] = *(const PG8_LAS bf16x8*)(lds + PG8_SB(b, h) + boff + n * 2048 + k * 1024); } while (0)
#define PG8_MMA(ai, bj, At, Bt) do { __builtin_amdgcn_s_setprio(1); _Pragma("unroll") for (int m = 0; m < 4; ++m) _Pragma("unroll") for (int n = 0; n < 2; ++n) _Pragma("unroll") for (int k = 0; k < 2; ++k) \
        acc[ai][bj][m][n] = __builtin_amdgcn_mfma_f32_16x16x32_bf16(Bt[n][k], At[m][k], acc[ai][bj][m][n], 0, 0, 0); __builtin_amdgcn_s_setprio(0); } while (0)
#define PG8_WAIT_V(n) asm volatile("s_waitcnt vmcnt(" #n ")" ::: "memory")
#define PG8_WAIT_L(n) asm volatile("s_waitcnt lgkmcnt(" #n ")" ::: "memory")
#define PG8_BAR __builtin_amdgcn_s_barrier()
#define PG8_SCHED __builtin_amdgcn_sched_barrier(0)
    Unit cur, nxt; int ui = 0;
    if (!S.next(0, cur)) return;
    f32x4 acc[2][2][4][2];
#pragma unroll
    for (int a = 0; a < 2; ++a)
#pragma unroll
        for (int b = 0; b < 2; ++b)
#pragma unroll
            for (int m = 0; m < 4; ++m)
#pragma unroll
                for (int n = 0; n < 2; ++n) acc[a][b][m][n] = (f32x4){0.f, 0.f, 0.f, 0.f};
    bf16x8 At[4][2], B0[2][2], B1[2][2];
    const char* cA = (const char*)g.A + (size_t)cur.pm * tstep; const char* cB = (const char*)g.Bt + (size_t)cur.pn * tstep;
    S.a_ready(cur);
    if constexpr (SP2) {
        PG8_STAGE(PG8_SB(0, 0), cB, voffB); PG8_STAGE(PG8_SB(0, 1), cB + hstep, voffB); PG8_STAGE(PG8_SA(0, 0), cA, voffA); PG8_STAGE(PG8_SA(0, 1), cA + hstep, voffA);
        if (wr == 1) PG8_BAR;
        PG8_WAIT_V(2); PG8_BAR;
        PG8_STAGE(PG8_SB(1, 0), cB + kstep, voffB); PG8_STAGE(PG8_SA(1, 0), cA + kstep, voffA); PG8_STAGE(PG8_SB(1, 1), cB + hstep + kstep, voffB);
        PG8_WAIT_V(6); PG8_BAR;
    } else {
        PG8_STAGE(PG8_SB(0, 0), cB, voffB); PG8_STAGE(PG8_SA(0, 0), cA, voffA); PG8_STAGE(PG8_SB(0, 1), cB + hstep, voffB); PG8_STAGE(PG8_SA(0, 1), cA + hstep, voffA);
        if (wr == 1) PG8_BAR;
        PG8_WAIT_V(4); PG8_BAR;
        PG8_STAGE(PG8_SB(1, 0), cB + kstep, voffB); PG8_STAGE(PG8_SA(1, 0), cA + kstep, voffA); PG8_STAGE(PG8_SB(1, 1), cB + hstep + kstep, voffB);
        PG8_WAIT_V(6); PG8_BAR;
    }
    for (;;) {
        const bool has_next = S.next(ui + 1, nxt);
        const char* nA = has_next ? (const char*)g.A + (size_t)nxt.pm * tstep : cA; const char* nB = has_next ? (const char*)g.Bt + (size_t)nxt.pn * tstep : cB;
        for (int t = 0; t < nt; t += 2) {
            const bool last = (t == nt - 2);
            const char* a1 = cA + (size_t)(t + 1) * kstep;
            const char* a2 = last ? nA : cA + (size_t)(t + 2) * kstep; const char* b2 = last ? nB : cB + (size_t)(t + 2) * kstep;
            const char* a3 = a2 + kstep; const char* b3 = b2 + kstep;
            if (last && has_next) S.a_ready(nxt);
            if constexpr (SP2) {
            PG8_LDB(B0, 0, 0); PG8_LDB(B1, 0, 1); PG8_SCHED; PG8_LDA(At, 0, 0); PG8_STAGE(PG8_SA(1, 1), a1 + hstep, voffA);
            PG8_WAIT_V(8); PG8_WAIT_L(0); PG8_BAR; PG8_MMA(0, 0, At, B0); PG8_MMA(0, 1, At, B1); PG8_BAR; PG8_SCHED;
            PG8_LDA(At, 0, 1); PG8_STAGE(PG8_SB(0, 0), b2, voffB); PG8_STAGE(PG8_SB(0, 1), b2 + hstep, voffB); PG8_STAGE(PG8_SA(0, 0), a2, voffA);
            PG8_WAIT_V(8); PG8_WAIT_L(0); PG8_BAR; PG8_MMA(1, 0, At, B0); PG8_MMA(1, 1, At, B1); PG8_BAR; PG8_SCHED;
            PG8_LDB(B0, 1, 0); PG8_LDB(B1, 1, 1); PG8_SCHED; PG8_LDA(At, 1, 0); PG8_STAGE(PG8_SA(0, 1), a2 + hstep, voffA);
            PG8_WAIT_V(8); PG8_WAIT_L(0); PG8_BAR; PG8_MMA(0, 0, At, B0); PG8_MMA(0, 1, At, B1); PG8_BAR; PG8_SCHED;
            PG8_LDA(At, 1, 1); PG8_STAGE(PG8_SB(1, 0), b3, voffB); PG8_STAGE(PG8_SB(1, 1), b3 + hstep, voffB); PG8_STAGE(PG8_SA(1, 0), a3, voffA);
            PG8_WAIT_V(8); PG8_WAIT_L(0); PG8_BAR; PG8_MMA(1, 0, At, B0); PG8_MMA(1, 1, At, B1); PG8_BAR; PG8_SCHED;
            } else {
            PG8_LDB(B0, 0, 0); PG8_SCHED; PG8_LDA(At, 0, 0); PG8_STAGE(PG8_SA(1, 1), a1 + hstep, voffA);
            PG8_WAIT_L(8); PG8_BAR; PG8_WAIT_L(0); PG8_MMA(0, 0, At, B0); PG8_BAR; PG8_SCHED;
            PG8_LDB(B1, 0, 1); PG8_STAGE(PG8_SB(0, 0), b2, voffB);
            PG8_BAR; PG8_WAIT_L(0); PG8_MMA(0, 1, At, B1); PG8_BAR;
            PG8_LDA(At, 0, 1); PG8_STAGE(PG8_SA(0, 0), a2, voffA);
            PG8_BAR; PG8_WAIT_L(0); PG8_MMA(1, 0, At, B0); PG8_BAR; PG8_SCHED;
            PG8_STAGE(PG8_SB(0, 1), b2 + hstep, voffB);
            PG8_WAIT_V(6); PG8_BAR; PG8_MMA(1, 1, At, B1); PG8_BAR;
            PG8_LDB(B0, 1, 0); PG8_SCHED; PG8_LDA(At, 1, 0); PG8_STAGE(PG8_SA(0, 1), a2 + hstep, voffA);
            PG8_WAIT_L(8); PG8_BAR; PG8_WAIT_L(0); PG8_MMA(0, 0, At, B0); PG8_BAR; PG8_SCHED;
            PG8_LDB(B1, 1, 1); PG8_STAGE(PG8_SB(1, 0), b3, voffB);
            PG8_BAR; PG8_WAIT_L(0); PG8_MMA(0, 1, At, B1); PG8_BAR;
            PG8_LDA(At, 1, 1); PG8_STAGE(PG8_SA(1, 0), a3, voffA);
            PG8_BAR; PG8_WAIT_L(0); PG8_MMA(1, 0, At, B0); PG8_BAR; PG8_SCHED;
            PG8_STAGE(PG8_SB(1, 1), b3 + hstep, voffB);
            PG8_WAIT_V(6); PG8_BAR; PG8_MMA(1, 1, At, B1); PG8_BAR;
            }
        }
        if constexpr (ALIGN_EPI) { if (wr == 0) PG8_BAR; }
        if constexpr (!Epi::AFTER_DRAIN) { E(acc, cur, wr, wc, fr, fq); S.done(cur); }
        if (!has_next) break;
#pragma unroll
        for (int a = 0; a < 2; ++a)
#pragma unroll
            for (int b = 0; b < 2; ++b)
#pragma unroll
                for (int m = 0; m < 4; ++m)
#pragma unroll
                    for (int n = 0; n < 2; ++n) acc[a][b][m][n] = (f32x4){0.f, 0.f, 0.f, 0.f};
        cur = nxt; cA = nA; cB = nB; ++ui;
        if constexpr (ALIGN_EPI) { if (wr == 1) PG8_BAR; }
    }
    PG8_WAIT_V(0);
    if constexpr (!ALIGN_EPI) { if (wr == 0) PG8_BAR; }
    PG8_BAR;
    if constexpr (Epi::AFTER_DRAIN) { E.fused(acc, cur, wr, wc, fr, fq, lds, wid, lane); S.done(cur); }
#undef PG8_SA
#undef PG8_SB
#undef PG8_STAGE
#undef PG8_LDA
#undef PG8_LDB
#undef PG8_MMA
#undef PG8_WAIT_V
#undef PG8_WAIT_L
#undef PG8_BAR
#undef PG8_SCHED
}
}

#ifndef PG8_SP2
#define PG8_SP2 true
#endif
#ifndef PG8_ALIGN
#define PG8_ALIGN true
#endif
#include <hip/hip_bf16.h>
#include <cmath>
namespace attn_body {
using bf16=__hip_bfloat16;
using bf16x8=__attribute__((ext_vector_type(8)))short;
using s16x4=__attribute__((ext_vector_type(4)))short;
using f32x16=__attribute__((ext_vector_type(16)))float;
using u32x4=__attribute__((ext_vector_type(4)))unsigned;
constexpr int BATCH=16,SEQ=2048,D=64,PIN=3584,POUT=1024;
constexpr int NW=8,QBLK=32,QB=QBLK*NW,KVBLK=64,NQB=SEQ/QB;
constexpr int ATTN_UNIT_ROWS=QB;
__device__ __forceinline__ int crow(int r,int hi){return (r&3)+8*(r>>2)+4*hi;}
#define SBAR() __builtin_amdgcn_sched_barrier(0)
__device__ __forceinline__ void cmask(f32x16&p0,f32x16&p1,int jb,int qrel,int hi){
  const float NEG=-INFINITY; int kb=64*jb+4*hi;
  #pragma unroll
  for(int r=0;r<16;++r){int kv=kb+(r&3)+8*(r>>2); if(kv>qrel)p0[r]=NEG; if(kv+32>qrel)p1[r]=NEG;}
}

constexpr int NSLOT=3, SLOTB=8192;
constexpr int LDS_K=0, LDS_V=NSLOT*SLOTB, LDS_WS=2*NSLOT*SLOTB, LDS_OST=LDS_WS+NW*64*4, LDS_BYTES=LDS_OST+NW*4096;
constexpr float C2=0.125f*1.4426950408889634f;
__device__ __forceinline__ void glds16(const void*gsrc,unsigned lds_dst){unsigned keep;
  asm volatile("s_mov_b32 %0, m0\n\ts_mov_b32 m0, %2\n\ts_nop 0\n\tglobal_load_lds_dwordx4 %1, off\n\ts_mov_b32 m0, %0":"=&s"(keep):"v"(gsrc),"s"(lds_dst):"memory");}
__device__ __forceinline__ float max3f(float a,float b,float c){float r;asm("v_max3_f32 %0, %1, %2, %3":"=v"(r):"v"(a),"v"(b),"v"(c));return r;}
__device__ __forceinline__ float max2f(float a,float b){float r;asm("v_max_f32_e32 %0, %1, %2":"=v"(r):"v"(a),"v"(b));return r;}
__device__ __forceinline__ float fadd_s(float a,float b){float r;asm("v_add_f32_e32 %0, %1, %2":"=v"(r):"v"(a),"v"(b));return r;}
__device__ __forceinline__ float fsub_s(float a,float b){float r;asm("v_sub_f32_e32 %0, %1, %2":"=v"(r):"v"(a),"v"(b));return r;}
typedef float f32x2_t __attribute__((ext_vector_type(2))); typedef __bf16 bf16x2_t __attribute__((ext_vector_type(2)));
__device__ __forceinline__ unsigned cvtpk_s(float lo,float hi){f32x2_t v={lo,hi};bf16x2_t b=__builtin_convertvector(v,bf16x2_t);return __builtin_bit_cast(unsigned,b);}
#define WAIT_BAR(N) asm volatile("s_waitcnt vmcnt(" #N ") lgkmcnt(0)\n\ts_barrier":::"memory")

__device__ __forceinline__ void qkt(f32x16&p0,f32x16&p1,const char*Kslot,const bf16x8*qr,const f32x16&negm,int r32,int hi){
  const char*kb=Kslot+hi*1024+r32*16;
  #pragma unroll
  for(int d0=0;d0<4;++d0){
    const bf16x8 b0=*reinterpret_cast<const bf16x8*>(kb+d0*2048);
    const bf16x8 b1=*reinterpret_cast<const bf16x8*>(kb+d0*2048+512);
    if(d0==0){p0=__builtin_amdgcn_mfma_f32_32x32x16_bf16(b0,qr[0],negm,0,0,0);p1=__builtin_amdgcn_mfma_f32_32x32x16_bf16(b1,qr[0],negm,0,0,0);}
    else{p0=__builtin_amdgcn_mfma_f32_32x32x16_bf16(b0,qr[d0],p0,0,0,0);p1=__builtin_amdgcn_mfma_f32_32x32x16_bf16(b1,qr[d0],p1,0,0,0);}}
}
typedef __attribute__((address_space(3))) const char* lds_cptr;
typedef short v4i16_t __attribute__((ext_vector_type(4)));
__device__ __forceinline__ void kload8(bf16x8*kf,lds_cptr kp){
  kf[0]=*(const __attribute__((address_space(3))) bf16x8*)(kp);      kf[1]=*(const __attribute__((address_space(3))) bf16x8*)(kp+512);
  kf[2]=*(const __attribute__((address_space(3))) bf16x8*)(kp+2048); kf[3]=*(const __attribute__((address_space(3))) bf16x8*)(kp+2560);
  kf[4]=*(const __attribute__((address_space(3))) bf16x8*)(kp+4096); kf[5]=*(const __attribute__((address_space(3))) bf16x8*)(kp+4608);
  kf[6]=*(const __attribute__((address_space(3))) bf16x8*)(kp+6144); kf[7]=*(const __attribute__((address_space(3))) bf16x8*)(kp+6656);
}
__device__ __forceinline__ void kload2(bf16x8*kf,lds_cptr kp,int j){ kf[2*j]=*(const __attribute__((address_space(3))) bf16x8*)(kp+j*2048); kf[2*j+1]=*(const __attribute__((address_space(3))) bf16x8*)(kp+j*2048+512); }
__device__ __forceinline__ s16x4 vtr(lds_cptr p){ return __builtin_bit_cast(s16x4,__builtin_amdgcn_ds_read_tr16_b64_v4i16((__attribute__((address_space(3))) v4i16_t*)p)); }
__device__ __forceinline__ float rowmax(const f32x16&p0,const f32x16&p1){
  float a=max3f(p0[0],p0[1],p1[0]),b=max3f(p0[2],p0[3],p1[1]);a=max3f(a,p1[2],p1[3]);
  #pragma unroll
  for(int r=4;r<16;r+=4){a=max3f(a,p0[r],p0[r+1]);b=max3f(b,p0[r+2],p0[r+3]);a=max3f(a,p1[r],p1[r+1]);b=max3f(b,p1[r+2],p1[r+3]);}
  const float m=max2f(a,b);
  auto rr=__builtin_amdgcn_permlane32_swap(__float_as_uint(m),__float_as_uint(m),false,false);
  return max2f(__uint_as_float(rr[0]),__uint_as_float(rr[1]));
}
__device__ __forceinline__ void pv(f32x16*o,int vb,bf16x8 pa0,bf16x8 pa1,bf16x8 pa2,bf16x8 pa3){
  #pragma unroll
  for(int d0=0;d0<2;++d0){s16x4 lo[4],hi[4];
    #pragma unroll
    for(int ks=0;ks<4;++ks){
      asm volatile("ds_read_b64_tr_b16 %0,%1 offset:%c2":"=&v"(lo[ks]):"v"(vb),"i"(d0*4096+ks*1024):"memory");
      asm volatile("ds_read_b64_tr_b16 %0,%1 offset:%c2":"=&v"(hi[ks]):"v"(vb),"i"(d0*4096+ks*1024+512):"memory");}
    asm volatile("s_waitcnt lgkmcnt(0)":::"memory");SBAR();
    #define PK(k) (bf16x8){lo[k][0],lo[k][1],lo[k][2],lo[k][3],hi[k][0],hi[k][1],hi[k][2],hi[k][3]}
    o[d0]=__builtin_amdgcn_mfma_f32_32x32x16_bf16(pa0,PK(0),o[d0],0,0,0);
    o[d0]=__builtin_amdgcn_mfma_f32_32x32x16_bf16(pa1,PK(1),o[d0],0,0,0);
    o[d0]=__builtin_amdgcn_mfma_f32_32x32x16_bf16(pa2,PK(2),o[d0],0,0,0);
    o[d0]=__builtin_amdgcn_mfma_f32_32x32x16_bf16(pa3,PK(3),o[d0],0,0,0);
    #undef PK
  }
}

#ifndef ATTN_STORE16
#define ATTN_STORE16(p,v) (*(u32x4*)(p)=(v))
#endif
template<int THRL> __device__ __forceinline__ void attn_unit(int b,int qb,const bf16*Q,const bf16*__restrict__ K,const bf16*__restrict__ V,bf16*O,char*shm){
  const int tid=threadIdx.x,lane=tid&63,r32=lane&31,hi=lane>>5; const int wid=__builtin_amdgcn_readfirstlane(tid>>6);
  const long rowbase=(long)b*SEQ; const int q0=qb*QB;
  const bf16*Qw=Q+(rowbase+q0+wid*QBLK)*PIN;
  const bf16*Kh=K+rowbase*PIN,*Vh=V+rowbase*PIN;
  const unsigned lds0=(unsigned)(uintptr_t)shm;
  float*wsf=(float*)(shm+LDS_WS)+wid*64;
  const bf16*ksrc=Kh+(long)lane*PIN+wid*8;
  const bf16*vsrc=Vh+(long)(16*(wid&3)+(lane>>2))*PIN+(wid>>2)*32+(lane&3)*8;
  const unsigned kdst=lds0+LDS_K+wid*1024, vdst=lds0+LDS_V+wid*1024;
  #define DMA_K(t,slot) glds16(ksrc+(long)(t)*KVBLK*PIN,(unsigned)__builtin_amdgcn_readfirstlane(kdst+(slot)))
  #define DMA_V(t,slot) glds16(vsrc+(long)(t)*KVBLK*PIN,(unsigned)__builtin_amdgcn_readfirstlane(vdst+(slot)))
  const int vb0=(int)(lds0+LDS_V)+((lane>>4)&1)*32+(lane&3)*8+(4*hi+((lane&15)>>2))*64;
  const char*Kbase=shm+LDS_K; bf16x8 kf[8];
  const lds_cptr shm3=(lds_cptr)shm; const lds_cptr kp0=shm3+LDS_K+hi*1024+r32*16; const lds_cptr vp0=shm3+LDS_V+((lane>>4)&1)*32+(lane&3)*8+(4*hi+((lane&15)>>2))*64;
  const int NT=(q0+QB)/KVBLK;
  DMA_K(0,0);DMA_V(0,0);DMA_K(1,SLOTB);
  bf16x8 qr[4];
  #pragma unroll
  for(int d0=0;d0<4;++d0)qr[d0]=*reinterpret_cast<const bf16x8*>(&Qw[(long)r32*PIN+d0*16+hi*8]);
  float mhat=0.f,l_reg=0.f;f32x16 o[2];o[0]=f32x16{};o[1]=f32x16{};f32x16 negm=f32x16{};asm volatile("":"+v"(negm));
  const int qrel=wid*QBLK+r32;
  #define CMASK(P0,P1,t) do{int jb_=(t)-(NT-4); if(jb_>=0)cmask(P0,P1,jb_,qrel,hi);}while(0)
  bool resc=false;
  #define START(P0,P1) do{ const float rm=rowmax(P0,P1); resc=false; \
    { const float dl=rm; mhat=fadd_s(mhat,dl); \
      _Pragma("unroll") for(int r=0;r<16;++r){P0[r]=fsub_s(P0[r],dl);P1[r]=fsub_s(P1[r],dl);} \
      _Pragma("unroll") for(int r=0;r<16;++r)negm[r]=-mhat; asm volatile("":"+v"(negm)); } \
    _Pragma("unroll") for(int r=0;r<16;++r)P0[r]=__builtin_amdgcn_exp2f(P0[r]); }while(0)
  #define RESC() do{ if(resc){ asm volatile("s_waitcnt lgkmcnt(0)":::"memory"); \
      _Pragma("unroll") for(int d_=0;d_<2;++d_) _Pragma("unroll") for(int r=0;r<16;++r)o[d_][r]*=wsf[crow(r,hi)]; } }while(0)
  f32x16 pA0,pA1,pB0,pB1;
  int sl_prev=0,sl_cur=0,sl_next=SLOTB;
  #define ROT() do{sl_prev=sl_cur;sl_cur=sl_next;sl_next=(sl_next==(NSLOT-1)*SLOTB)?0:sl_next+SLOTB;}while(0)
  DMA_K(2,2*SLOTB);
  WAIT_BAR(3);
  qkt(pA0,pA1,Kbase,qr,negm,r32,hi);asm volatile("s_nop 15\n\ts_nop 7":"+v"(pA0),"+v"(pA1));CMASK(pA0,pA1,0);
  START(pA0,pA1);
  _Pragma("unroll") for(int r=0;r<16;++r)pA1[r]=__builtin_amdgcn_exp2f(pA1[r]);
  WAIT_BAR(0);
  DMA_K(3,0);DMA_V(1,SLOTB);
  ROT();
  kload8(kf,kp0+sl_cur);
  WAIT_BAR(2);
  s16x4 vlo[8],vhi[8]; u32x4 pw0,pw1,pw2,pw3;
  #define PKW(P,B) cvtpk_s(P[B],P[B+1])
  #define PAF(k) __builtin_bit_cast(bf16x8,pw##k)
  #define VFR(i) (bf16x8){vlo[i][0],vlo[i][1],vlo[i][2],vlo[i][3],vhi[i][0],vhi[i][1],vhi[i][2],vhi[i][3]}
  #define PIN(x) asm volatile("":"+v"(x))
  #define MX3(a,b,c) __builtin_fmaxf(__builtin_fmaxf((a),(b)),(c))
  #define GAPA(MF,A0,A1,A2,A3,W0,W1,PW) do{ MF; sacc+=A0; sacc+=A1; sacc+=A2; sacc+=A3; PIN(sacc); W0; W1; PIN(PW); SBAR(); }while(0)
  #define EX(v) __builtin_amdgcn_exp2f(v)
  #define GAPB(MF,X,B) do{ MF; X[B]=EX(X[B]); X[B+1]=EX(X[B+1]); X[B+2]=EX(X[B+2]); X[B+3]=EX(X[B+3]); PIN(X); SBAR(); }while(0)
  #define VRD(i) do{ vlo[i]=vtr(vp_+(((i)>>2)*4096+((i)&3)*1024)); vhi[i]=vtr(vp_+(((i)>>2)*4096+((i)&3)*1024+512)); }while(0)
  #define KRD(G,j) do{ if(G){ kload2(kf,kp0+sl_next,j); SBAR(); } }while(0)
  #define STEP(C0,C1,P0,P1,t,GK,GV,GL) do{ SBAR(); \
    const lds_cptr vp_=vp0+sl_prev; \
    VRD(0); SBAR(); float sacc=(P0[0]+P0[1]); \
    GAPA(C0=__builtin_amdgcn_mfma_f32_32x32x16_bf16(kf[0],qr[0],negm,0,0,0), P0[2],P0[3],P0[4],P0[5],     pw0[0]=PKW(P0,0), pw0[1]=PKW(P0,2), pw0); \
    VRD(4); SBAR(); GAPA(C1=__builtin_amdgcn_mfma_f32_32x32x16_bf16(kf[1],qr[0],negm,0,0,0), P0[6],P0[7],P0[8],P0[9],     pw0[2]=PKW(P0,4), pw0[3]=PKW(P0,6), pw0); \
    VRD(1); SBAR(); GAPA(C0=__builtin_amdgcn_mfma_f32_32x32x16_bf16(kf[2],qr[1],C0,0,0,0),   P0[10],P0[11],P0[12],P0[13], pw1[0]=PKW(P0,8), pw1[1]=PKW(P0,10), pw1); \
    VRD(5); SBAR(); GAPA(C1=__builtin_amdgcn_mfma_f32_32x32x16_bf16(kf[3],qr[1],C1,0,0,0),   P0[14],P0[15],P1[0],P1[1],   pw1[2]=PKW(P0,12),pw1[3]=PKW(P0,14), pw1); \
    VRD(2); SBAR(); GAPA(C0=__builtin_amdgcn_mfma_f32_32x32x16_bf16(kf[4],qr[2],C0,0,0,0),   P1[2],P1[3],P1[4],P1[5],     pw2[0]=PKW(P1,0), pw2[1]=PKW(P1,2), pw2); \
    VRD(6); SBAR(); GAPA(C1=__builtin_amdgcn_mfma_f32_32x32x16_bf16(kf[5],qr[2],C1,0,0,0),   P1[6],P1[7],P1[8],P1[9],     pw2[2]=PKW(P1,4), pw2[3]=PKW(P1,6), pw2); \
    VRD(3); SBAR(); GAPA(C0=__builtin_amdgcn_mfma_f32_32x32x16_bf16(kf[6],qr[3],C0,0,0,0),   P1[10],P1[11],P1[12],P1[13], pw3[0]=PKW(P1,8), pw3[1]=PKW(P1,10), pw3); \
    VRD(7); SBAR(); GAPA(C1=__builtin_amdgcn_mfma_f32_32x32x16_bf16(kf[7],qr[3],C1,0,0,0),   P1[14],P1[15],0.f,0.f,       pw3[2]=PKW(P1,12),pw3[3]=PKW(P1,14), pw3); \
    l_reg+=sacc; \
    if(GK){DMA_K((t)+3,sl_cur);} if(GV){DMA_V((t)+1,sl_next);} \
    CMASK(C0,C1,t); \
    { float a=MX3(C0[0],C0[1],C1[0]),b=MX3(C0[2],C0[3],C1[1]); a=MX3(a,C1[2],C1[3]); \
      _Pragma("unroll") for(int r=4;r<16;r+=4){a=MX3(a,C0[r],C0[r+1]);b=MX3(b,C0[r+2],C0[r+3]);a=MX3(a,C1[r],C1[r+1]);b=MX3(b,C1[r+2],C1[r+3]);} \
      float rm=__builtin_fmaxf(a,b); { auto rr=__builtin_amdgcn_permlane32_swap(__float_as_uint(rm),__float_as_uint(rm),false,false); rm=__builtin_fmaxf(__uint_as_float(rr[0]),__uint_as_float(rr[1])); } \
      resc=false; \
      if(__builtin_expect(__any(rm>(float)THRL),0)){ const float dl=__builtin_fmaxf(rm,0.f); mhat+=dl; \
        _Pragma("unroll") for(int r=0;r<16;++r){C0[r]-=dl;C1[r]-=dl;} \
        _Pragma("unroll") for(int r=0;r<16;++r)negm[r]=-mhat; asm volatile("":"+v"(negm)); \
        const float f=__builtin_amdgcn_exp2f(-dl); l_reg*=f; if(hi==0)wsf[r32]=f; resc=true; } } \
    SBAR(); \
    GAPB(o[0]=__builtin_amdgcn_mfma_f32_32x32x16_bf16(PAF(0),VFR(0),o[0],0,0,0), C0,0); \
    GAPB(o[1]=__builtin_amdgcn_mfma_f32_32x32x16_bf16(PAF(0),VFR(4),o[1],0,0,0), C0,4); \
    KRD(GL,0); GAPB(o[0]=__builtin_amdgcn_mfma_f32_32x32x16_bf16(PAF(1),VFR(1),o[0],0,0,0), C0,8); \
    KRD(GL,1); GAPB(o[1]=__builtin_amdgcn_mfma_f32_32x32x16_bf16(PAF(1),VFR(5),o[1],0,0,0), C0,12); \
    KRD(GL,2); GAPB(o[0]=__builtin_amdgcn_mfma_f32_32x32x16_bf16(PAF(2),VFR(2),o[0],0,0,0), C1,0); \
    KRD(GL,3); GAPB(o[1]=__builtin_amdgcn_mfma_f32_32x32x16_bf16(PAF(2),VFR(6),o[1],0,0,0), C1,4); \
    GAPB(o[0]=__builtin_amdgcn_mfma_f32_32x32x16_bf16(PAF(3),VFR(3),o[0],0,0,0), C1,8); \
    GAPB(o[1]=__builtin_amdgcn_mfma_f32_32x32x16_bf16(PAF(3),VFR(7),o[1],0,0,0), C1,12); \
    }while(0)
  int t=1;
  #undef CMASK
  #define CMASK(P0,P1,t) do{}while(0)
  for(;t+5<NT;t+=2){
    STEP(pB0,pB1,pA0,pA1,t,true,true,true);     WAIT_BAR(2); RESC(); ROT();
    STEP(pA0,pA1,pB0,pB1,t+1,true,true,true);   WAIT_BAR(2); RESC(); ROT();
  }
  #undef CMASK
  #define CMASK(P0,P1,t) do{int jb_=(t)-(NT-4); if(jb_>=0)cmask(P0,P1,jb_,qrel,hi);}while(0)
  #define ENDW(tt) do{ if((tt)+3<NT){WAIT_BAR(2);} else if((tt)+2<NT){WAIT_BAR(1);} else {WAIT_BAR(0);} }while(0)
  for(;t+1<NT;t+=2){
    STEP(pB0,pB1,pA0,pA1,t,(t+3<NT),(t+1<NT),(t+1<NT));       ENDW(t);   RESC(); ROT();
    STEP(pA0,pA1,pB0,pB1,t+1,(t+4<NT),(t+2<NT),(t+2<NT));     ENDW(t+1); RESC(); ROT();
  }
  STEP(pB0,pB1,pA0,pA1,NT-1,false,false,false); RESC();
  { float sacc=pB0[0]+pB0[1]; _Pragma("unroll") for(int r=2;r<16;++r)sacc+=pB0[r]; _Pragma("unroll") for(int r=0;r<16;++r)sacc+=pB1[r]; l_reg+=sacc;
    pw0=(u32x4){PKW(pB0,0),PKW(pB0,2),PKW(pB0,4),PKW(pB0,6)};pw1=(u32x4){PKW(pB0,8),PKW(pB0,10),PKW(pB0,12),PKW(pB0,14)};pw2=(u32x4){PKW(pB1,0),PKW(pB1,2),PKW(pB1,4),PKW(pB1,6)};pw3=(u32x4){PKW(pB1,8),PKW(pB1,10),PKW(pB1,12),PKW(pB1,14)};
    SBAR(); pv(o,vb0+sl_cur,PAF(0),PAF(1),PAF(2),PAF(3)); }
  #undef PKW
  #undef PAF
  #undef VFR
  #undef PIN
  #undef MX3
  #undef GAPA
  #undef GAPB
  #undef EX
  #undef VRD
  #undef KRD
  #undef STEP
  #undef ENDW
  {auto rr=__builtin_amdgcn_permlane32_swap(__float_as_uint(l_reg),__float_as_uint(l_reg),false,false);l_reg=__uint_as_float(rr[0])+__uint_as_float(rr[1]);}
  if(hi==0)wsf[32+r32]=l_reg;asm volatile("s_waitcnt lgkmcnt(0)":::"memory");
  float rli[16];
  #pragma unroll
  for(int r=0;r<16;++r)rli[r]=__builtin_amdgcn_rcpf(wsf[32+crow(r,hi)]);
  bf16*Ow=O+(rowbase+q0+wid*QBLK)*POUT;
  { bf16*stg=(bf16*)(shm+LDS_OST)+wid*2048;
    #pragma unroll
    for(int r=0;r<16;++r){const int orow=crow(r,hi);
      #pragma unroll
      for(int d0=0;d0<2;++d0)stg[orow*64+d0*32+r32]=__float2bfloat16(o[d0][r]*rli[r]);}
    asm volatile("s_waitcnt lgkmcnt(0)":::"memory");
    #pragma unroll
    for(int i=0;i<4;++i){const int row=i*8+(lane>>3),ch=lane&7; const u32x4 v=*(const u32x4*)(stg+row*64+ch*8); ATTN_STORE16(Ow+(long)row*POUT+ch*8,v);} }
  asm volatile("s_waitcnt lgkmcnt(0)\n\ts_barrier":::"memory");
  #undef DMA_K
  #undef DMA_V
  #undef CMASK
  #undef START
  #undef RESC
  #undef ROT
}
constexpr int ATTN_LDS_BYTES=LDS_BYTES;
#undef SBAR
#undef WAIT_BAR
}

#define GAS __attribute__((address_space(1)))
#define LAS __attribute__((address_space(3)))
typedef unsigned short bf16;
typedef unsigned v4u __attribute__((ext_vector_type(4)));
typedef float f32x4 __attribute__((ext_vector_type(4)));
typedef short bf16x8 __attribute__((ext_vector_type(8)));
typedef GAS unsigned gu32;
typedef GAS unsigned long long gu64;
#define RLX_AGENT __ATOMIC_RELAXED, __HIP_MEMORY_SCOPE_AGENT
#define LDS_WAIT() asm volatile("s_waitcnt lgkmcnt(0)" ::: "memory")
#define VM_WAIT() asm volatile("s_waitcnt vmcnt(0)" ::: "memory")
__device__ __forceinline__ unsigned long long rt() { return __builtin_amdgcn_s_memrealtime(); }
__device__ __forceinline__ unsigned f2bf(float f) { unsigned u = __builtin_bit_cast(unsigned, f); return (u + 0x7fffu + ((u >> 16) & 1u)) >> 16; }
__device__ __forceinline__ unsigned pk2(float lo, float hi) { return f2bf(lo) | (f2bf(hi) << 16); }

#define XB_TMO      128
#define XB_XCNT(j)  (256  + 64 * (j))
#define XB_XSUB(j)  (1280 + 64 * (j))
#define XB_XGEN(j)  (2304 + 64 * (j))
#define XB_TOP      3328
#define XB_TOPGEN   3392
#define XCD_BAR_WORDS 3456
#define XB_SPIN_CAP (1u << 18)

__device__ __forceinline__ unsigned xb_ld(unsigned* p)              { return __hip_atomic_load(p, __ATOMIC_RELAXED, __HIP_MEMORY_SCOPE_AGENT); }
__device__ __forceinline__ unsigned xb_add(unsigned* p, unsigned v) { return __hip_atomic_fetch_add(p, v, __ATOMIC_RELAXED, __HIP_MEMORY_SCOPE_AGENT); }
__device__ __forceinline__ unsigned xb_xcc_id() { return (unsigned)__builtin_amdgcn_s_getreg((3 << 11) | 20) & 0xFu; }
#define XB_SPIN(cond, bar) do { unsigned _sp = 0; while (cond) { __builtin_amdgcn_s_sleep(1); \
    if ((++_sp & 255u) == 0u) { if (xb_ld(&(bar)[XB_TMO])) break; if (_sp > XB_SPIN_CAP) { atomicAdd(&(bar)[XB_TMO], 1u); break; } } } } while (0)

struct XcdBarrier {
    unsigned* bar; unsigned x;
    volatile LAS unsigned* st;
};

__device__ __forceinline__ XcdBarrier xcd_barrier_post(unsigned* bar, volatile LAS unsigned* st) {
    XcdBarrier b; b.bar = bar; b.x = xb_xcc_id(); b.st = st;
    if (threadIdx.x == 0) (void)xb_add(&bar[XB_XCNT(b.x)], 1u);
    return b;
}
__device__ __forceinline__ void xcd_barrier_complete(unsigned* bar, unsigned x, unsigned& nloc, unsigned& nx) {
    const unsigned G = gridDim.x * gridDim.y * gridDim.z;
    unsigned sum, cnt, mine, sp = 0u;
    for (;;) {
        sum = 0u; cnt = 0u; mine = 0u;
#pragma unroll
        for (unsigned j = 0; j < 16; ++j) { const unsigned c = xb_ld(&bar[XB_XCNT(j)]); sum += c; cnt += (c > 0u) ? 1u : 0u; mine = (j == x) ? c : mine; }
        if (sum == G) break;
        __builtin_amdgcn_s_sleep(1);
        if ((++sp & 255u) == 0u) { if (xb_ld(&bar[XB_TMO])) break; if (sp > XB_SPIN_CAP) { atomicAdd(&bar[XB_TMO], 1u); break; } }
    }
    nloc = mine > 0u ? mine : 1u; nx = cnt > 0u ? cnt : 1u;
}

__device__ __forceinline__ void xcd_barrier(const XcdBarrier& b) {
    asm volatile("s_waitcnt vmcnt(0)" ::: "memory");
    __syncthreads();
    if (threadIdx.x == 0) {
        unsigned* bar = b.bar;
        __builtin_amdgcn_s_waitcnt(0);
        unsigned nloc = b.st[0], nx = b.st[1];
        if (nloc == 0u) { xcd_barrier_complete(bar, b.x, nloc, nx); b.st[0] = nloc; b.st[1] = nx; }
        const unsigned old = xb_add(&bar[XB_XSUB(b.x)], 1u);
        const unsigned gen = old / nloc;
        if (old + 1u == (gen + 1u) * nloc) {
            __builtin_amdgcn_fence(__ATOMIC_RELEASE, "agent");
            asm volatile("s_waitcnt vmcnt(0)" ::: "memory");
            const unsigned og = xb_add(&bar[XB_TOP], 1u);
            const unsigned tg = og / nx;
            if (og + 1u == (tg + 1u) * nx) xb_add(&bar[XB_TOPGEN], 1u);
            else XB_SPIN(xb_ld(&bar[XB_TOPGEN]) == tg, bar);
            __builtin_amdgcn_fence(__ATOMIC_ACQUIRE, "agent");
            xb_add(&bar[XB_XGEN(b.x)], 1u);
            asm volatile("s_waitcnt vmcnt(0)" ::: "memory");
        } else {
            XB_SPIN(xb_ld(&bar[XB_XGEN(b.x)]) == gen, bar);
            __builtin_amdgcn_fence(__ATOMIC_ACQUIRE, "agent");
            asm volatile("s_waitcnt vmcnt(0)" ::: "memory");
        }
    }
    __syncthreads();
}

constexpr int NWAVES = 8;
constexpr int BATCH = 16, SEQ = 2048, D = 1024, M = BATCH * SEQ;
constexpr int NPROJ = 3584;
constexpr int C_RQ = 0, C_RK = 512, C_RV = 1024, C_RG = 1536, C_DQ = 2048, C_DK = 2560, C_DV = 3072;
constexpr int NQ = 2048, NEXP = 16384, NSEL = 128;
constexpr float ALPHA = 1.189207115002721f, LN_EPS = 1e-5f, LAMBDA_INIT = 0.2f;
constexpr float QSCALE = 0.125f * 1.4426950408889634f;
constexpr float KSCALE = 0.08838834764831845f;

constexpr size_t MiB = 1u << 20;
constexpr size_t WS_CTL = 0, CTL_ZERO_BYTES = 1 * MiB;
constexpr size_t WS_WIN = 2 * MiB, WS_WOUT = 10 * MiB, WS_WQ = 12 * MiB, WS_SK = 16 * MiB, WS_ROPE = 17 * MiB, WS_MISC = 18 * MiB;
constexpr size_t WS_XB = 32 * MiB;
constexpr size_t WS_DOUT = 32 * MiB;
constexpr size_t WS_PU = 96 * MiB, WS_PV = 128 * MiB;
constexpr size_t WS_PROJ = 160 * MiB;
constexpr size_t WS_X1 = 160 * MiB, WS_IDX = 224 * MiB, WS_GATE = 240 * MiB, WS_QP = 256 * MiB;
constexpr size_t WS_MIX = 400 * MiB;
constexpr size_t WS_END = 496 * MiB;
constexpr int CW_TMO = 0, CW_CODE = 1, CW_BAR = 4096;

constexpr int RING_OFF = 0, RING_BYTES = 131072;
constexpr int LDSCTL_OFF = RING_BYTES, MISC_OFF = LDSCTL_OFF + 320;
constexpr int LDS_BYTES = 147456;

struct Frame {
    LAS unsigned char* lds;
    volatile LAS unsigned* MISC;
    gu32* ctl;
    int tid, lane, wave;
    int vcu, G;
    const float* const* in; float* out; unsigned char* ws;
};

__device__ __forceinline__ float bf2f(unsigned short b) { return __builtin_bit_cast(float, (unsigned)b << 16); }
__device__ __forceinline__ float bflo(unsigned w) { return __builtin_bit_cast(float, w << 16); }
__device__ __forceinline__ float bfhi(unsigned w) { return __builtin_bit_cast(float, w & 0xffff0000u); }
__device__ __forceinline__ float wave_sum(float v) {
#pragma unroll
    for (int o = 1; o < 64; o <<= 1) v += __shfl_xor(v, o);
    return v;
}
__device__ __forceinline__ float wave_max(float v) {
#pragma unroll
    for (int o = 1; o < 64; o <<= 1) v = fmaxf(v, __shfl_xor(v, o));
    return v;
}
__device__ __forceinline__ float dot8(v4u a, v4u b, float s) {
    s = fmaf(bflo(a.x), bflo(b.x), s); s = fmaf(bfhi(a.x), bfhi(b.x), s);
    s = fmaf(bflo(a.y), bflo(b.y), s); s = fmaf(bfhi(a.y), bfhi(b.y), s);
    s = fmaf(bflo(a.z), bflo(b.z), s); s = fmaf(bfhi(a.z), bfhi(b.z), s);
    s = fmaf(bflo(a.w), bflo(b.w), s); s = fmaf(bfhi(a.w), bfhi(b.w), s);
    return s;
}

__device__ __forceinline__ unsigned offb(unsigned row, unsigned ch) { return 256u * row + 16u * (ch ^ (((row & 3u) << 2) | ((row >> 2) & 3u))); }
__device__ __forceinline__ int phys_col(int L) { if (L >= 1024) return L; const int hd = L >> 7, l = L & 127; return hd * 128 + (l < 64 ? 2 * l : 2 * (l - 64) + 1); }
template <bool PERMQK>
__device__ __forceinline__ void p0_transpose_item(const float* W, int K, int N, bf16* WT, LAS float* scr, int item, int lane) {
    const int nblk = N / 32, kb = item / nblk, nb = item % nblk, k0 = 64 * kb, n0 = 32 * nb;
#pragma unroll 8
    for (int i = 0; i < 32; ++i) { const int kk = 2 * i + (lane >> 5); scr[kk * 33 + (lane & 31)] = W[(size_t)(k0 + kk) * N + n0 + (lane & 31)]; }
    LDS_WAIT(); asm volatile("" ::: "memory");
    const int c = lane & 7;
#pragma unroll
    for (int j = 0; j < 4; ++j) { const int n = (lane >> 3) + 8 * j; const LAS float* s = scr + (8 * c) * 33 + n;
        v4u o; o.x = pk2(s[0 * 33], s[1 * 33]); o.y = pk2(s[2 * 33], s[3 * 33]); o.z = pk2(s[4 * 33], s[5 * 33]); o.w = pk2(s[6 * 33], s[7 * 33]);
        const int orow = PERMQK ? phys_col(n0 + n) : (n0 + n);
        *(GAS v4u*)(WT + (size_t)orow * K + k0 + 8 * c) = o; }
    LDS_WAIT(); asm volatile("" ::: "memory");
}
__device__ __forceinline__ void cvt_bf16_stream(const float* src, bf16* dst, size_t n4, int gt, int ngt) {
    for (size_t i = gt; i < n4; i += ngt) { const f32x4 v = ((const GAS f32x4*)src)[i]; typedef unsigned u2 __attribute__((ext_vector_type(2))); u2 o; o.x = pk2(v.x, v.y); o.y = pk2(v.z, v.w); ((GAS u2*)dst)[i] = o; }
}
__device__ __forceinline__ void p0_prologue(Frame& F) {
    LAS float* scr = (LAS float*)(F.lds + RING_OFF + F.wave * 16384);
    const int gw = F.vcu * NWAVES + F.wave, NGW = F.G * NWAVES;
    const int gt = (int)blockIdx.x * (NWAVES * 64) + F.tid, ngt = F.G * NWAVES * 64;
    constexpr int I_IN = (D / 64) * (NPROJ / 32), I_OUT = (D / 64) * (D / 32), I_Q = (D / 64) * (NQ / 32);
    constexpr int NITEMS = I_IN + I_OUT + I_Q;
    for (int it = gw; it < NITEMS; it += NGW) {
        int r = it;
        if (r < I_IN) { p0_transpose_item<true>(F.in[1], D, NPROJ, (bf16*)(F.ws + WS_WIN), scr, r, F.lane); continue; } r -= I_IN;
        if (r < I_OUT) { p0_transpose_item<false>(F.in[9], D, D, (bf16*)(F.ws + WS_WOUT), scr, r, F.lane); continue; } r -= I_OUT;
        p0_transpose_item<false>(F.in[12], D, NQ, (bf16*)(F.ws + WS_WQ), scr, r, F.lane);
    }
    cvt_bf16_stream(F.in[13], (bf16*)(F.ws + WS_SK), (size_t)8 * 2 * 128 * 128 / 4, gt, ngt);
    cvt_bf16_stream(F.in[14], (bf16*)(F.ws + WS_PU), (size_t)NEXP * D / 4, gt, ngt);
    cvt_bf16_stream(F.in[15], (bf16*)(F.ws + WS_PV), (size_t)NEXP * D / 4, gt, ngt);
    cvt_bf16_stream(F.in[0], (bf16*)(F.ws + WS_XB), (size_t)M * D / 4, gt, ngt);
    float* rope = (float*)(F.ws + WS_ROPE);
    for (int e = gt; e < SEQ * 64; e += ngt) {
        const int pos = e >> 6, i = e & 63;
        const float inv = exp2f(-(float)i * (13.287712379549449f / 64.f));
        const float ang = (float)pos * inv;
        const float k = rintf(ang * 0.15915494309189535f);
        float r = fmaf(-k, 6.2831854820251465f, ang); r = fmaf(-k, -1.7484555314695172e-07f, r);
        rope[2 * e] = cosf(r); rope[2 * e + 1] = sinf(r);
    }
}

__device__ __forceinline__ void p2_retention_naive(Frame& F) {
    const bf16* PROJ = (const bf16*)(F.ws + WS_PROJ); bf16* MIX = (bf16*)(F.ws + WS_MIX);
    LAS float* S = (LAS float*)(F.lds + RING_OFF); LAS float* ST = S + 128 * 128;
    const float* gn_g = F.in[2]; const float* gn_b = F.in[3];
    const int t = F.tid;
    for (int u = (int)blockIdx.x; u < BATCH * 4; u += F.G) {
        const int b = u >> 2, h = u & 3;
        const float gam = 1.f - exp2f(-5.f - (float)h); const float l2g = log2f(gam);
        for (int e = t; e < 128 * 128; e += NWAVES * 64) ST[e] = 0.f;
        __syncthreads();
        for (int c = 0; c < 16; ++c) {
            const size_t rb = (size_t)b * SEQ + c * 128;
            {
                const int i = t >> 2, jq = t & 3;
                const GAS v4u* qp = (const GAS v4u*)(PROJ + (rb + i) * NPROJ + C_RQ + h * 128);
#pragma unroll 1
                for (int jj = 0; jj < 32; ++jj) { const int j = jq * 32 + jj; float s = 0.f;
                    if (j <= i) { const GAS v4u* kp = (const GAS v4u*)(PROJ + (rb + j) * NPROJ + C_RK + h * 128);
#pragma unroll
                        for (int d = 0; d < 16; ++d) s = dot8(qp[d], kp[d], s);
                        s *= exp2f((float)(i - j) * l2g); }
                    S[i * 128 + j] = s; }
            }
            __syncthreads();
            {
                const int i = t >> 2, vq = t & 3;
                float o[32];
#pragma unroll
                for (int v = 0; v < 32; ++v) o[v] = 0.f;
#pragma unroll 2
                for (int j = 0; j <= i; ++j) { const float sij = S[i * 128 + j];
                    const GAS v4u* vp = (const GAS v4u*)(PROJ + (rb + j) * NPROJ + C_RV + h * 128 + vq * 32);
#pragma unroll
                    for (int q4 = 0; q4 < 4; ++q4) { const v4u w = vp[q4];
                        o[q4 * 8 + 0] = fmaf(sij, bflo(w.x), o[q4 * 8 + 0]); o[q4 * 8 + 1] = fmaf(sij, bfhi(w.x), o[q4 * 8 + 1]);
                        o[q4 * 8 + 2] = fmaf(sij, bflo(w.y), o[q4 * 8 + 2]); o[q4 * 8 + 3] = fmaf(sij, bfhi(w.y), o[q4 * 8 + 3]);
                        o[q4 * 8 + 4] = fmaf(sij, bflo(w.z), o[q4 * 8 + 4]); o[q4 * 8 + 5] = fmaf(sij, bfhi(w.z), o[q4 * 8 + 5]);
                        o[q4 * 8 + 6] = fmaf(sij, bflo(w.w), o[q4 * 8 + 6]); o[q4 * 8 + 7] = fmaf(sij, bfhi(w.w), o[q4 * 8 + 7]); } }
                const float dq = exp2f((float)(i + 1) * l2g);
                const GAS unsigned short* qrow = (const GAS unsigned short*)(PROJ + (rb + i) * NPROJ + C_RQ + h * 128);
#pragma unroll 2
                for (int d = 0; d < 128; ++d) { const float qd = bf2f(qrow[d]) * dq; const LAS float* sp = ST + d * 128 + vq * 32;
#pragma unroll
                    for (int v = 0; v < 32; ++v) o[v] = fmaf(qd, sp[v], o[v]); }
                float sm = 0.f;
#pragma unroll
                for (int v = 0; v < 32; ++v) sm += o[v];
                sm += __shfl_xor(sm, 1); sm += __shfl_xor(sm, 2);
                const float mu = sm * (1.f / 128.f); float q2 = 0.f;
#pragma unroll
                for (int v = 0; v < 32; ++v) { const float dlt = o[v] - mu; q2 += dlt * dlt; }
                q2 += __shfl_xor(q2, 1); q2 += __shfl_xor(q2, 2);
                const float rstd = 1.f / sqrtf(q2 * (1.f / 128.f) + LN_EPS);
                const GAS unsigned short* grow = (const GAS unsigned short*)(PROJ + (rb + i) * NPROJ + C_RG + h * 128 + vq * 32);
                GAS unsigned short* mrow = (GAS unsigned short*)(MIX + (rb + i) * D + h * 128 + vq * 32);
#pragma unroll
                for (int v = 0; v < 32; ++v) { const int ch = h * 128 + vq * 32 + v; const float r = bf2f(grow[v]) * ((o[v] - mu) * rstd * gn_g[ch] + gn_b[ch]); mrow[v] = (unsigned short)f2bf(r); }
            }
            __syncthreads();
            {
                const int d = t >> 2, vq = t & 3;
                float a[32];
                const float dc = exp2f(128.f * l2g);
                LAS float* sp = ST + d * 128 + vq * 32;
#pragma unroll
                for (int v = 0; v < 32; ++v) a[v] = sp[v] * dc;
#pragma unroll 2
                for (int j = 0; j < 128; ++j) { const float kd = bf2f(((const GAS unsigned short*)PROJ)[(rb + j) * NPROJ + C_RK + h * 128 + d]) * exp2f((float)(127 - j) * l2g);
                    const GAS v4u* vp = (const GAS v4u*)(PROJ + (rb + j) * NPROJ + C_RV + h * 128 + vq * 32);
#pragma unroll
                    for (int q4 = 0; q4 < 4; ++q4) { const v4u w = vp[q4];
                        a[q4 * 8 + 0] = fmaf(kd, bflo(w.x), a[q4 * 8 + 0]); a[q4 * 8 + 1] = fmaf(kd, bfhi(w.x), a[q4 * 8 + 1]);
                        a[q4 * 8 + 2] = fmaf(kd, bflo(w.y), a[q4 * 8 + 2]); a[q4 * 8 + 3] = fmaf(kd, bfhi(w.y), a[q4 * 8 + 3]);
                        a[q4 * 8 + 4] = fmaf(kd, bflo(w.z), a[q4 * 8 + 4]); a[q4 * 8 + 5] = fmaf(kd, bfhi(w.z), a[q4 * 8 + 5]);
                        a[q4 * 8 + 6] = fmaf(kd, bflo(w.w), a[q4 * 8 + 6]); a[q4 * 8 + 7] = fmaf(kd, bfhi(w.w), a[q4 * 8 + 7]); } }
#pragma unroll
                for (int v = 0; v < 32; ++v) sp[v] = a[v];
            }
            __syncthreads();
        }
    }
}

__device__ __forceinline__ float diff_lambda(Frame& F) {
    const float a = wave_sum(F.in[4][F.lane] * F.in[5][F.lane]); const float b = wave_sum(F.in[6][F.lane] * F.in[7][F.lane]);
    return expf(a) - expf(b) + LAMBDA_INIT;
}
__device__ __forceinline__ void p2_diffattn_naive(Frame& F) {
    const bf16* PROJ = (const bf16*)(F.ws + WS_PROJ); bf16* MIX = (bf16*)(F.ws + WS_MIX);
    LAS float* sb = (LAS float*)(F.lds + RING_OFF) + F.wave * 2048;
    const float lam = diff_lambda(F);
    const float* sg = F.in[8];
    const int gw = (int)blockIdx.x * NWAVES + F.wave, NGW = F.G * NWAVES;
    const int lane = F.lane;
    for (int task = gw; task < BATCH * 4 * SEQ; task += NGW) {
        const int i = task >> 6, bh = task & 63, b = bh >> 2, h = bh & 3;
        const size_t rb = (size_t)b * SEQ;
        float oc[2][2];
#pragma unroll
        for (int c = 0; c < 2; ++c) {
            const GAS v4u* qp = (const GAS v4u*)(PROJ + (rb + i) * NPROJ + C_DQ + h * 128 + c * 64);
            v4u q[8];
#pragma unroll
            for (int d = 0; d < 8; ++d) q[d] = qp[d];
            float mx = -INFINITY;
#pragma unroll 1
            for (int j0 = 0; j0 <= i; j0 += 64) { const int j = j0 + lane;
                if (j <= i) { const GAS v4u* kp = (const GAS v4u*)(PROJ + (rb + j) * NPROJ + C_DK + h * 128 + c * 64); float s = 0.f;
#pragma unroll
                    for (int d = 0; d < 8; ++d) s = dot8(q[d], kp[d], s);
                    sb[j] = s; mx = fmaxf(mx, s); } }
            mx = wave_max(mx);
            float l = 0.f;
            for (int j0 = 0; j0 <= i; j0 += 64) { const int j = j0 + lane; if (j <= i) { const float p = exp2f(sb[j] - mx); sb[j] = p; l += p; } }
            l = wave_sum(l);
            LDS_WAIT(); asm volatile("" ::: "memory");
            float o0 = 0.f, o1 = 0.f;
            const GAS unsigned* vp = (const GAS unsigned*)(PROJ + rb * NPROJ + C_DV + h * 128) + lane;
#pragma unroll 4
            for (int j = 0; j <= i; ++j) { const float p = sb[j]; const unsigned w = vp[(size_t)j * (NPROJ / 2)]; o0 = fmaf(p, bflo(w), o0); o1 = fmaf(p, bfhi(w), o1); }
            const float rl = 1.f / l; oc[c][0] = o0 * rl; oc[c][1] = o1 * rl;
            LDS_WAIT(); asm volatile("" ::: "memory");
        }
        const float d0 = oc[0][0] - lam * oc[1][0], d1 = oc[0][1] - lam * oc[1][1];
        const float ms = wave_sum(d0 * d0 + d1 * d1) * (1.f / 128.f);
        const float rs = (1.f - LAMBDA_INIT) / sqrtf(ms + LN_EPS);
        const int ch = h * 128 + 2 * lane;
        ((GAS unsigned*)(MIX + (rb + i) * D + 512 + h * 128))[lane] = pk2(d0 * rs * sg[ch], d1 * rs * sg[ch + 1]);
    }
}


typedef short v4i16_t __attribute__((ext_vector_type(4)));
__device__ __forceinline__ bf16x8 frag_row(LAS const unsigned char* img, int lane, int rb, int s) { return *(const LAS bf16x8*)(img + offb((unsigned)((lane & 15) + 16 * rb), (unsigned)(4 * s + (lane >> 4)))); }
__device__ __forceinline__ bf16x8 frag_tr(LAS const unsigned char* img, int lane, int c, int ks) {
    const unsigned g = (unsigned)lane >> 4, q = ((unsigned)lane & 15u) >> 2, p = (unsigned)lane & 3u;
    const unsigned a0 = offb(32u * ks + 8u * g + q, 2u * c + (p >> 1)) + 8u * (p & 1u), a1 = offb(32u * ks + 8u * g + 4u + q, 2u * c + (p >> 1)) + 8u * (p & 1u);
    const v4i16_t t0 = __builtin_amdgcn_ds_read_tr16_b64_v4i16((LAS v4i16_t*)(img + a0)), t1 = __builtin_amdgcn_ds_read_tr16_b64_v4i16((LAS v4i16_t*)(img + a1));
    return (bf16x8){t0[0], t0[1], t0[2], t0[3], t1[0], t1[1], t1[2], t1[3]};
}
constexpr size_t WS_ST = 464 * MiB;
__device__ __forceinline__ void p2_retention_scan(Frame& F) {
    const bf16* PROJ = (const bf16*)(F.ws + WS_PROJ); bf16* ST = (bf16*)(F.ws + WS_ST);
    int tid = F.tid; asm volatile("" : "+v"(tid)); const int lane = tid & 63, wave = F.wave;
    for (int u = F.vcu; u < BATCH * 4 * 4; u += F.G) {
        const int bh = u >> 2, vq = u & 3, b = bh >> 2, h = bh & 3;
        const float l2g = log2f(1.f - exp2f(-5.f - (float)h)); const float dc = exp2f(128.f * l2g);
        f32x4 acc[2] = {(f32x4){0.f, 0.f, 0.f, 0.f}, (f32x4){0.f, 0.f, 0.f, 0.f}};
        v4u rk[4], rv[4];
#define RET_LOADKV(cc) do { _Pragma("unroll") for (int q = 0; q < 4; ++q) { const int id = tid + 512 * q, row = id >> 4, ch = id & 15; const size_t r = (size_t)b * SEQ + (cc) * 128 + row; \
            rk[q] = *(const GAS v4u*)(PROJ + r * NPROJ + C_RK + h * 128 + ch * 8); rv[q] = *(const GAS v4u*)(PROJ + r * NPROJ + C_RV + h * 128 + ch * 8); } } while (0)
        RET_LOADKV(0);
#pragma unroll 1
        for (int c = 0; c < 16; ++c) {
            LAS unsigned char* kimg = F.lds + RING_OFF + (c & 1) * 65536; LAS unsigned char* vimg = kimg + 32768;
#pragma unroll
            for (int q = 0; q < 4; ++q) { const int id = tid + 512 * q, row = id >> 4, ch = id & 15; const float sc = exp2f((float)(127 - row) * l2g);
                v4u w = rk[q]; w.x = pk2(bflo(w.x) * sc, bfhi(w.x) * sc); w.y = pk2(bflo(w.y) * sc, bfhi(w.y) * sc); w.z = pk2(bflo(w.z) * sc, bfhi(w.z) * sc); w.w = pk2(bflo(w.w) * sc, bfhi(w.w) * sc);
                *(LAS v4u*)(kimg + offb((unsigned)row, (unsigned)ch)) = w; *(LAS v4u*)(vimg + offb((unsigned)row, (unsigned)ch)) = rv[q]; }
            if (c + 1 < 16) RET_LOADKV(c + 1);
            { bf16* sp = ST + ((size_t)(bh * 16 + c) * 128) * 128;
#pragma unroll
              for (int mb = 0; mb < 2; ++mb)
#pragma unroll
                  for (int rg = 0; rg < 4; ++rg) ((GAS unsigned short*)sp)[(size_t)(32 * vq + 16 * mb + 4 * (lane >> 4) + rg) * 128 + 16 * wave + (lane & 15)] = (unsigned short)f2bf(acc[mb][rg]); }
            __syncthreads();
#pragma unroll
            for (int mb = 0; mb < 2; ++mb) acc[mb] = acc[mb] * dc;
#pragma unroll
            for (int ks = 0; ks < 4; ++ks) { const bf16x8 bk = frag_tr(kimg, lane, wave, ks);
#pragma unroll
                for (int mb = 0; mb < 2; ++mb) { const bf16x8 av = frag_tr(vimg, lane, 2 * vq + mb, ks); acc[mb] = __builtin_amdgcn_mfma_f32_16x16x32_bf16(av, bk, acc[mb], 0, 0, 0); } }
        }
#undef RET_LOADKV
        __syncthreads();
    }
}
__device__ __forceinline__ void p3_retention_out(Frame& F) {
    const bf16* PROJ = (const bf16*)(F.ws + WS_PROJ); const bf16* ST = (const bf16*)(F.ws + WS_ST); bf16* MIX = (bf16*)(F.ws + WS_MIX);
    const float* gn_g = F.in[2]; const float* gn_b = F.in[3];
    int tid = F.tid; asm volatile("" : "+v"(tid)); const int lane = tid & 63, w = F.wave, g = lane >> 4, ln = lane & 15;
    LAS unsigned char* qimg = F.lds + RING_OFF; LAS unsigned char* kimg = qimg + 32768; LAS unsigned char* vimg = qimg + 65536; LAS unsigned char* pimg = qimg + 98304;
#pragma unroll 1
    for (int it = F.vcu; it < BATCH * 4 * 16; it += F.G) {
        const int bh = it >> 4, c = it & 15, b = bh >> 2, h = bh & 3;
        const float l2g = log2f(1.f - exp2f(-5.f - (float)h));
        const size_t rb0 = (size_t)b * SEQ + c * 128;
#pragma unroll
        for (int q = 0; q < 4; ++q) { const int id = tid + 512 * q, row = id >> 4, ch = id & 15; const bf16* pr = PROJ + (rb0 + row) * NPROJ + h * 128 + ch * 8; const unsigned o = offb((unsigned)row, (unsigned)ch);
            *(LAS v4u*)(qimg + o) = *(const GAS v4u*)(pr + C_RQ); *(LAS v4u*)(kimg + o) = *(const GAS v4u*)(pr + C_RK); *(LAS v4u*)(vimg + o) = *(const GAS v4u*)(pr + C_RV); }
        __syncthreads();
        bf16x8 qf[4];
#pragma unroll
        for (int s4 = 0; s4 < 4; ++s4) qf[s4] = frag_row(qimg, lane, w, s4);
        f32x4 oacc[8];
        { const bf16* sp = ST + ((size_t)(bh * 16 + c) * 128 + ln) * 128 + 8 * g;
#pragma unroll
          for (int nb = 0; nb < 8; ++nb) { oacc[nb] = (f32x4){0.f, 0.f, 0.f, 0.f};
#pragma unroll
              for (int s4 = 0; s4 < 4; ++s4) oacc[nb] = __builtin_amdgcn_mfma_f32_16x16x32_bf16(qf[s4], *(const GAS bf16x8*)(sp + (size_t)(16 * nb) * 128 + 32 * s4), oacc[nb], 0, 0, 0); } }
        { float dq[4];
#pragma unroll
          for (int rg = 0; rg < 4; ++rg) dq[rg] = exp2f((float)(16 * w + 4 * g + rg + 1) * l2g);
#pragma unroll
          for (int nb = 0; nb < 8; ++nb)
#pragma unroll
              for (int rg = 0; rg < 4; ++rg) oacc[nb][rg] *= dq[rg]; }
        { const float el = exp2f((float)(ln - 4 * g) * l2g); float fr[4];
#pragma unroll
          for (int rg = 0; rg < 4; ++rg) fr[rg] = el * exp2f(-(float)rg * l2g);
          typedef unsigned u2_t __attribute__((ext_vector_type(2)));
#pragma unroll 1
          for (int jb = 0; jb <= w; ++jb) {
              f32x4 sacc = (f32x4){0.f, 0.f, 0.f, 0.f};
#pragma unroll
              for (int s4 = 0; s4 < 4; ++s4) sacc = __builtin_amdgcn_mfma_f32_16x16x32_bf16(frag_row(kimg, lane, jb, s4), qf[s4], sacc, 0, 0, 0);
              const float fb = exp2f((float)(16 * (w - jb)) * l2g); float p4[4];
#pragma unroll
              for (int rg = 0; rg < 4; ++rg) { const int dlt = 16 * (w - jb) + ln - 4 * g - rg; p4[rg] = dlt >= 0 ? sacc[rg] * (fb * fr[rg]) : 0.f; }
              u2_t pk; pk.x = pk2(p4[0], p4[1]); pk.y = pk2(p4[2], p4[3]);
              *(LAS u2_t*)(pimg + offb((unsigned)(16 * w + ln), (unsigned)(2 * jb + (g >> 1))) + 8 * (g & 1)) = pk; }
          if ((w & 1) == 0) { u2_t z; z.x = 0u; z.y = 0u; *(LAS u2_t*)(pimg + offb((unsigned)(16 * w + ln), (unsigned)(2 * (w + 1) + (g >> 1))) + 8 * (g & 1)) = z; } }
        LDS_WAIT(); asm volatile("" ::: "memory");
#pragma unroll 1
        for (int ks = 0; ks <= (w >> 1); ++ks) { const bf16x8 pa = frag_row(pimg, lane, w, ks);
#pragma unroll
            for (int nb = 0; nb < 8; ++nb) oacc[nb] = __builtin_amdgcn_mfma_f32_16x16x32_bf16(pa, frag_tr(vimg, lane, nb, ks), oacc[nb], 0, 0, 0); }
        float mu[4], rs[4];
#pragma unroll
        for (int rg = 0; rg < 4; ++rg) { float sm = 0.f;
#pragma unroll
            for (int nb = 0; nb < 8; ++nb) sm += oacc[nb][rg];
            sm += __shfl_xor(sm, 1); sm += __shfl_xor(sm, 2); sm += __shfl_xor(sm, 4); sm += __shfl_xor(sm, 8); mu[rg] = sm * (1.f / 128.f);
            float q2 = 0.f;
#pragma unroll
            for (int nb = 0; nb < 8; ++nb) { const float dl = oacc[nb][rg] - mu[rg]; q2 += dl * dl; }
            q2 += __shfl_xor(q2, 1); q2 += __shfl_xor(q2, 2); q2 += __shfl_xor(q2, 4); q2 += __shfl_xor(q2, 8); rs[rg] = 1.f / sqrtf(q2 * (1.f / 128.f) + LN_EPS); }
#pragma unroll
        for (int nb = 0; nb < 8; ++nb) { const int ch = h * 128 + 16 * nb + ln; const float gg = gn_g[ch], gb = gn_b[ch];
#pragma unroll
            for (int rg = 0; rg < 4; ++rg) { const size_t row = rb0 + 16 * w + 4 * g + rg;
                const float gate = bf2f(((const GAS unsigned short*)PROJ)[row * NPROJ + C_RG + ch]);
                ((GAS unsigned short*)MIX)[row * D + ch] = (unsigned short)f2bf(gate * ((oacc[nb][rg] - mu[rg]) * rs[rg] * gg + gb)); } }
        __syncthreads();
    }
}
struct DiffUnit { int b, h, qb, c, hf; };
struct DiffOrder {
    int pu;
    __device__ __forceinline__ bool next(int i, DiffUnit& u) const { if (i >= 8) return false; const int bh = pu >> 2, s = pu & 3; u.b = bh >> 2; u.h = bh & 3; u.qb = (i >> 2) ? s : 7 - s; u.c = (i >> 1) & 1; u.hf = i & 1; return true; }
};
__device__ __forceinline__ void diff_combine(Frame& F, const DiffUnit& u) {
    VM_WAIT();
    const float lam = diff_lambda(F);
    const float* sg = F.in[8] + u.h * 128 + 2 * F.lane;
    const float g0 = sg[0], g1 = sg[1];
    const size_t row0 = (size_t)u.b * SEQ + u.qb * 256 + F.wave * 32;
    const GAS unsigned* op = (const GAS unsigned*)((const bf16*)(F.ws + WS_DOUT) + row0 * 1024 + u.h * 256) + F.lane;
    GAS unsigned* mp = (GAS unsigned*)((bf16*)(F.ws + WS_MIX) + row0 * D + 512 + u.h * 128) + F.lane;
#pragma unroll 4
    for (int r = 0; r < 32; ++r) {
        const unsigned w1 = op[r * 512], w2 = op[r * 512 + 64];
        const float d0 = bflo(w1) - lam * bflo(w2), d1 = bfhi(w1) - lam * bfhi(w2);
        const float ms = wave_sum(d0 * d0 + d1 * d1) * (1.f / 128.f);
        const float rs = (1.f - LAMBDA_INIT) / sqrtf(ms + LN_EPS);
        mp[r * 512] = pk2(d0 * rs * g0, d1 * rs * g1);
    }
}
template <class Sched> __device__ __forceinline__ void diff_phase(Frame& F, char* lds, const attn_body::bf16* P, attn_body::bf16* O, const Sched& S) {
    DiffUnit u;
    for (int i = 0; S.next(i, u); ++i) { const attn_body::bf16* Ph = P + u.h * 128;
        attn_body::attn_unit<8>(u.b, u.qb, Ph + C_DQ + u.c * 64, Ph + C_DK + u.c * 64, Ph + C_DV + u.hf * 64, O + u.h * 256 + u.c * 128 + u.hf * 64, lds);
    }
}
__device__ __forceinline__ void p2_diffattn(Frame& F, char* lds_generic) {
    const DiffOrder S{F.vcu};
    diff_phase<DiffOrder>(F, lds_generic, (const attn_body::bf16*)(F.ws + WS_PROJ), (attn_body::bf16*)(F.ws + WS_DOUT), S);
    DiffUnit u;
    S.next(3, u); diff_combine(F, u);
    S.next(7, u); diff_combine(F, u);
}
__device__ __forceinline__ void p3_ln1_rows(Frame& F) {
    const float* Y = F.out; bf16* X1 = (bf16*)(F.ws + WS_X1); const float* g = F.in[10]; const float* bb = F.in[11];
    const int gw = (int)blockIdx.x * NWAVES + F.wave, NGW = F.G * NWAVES;
    for (int m = gw; m < M; m += NGW) {
        const GAS f32x4* xr = (const GAS f32x4*)(Y + (size_t)m * D) + F.lane;
        f32x4 v[4]; float s = 0.f;
#pragma unroll
        for (int j = 0; j < 4; ++j) { v[j] = xr[64 * j]; s += (v[j].x + v[j].y) + (v[j].z + v[j].w); }
        const float mean = wave_sum(s) * (1.f / D); float s2 = 0.f;
#pragma unroll
        for (int j = 0; j < 4; ++j) { v[j] = v[j] - mean; s2 += (v[j].x * v[j].x + v[j].y * v[j].y) + (v[j].z * v[j].z + v[j].w * v[j].w); }
        const float rstd = 1.f / sqrtf(wave_sum(s2) * (1.f / D) + LN_EPS);
        GAS unsigned long long* o8 = (GAS unsigned long long*)(X1 + (size_t)m * D) + F.lane;
#pragma unroll
        for (int j = 0; j < 4; ++j) { const f32x4 gg = ((const GAS f32x4*)g)[F.lane + 64 * j], bv = ((const GAS f32x4*)bb)[F.lane + 64 * j]; const f32x4 r = v[j] * rstd * gg + bv;
            o8[64 * j] = (unsigned long long)pk2(r.x, r.y) | ((unsigned long long)pk2(r.z, r.w) << 32); }
    }
}

__device__ __forceinline__ void argmax_step(float& v, int& i) {
#pragma unroll
    for (int o = 1; o < 64; o <<= 1) { const float ov = __shfl_xor(v, o); const int oi = __shfl_xor(i, o); if (ov > v || (ov == v && oi < i)) { v = ov; i = oi; } }
}
__device__ __forceinline__ void p5_topk_naive(Frame& F) {
    const bf16* QP = (const bf16*)(F.ws + WS_QP); const bf16* SK = (const bf16*)(F.ws + WS_SK);
    int* IDX = (int*)(F.ws + WS_IDX); float* GATE = (float*)(F.ws + WS_GATE);
    const int gw = (int)blockIdx.x * NWAVES + F.wave, NGW = F.G * NWAVES; const int lane = F.lane;
    for (int task = gw; task < M * 8; task += NGW) {
        const int t = task >> 3, h = task & 7;
        float ts[2]; int ti[2];
#pragma unroll
        for (int c = 0; c < 2; ++c) {
            const GAS v4u* qp = (const GAS v4u*)(QP + (size_t)t * NQ + h * 256 + c * 128);
            const GAS v4u* k0p = (const GAS v4u*)(SK + ((size_t)(h * 2 + c) * 128 + lane) * 128);
            const GAS v4u* k1p = (const GAS v4u*)(SK + ((size_t)(h * 2 + c) * 128 + lane + 64) * 128);
            float s0 = 0.f, s1 = 0.f;
#pragma unroll
            for (int d = 0; d < 16; ++d) { const v4u q = qp[d]; s0 = dot8(q, k0p[d], s0); s1 = dot8(q, k1p[d], s1); }
            float mys = 0.f; int myi = 0;
            for (int r = 0; r < 16; ++r) {
                float v = fmaxf(s0, s1); int ix = (s0 >= s1) ? lane : lane + 64;
                argmax_step(v, ix);
                if (lane == r) { mys = v; myi = ix; }
                if ((ix & 63) == lane) { if (ix < 64) s0 = -INFINITY; else s1 = -INFINITY; }
            }
            ts[c] = mys; ti[c] = myi;
        }
        float cs[4]; int ci[4];
#pragma unroll
        for (int q = 0; q < 4; ++q) { const int a = (lane >> 4) + 4 * q, bq = lane & 15; cs[q] = __shfl(ts[0], a) + __shfl(ts[1], bq); ci[q] = __shfl(ti[0], a) * 128 + __shfl(ti[1], bq); }
        float bs = 0.f; int be = 0;
        {
            LAS float* bsl = (LAS float*)(F.lds + RING_OFF) + F.wave * 32; LAS int* bel = (LAS int*)(bsl + 16);
            int rk[4] = {0, 0, 0, 0};
            for (int k = 0; k < 64; ++k) {
#pragma unroll
                for (int qq = 0; qq < 4; ++qq) { const float av = __shfl(cs[qq], k); const int an = k + 64 * qq;
#pragma unroll
                    for (int q = 0; q < 4; ++q) { const int n = lane + 64 * q; rk[q] += (av > cs[q] || (av == cs[q] && an < n)) ? 1 : 0; } } }
#pragma unroll
            for (int q = 0; q < 4; ++q) if (rk[q] < 16) { bsl[rk[q]] = cs[q]; bel[rk[q]] = ci[q]; }
            LDS_WAIT(); asm volatile("" ::: "memory");
            bs = bsl[lane & 15]; be = bel[lane & 15];
            LDS_WAIT(); asm volatile("" ::: "memory");
        }
        const float mx = __shfl(bs, 0);
        float ex = expf(bs - mx); float sm = ex;
        sm += __shfl_xor(sm, 1); sm += __shfl_xor(sm, 2); sm += __shfl_xor(sm, 4); sm += __shfl_xor(sm, 8);
        if (lane < 16) { IDX[(size_t)t * NSEL + h * 16 + lane] = be; GATE[(size_t)t * NSEL + h * 16 + lane] = ex / sm; }
    }
}

__device__ __forceinline__ void unpack8(v4u w, float* f) { f[0] = bflo(w.x); f[1] = bfhi(w.x); f[2] = bflo(w.y); f[3] = bfhi(w.y); f[4] = bflo(w.z); f[5] = bfhi(w.z); f[6] = bflo(w.w); f[7] = bfhi(w.w); }
__device__ __forceinline__ void p6_experts_naive(Frame& F) {
    const bf16* X1 = (const bf16*)(F.ws + WS_X1); const bf16* PU = (const bf16*)(F.ws + WS_PU); const bf16* PV = (const bf16*)(F.ws + WS_PV);
    const int* IDX = (const int*)(F.ws + WS_IDX); const float* GATE = (const float*)(F.ws + WS_GATE);
    const float* g2 = F.in[16]; const float* b2 = F.in[17];
    const int gw = (int)blockIdx.x * NWAVES + F.wave, NGW = F.G * NWAVES; const int lane = F.lane;
    for (int t = gw; t < M; t += NGW) {
        float x[16], acc[16];
        { const GAS v4u* xp = (const GAS v4u*)(X1 + (size_t)t * D); unpack8(xp[lane], x); unpack8(xp[64 + lane], x + 8); }
#pragma unroll
        for (int k = 0; k < 16; ++k) acc[k] = 0.f;
#pragma unroll 2
        for (int e = 0; e < NSEL; ++e) {
            const int idx = IDX[(size_t)t * NSEL + e]; const float gt = GATE[(size_t)t * NSEL + e];
            const GAS v4u* up = (const GAS v4u*)(PU + (size_t)idx * D); const GAS v4u* vp = (const GAS v4u*)(PV + (size_t)idx * D);
            const v4u u0 = up[lane], u1 = up[64 + lane], v0 = vp[lane], v1 = vp[64 + lane];
            float uf[16]; unpack8(u0, uf); unpack8(u1, uf + 8);
            float s = 0.f;
#pragma unroll
            for (int k = 0; k < 16; ++k) s = fmaf(x[k], uf[k], s);
            s = wave_sum(s);
            const float w = gt * 0.5f * s * (1.f + erff(s * 0.7071067811865476f));
            float vf[16]; unpack8(v0, vf); unpack8(v1, vf + 8);
#pragma unroll
            for (int k = 0; k < 16; ++k) acc[k] = fmaf(w, vf[k], acc[k]);
        }
        float sm = 0.f;
#pragma unroll
        for (int k = 0; k < 16; ++k) { acc[k] = fmaf(ALPHA, x[k], acc[k]); sm += acc[k]; }
        const float mean = wave_sum(sm) * (1.f / D); float q2 = 0.f;
#pragma unroll
        for (int k = 0; k < 16; ++k) { acc[k] -= mean; q2 += acc[k] * acc[k]; }
        const float rstd = 1.f / sqrtf(wave_sum(q2) * (1.f / D) + LN_EPS);
        GAS f32x4* op = (GAS f32x4*)(F.out + (size_t)t * D);
#pragma unroll
        for (int hf = 0; hf < 2; ++hf)
#pragma unroll
            for (int q4 = 0; q4 < 2; ++q4) { const int c0 = hf * 512 + lane * 8 + q4 * 4; const f32x4 gg = *(const GAS f32x4*)(g2 + c0), bv = *(const GAS f32x4*)(b2 + c0);
                f32x4 r; r.x = acc[hf * 8 + q4 * 4 + 0] * rstd * gg.x + bv.x; r.y = acc[hf * 8 + q4 * 4 + 1] * rstd * gg.y + bv.y; r.z = acc[hf * 8 + q4 * 4 + 2] * rstd * gg.z + bv.z; r.w = acc[hf * 8 + q4 * 4 + 3] * rstd * gg.w + bv.w;
                op[c0 / 4] = r; }
    }
}


typedef float f32x16_t __attribute__((ext_vector_type(16)));
__device__ __forceinline__ int enc_key(float f) { const int u = __builtin_bit_cast(int, f); return u ^ ((u >> 31) & 0x7fffffff); }
__device__ __forceinline__ float dec_key(int k) { return __builtin_bit_cast(float, k ^ ((k >> 31) & 0x7fffffff)); }
__device__ __forceinline__ int pair_max(int m) { const auto rr = __builtin_amdgcn_permlane32_swap((unsigned)m, (unsigned)m, false, false); const int a = (int)rr[0], b = (int)rr[1]; return a > b ? a : b; }
__device__ __forceinline__ void p5_topk_fast(Frame& F) {
    constexpr int PI[50] = {0, 0, 0, 0, 0, 0, 0, 0, 0, 0, 0, 0, 0, 0, 0, 0, 1, 1, 1, 1, 1, 1, 1, 1, 2, 2, 2, 2, 2, 3, 3, 3, 3, 4, 4, 4, 5, 5, 6, 6, 7, 7, 8, 9, 10, 11, 12, 13, 14, 15};
    constexpr int PJ[50] = {0, 1, 2, 3, 4, 5, 6, 7, 8, 9, 10, 11, 12, 13, 14, 15, 0, 1, 2, 3, 4, 5, 6, 7, 0, 1, 2, 3, 4, 0, 1, 2, 3, 0, 1, 2, 0, 1, 0, 1, 0, 1, 0, 0, 0, 0, 0, 0, 0, 0};
    const bf16* QP = (const bf16*)(F.ws + WS_QP); const bf16* SK = (const bf16*)(F.ws + WS_SK);
    int* IDX = (int*)(F.ws + WS_IDX); float* GATE = (float*)(F.ws + WS_GATE);
    LAS unsigned char* skl = F.lds + RING_OFF;
    const int h = F.vcu & 7;
    for (int n = F.tid; n < 4096; n += NWAVES * 64) { const unsigned row = (unsigned)n >> 4, ch = (unsigned)n & 15u;
        const v4u v = *(const GAS v4u*)(SK + ((size_t)h * 256 + row) * 128 + ch * 8); *(LAS v4u*)(skl + offb(row, ch)) = v; }
    __syncthreads();
    LAS int* TOP = (LAS int*)(F.lds + RING_OFF + 65536 + F.wave * 4096);
    LAS unsigned short* EIDX = (LAS unsigned short*)TOP;
    LAS int* WIN = (LAS int*)(F.lds + RING_OFF + 98304 + F.wave * 2048);
    const int lane = F.lane, tok = lane & 31, hi = lane >> 5;
    const int IMIN = (int)0x80000000;
#pragma unroll 1
    for (int tile = F.vcu >> 3; tile < M / 256; tile += F.G >> 3) {
        const size_t token = (size_t)tile * 256 + F.wave * 32 + tok;
#pragma unroll 1
        for (int c = 0; c < 2; ++c) {
            f32x16_t acc[4];
#pragma unroll
            for (int kb = 0; kb < 4; ++kb) acc[kb] = f32x16_t{};
            const bf16* qrow = QP + token * NQ + h * 256 + c * 128 + 8 * hi;
#pragma unroll
            for (int sst = 0; sst < 8; ++sst) { const bf16x8 bq = *(const GAS bf16x8*)(qrow + 16 * sst);
#pragma unroll
                for (int kb = 0; kb < 4; ++kb) { const bf16x8 a = *(const LAS bf16x8*)(skl + offb((unsigned)(c * 128 + 32 * kb + tok), (unsigned)(2 * sst + hi)));
                    acc[kb] = __builtin_amdgcn_mfma_f32_32x32x16_bf16(a, bq, acc[kb], 0, 0, 0); } }
            int k[64];
#pragma unroll
            for (int kb = 0; kb < 4; ++kb)
#pragma unroll
                for (int r = 0; r < 16; ++r) { const int kidx = 32 * kb + (r & 3) + 8 * (r >> 2) + 4 * hi; k[kb * 16 + r] = (enc_key(acc[kb][r]) & ~127) | (127 - kidx); }
            int prev = 0x7fffffff;
#pragma unroll 1
            for (int r = 0; r < 16; ++r) {
                int m = IMIN;
#pragma unroll
                for (int i = 0; i < 64; ++i) { const int t = k[i] < prev ? k[i] : IMIN; m = t > m ? t : m; }
                m = pair_max(m);
                TOP[(c * 16 + r) * 32 + tok] = m;
                prev = m;
            }
        }
        LDS_WAIT(); asm volatile("" ::: "memory");
        int a[16], b[16]; float af[16], bf_[16];
#pragma unroll
        for (int i = 0; i < 16; ++i) { a[i] = TOP[i * 32 + tok]; b[i] = TOP[(16 + i) * 32 + tok]; }
        LDS_WAIT(); asm volatile("" ::: "memory");
#pragma unroll
        for (int i = 0; i < 16; ++i) { af[i] = dec_key(a[i] & ~127); bf_[i] = dec_key(b[i] & ~127); a[i] = 127 - (a[i] & 127); b[i] = 127 - (b[i] & 127); }
        int ck[25];
#pragma unroll
        for (int n = 0; n < 25; ++n) { const int i0 = PI[2 * n], j0 = PJ[2 * n], i1 = PI[2 * n + 1], j1 = PJ[2 * n + 1];
            const float s0 = af[i0] + bf_[j0], s1 = af[i1] + bf_[j1]; const int e0 = a[i0] * 128 + b[j0], e1 = a[i1] * 128 + b[j1];
            const float sv = hi ? s1 : s0; const int ev = hi ? e1 : e0; const int id = 2 * n + hi;
            ck[n] = (enc_key(sv) & ~63) | (63 - id); EIDX[tok * 64 + id] = (unsigned short)ev; }
        int prev = 0x7fffffff;
#pragma unroll 1
        for (int r = 0; r < 16; ++r) {
            int m = IMIN;
#pragma unroll
            for (int i = 0; i < 25; ++i) { const int t = ck[i] < prev ? ck[i] : IMIN; m = t > m ? t : m; }
            m = pair_max(m);
            WIN[r * 32 + tok] = m;
            prev = m;
        }
        LDS_WAIT(); asm volatile("" ::: "memory");
        int w[16]; float e[16];
#pragma unroll
        for (int r = 0; r < 16; ++r) w[r] = WIN[r * 32 + tok];
        LDS_WAIT(); asm volatile("" ::: "memory");
        const float mx = dec_key(w[0] & ~63); float sm = 0.f;
#pragma unroll
        for (int r = 0; r < 16; ++r) { e[r] = __builtin_amdgcn_exp2f((dec_key(w[r] & ~63) - mx) * 1.4426950408889634f); sm += e[r]; }
        const float inv = 1.f / sm;
        int oi[8]; float og[8];
#pragma unroll
        for (int q = 0; q < 8; ++q) { const int wq = hi ? w[8 + q] : w[q]; const float eq = hi ? e[8 + q] : e[q]; oi[q] = (int)EIDX[tok * 64 + (63 - (wq & 63))]; og[q] = eq * inv; }
        LDS_WAIT(); asm volatile("" ::: "memory");
        int* ip = IDX + token * NSEL + h * 16 + 8 * hi; float* gp = GATE + token * NSEL + h * 16 + 8 * hi;
        typedef int i32x4 __attribute__((ext_vector_type(4)));
        *(GAS i32x4*)ip = (i32x4){oi[0], oi[1], oi[2], oi[3]}; *(GAS i32x4*)(ip + 4) = (i32x4){oi[4], oi[5], oi[6], oi[7]};
        *(GAS f32x4*)gp = (f32x4){og[0], og[1], og[2], og[3]}; *(GAS f32x4*)(gp + 4) = (f32x4){og[4], og[5], og[6], og[7]};
    }
    __syncthreads();
}
typedef __bf16 bf16x2_t __attribute__((ext_vector_type(2)));
__device__ __forceinline__ float dot2bf(unsigned a, unsigned b, float c) { return __builtin_amdgcn_fdot2_f32_bf16(__builtin_bit_cast(bf16x2_t, a), __builtin_bit_cast(bf16x2_t, b), c, false); }
__device__ __forceinline__ float dot8p(v4u a, v4u b, float s) { s = dot2bf(a.x, b.x, s); s = dot2bf(a.y, b.y, s); s = dot2bf(a.z, b.z, s); return dot2bf(a.w, b.w, s); }
__device__ __forceinline__ float gelu_erf(float v) {
    const float av = fabsf(v), t = __builtin_amdgcn_rcpf(fmaf(av, 0.2316418882f, 1.0f));
    float q = fmaf(t, 0.5307027145f, -0.7265760135f); q = fmaf(q, t, 0.7107068705f); q = fmaf(q, t, -0.142248368f); q = fmaf(q, t, 0.127414796f); q = q * t;
    const float e = __builtin_amdgcn_exp2f(v * v * -0.72134752044f);
    const float m = v * (q * e);
    return v < 0.f ? m : v - m;
}
#define ACC8(A, W, S, O) do { A[O + 0] = fmaf(S, bflo(W.x), A[O + 0]); A[O + 1] = fmaf(S, bfhi(W.x), A[O + 1]); A[O + 2] = fmaf(S, bflo(W.y), A[O + 2]); A[O + 3] = fmaf(S, bfhi(W.y), A[O + 3]); \
                               A[O + 4] = fmaf(S, bflo(W.z), A[O + 4]); A[O + 5] = fmaf(S, bfhi(W.z), A[O + 5]); A[O + 6] = fmaf(S, bflo(W.w), A[O + 6]); A[O + 7] = fmaf(S, bfhi(W.w), A[O + 7]); } while (0)
__device__ __forceinline__ void p6_experts(Frame& F) {
    const bf16* X1 = (const bf16*)(F.ws + WS_X1); const bf16* PU = (const bf16*)(F.ws + WS_PU); const bf16* PV = (const bf16*)(F.ws + WS_PV);
    const int* IDX = (const int*)(F.ws + WS_IDX); const float* GATE = (const float*)(F.ws + WS_GATE);
    const float* g2 = F.in[16]; const float* b2 = F.in[17];
    const int gw = (int)blockIdx.x * NWAVES + F.wave, NGW = F.G * NWAVES;
    const int e_of_lane = (F.lane >> 3) & 7; const bool h5 = F.lane >= 32, h4 = (F.lane >> 4) & 1, h3 = (F.lane >> 3) & 1;
#pragma unroll 1
    for (int t = gw; t < M; t += NGW) {
        int lane = F.lane; asm volatile("" : "+v"(lane));
        const GAS v4u* xp = (const GAS v4u*)(X1 + (size_t)t * D); const v4u xa = xp[lane], xb = xp[64 + lane];
        const int ilo = IDX[(size_t)t * NSEL + lane], ihi = IDX[(size_t)t * NSEL + 64 + lane];
        const float glo = GATE[(size_t)t * NSEL + lane], ghi = GATE[(size_t)t * NSEL + 64 + lane];
        float acc[16];
#pragma unroll
        for (int k = 0; k < 16; ++k) acc[k] = 0.f;
        v4u ua[8], ub[8], va[8], vb[8];
#pragma unroll
        for (int k = 0; k < 8; ++k) { const int idx = __builtin_amdgcn_readlane(ilo, k); const GAS v4u* up = (const GAS v4u*)(PU + (size_t)idx * D); ua[k] = up[lane]; ub[k] = up[64 + lane];
            const GAS v4u* vp = (const GAS v4u*)(PV + (size_t)idx * D); va[k] = vp[lane]; vb[k] = vp[64 + lane]; }
#pragma unroll 1
        for (int bb = 0; bb < 16; ++bb) {
            float s[8];
#pragma unroll
            for (int k = 0; k < 8; ++k) { s[k] = dot8p(xb, ub[k], dot8p(xa, ua[k], 0.f)); __builtin_amdgcn_sched_barrier(0); }
            const int nb = bb + 1; const int isrc_n = nb < 8 ? ilo : ihi;
            if (nb < 16) {
#pragma unroll
                for (int k = 0; k < 8; ++k) { const int idx = __builtin_amdgcn_readlane(isrc_n, (nb & 7) * 8 + k); const GAS v4u* up = (const GAS v4u*)(PU + (size_t)idx * D); ua[k] = up[lane]; ub[k] = up[64 + lane]; }
            }
            float r4[4], r2[2], z;
#pragma unroll
            for (int i = 0; i < 4; ++i) { const float send = h5 ? s[i] : s[i + 4], keep = h5 ? s[i + 4] : s[i]; r4[i] = keep + __shfl_xor(send, 32); }
#pragma unroll
            for (int i = 0; i < 2; ++i) { const float send = h4 ? r4[i] : r4[i + 2], keep = h4 ? r4[i + 2] : r4[i]; r2[i] = keep + __shfl_xor(send, 16); }
            { const float send = h3 ? r2[0] : r2[1], keep = h3 ? r2[1] : r2[0]; z = keep + __shfl_xor(send, 8); }
            z += __shfl_xor(z, 4); z += __shfl_xor(z, 2); z += __shfl_xor(z, 1);
            const float gsrc = bb < 8 ? glo : ghi;
            const float w = __shfl(gsrc, (bb & 7) * 8 + e_of_lane) * gelu_erf(z);
#pragma unroll
            for (int k = 0; k < 8; ++k) { const float wk = __builtin_bit_cast(float, __builtin_amdgcn_readlane(__builtin_bit_cast(int, w), 8 * k)); ACC8(acc, va[k], wk, 0); ACC8(acc, vb[k], wk, 8); __builtin_amdgcn_sched_barrier(0); }
            if (nb < 16) {
#pragma unroll
                for (int k = 0; k < 8; ++k) { const int idx = __builtin_amdgcn_readlane(isrc_n, (nb & 7) * 8 + k); const GAS v4u* vp = (const GAS v4u*)(PV + (size_t)idx * D); va[k] = vp[lane]; vb[k] = vp[64 + lane]; }
            }
        }
        float x[16]; unpack8(xa, x); unpack8(xb, x + 8);
        float sm = 0.f;
#pragma unroll
        for (int k = 0; k < 16; ++k) { acc[k] = fmaf(ALPHA, x[k], acc[k]); sm += acc[k]; }
        const float mean = wave_sum(sm) * (1.f / D); float q2 = 0.f;
#pragma unroll
        for (int k = 0; k < 16; ++k) { acc[k] -= mean; q2 += acc[k] * acc[k]; }
        const float rstd = 1.f / sqrtf(wave_sum(q2) * (1.f / D) + LN_EPS);
        GAS f32x4* op = (GAS f32x4*)(F.out + (size_t)t * D);
#pragma unroll
        for (int hf = 0; hf < 2; ++hf)
#pragma unroll
            for (int q4 = 0; q4 < 2; ++q4) { const int c0 = hf * 512 + lane * 8 + q4 * 4; const f32x4 gg = *(const GAS f32x4*)(g2 + c0), bv = *(const GAS f32x4*)(b2 + c0);
                f32x4 r; r.x = acc[hf * 8 + q4 * 4 + 0] * rstd * gg.x + bv.x; r.y = acc[hf * 8 + q4 * 4 + 1] * rstd * gg.y + bv.y; r.z = acc[hf * 8 + q4 * 4 + 2] * rstd * gg.z + bv.z; r.w = acc[hf * 8 + q4 * 4 + 3] * rstd * gg.w + bv.w;
                op[c0 / 4] = r; }
    }
}
struct Args { const float* in[18]; float* out; unsigned char* ws; };
__global__ void __launch_bounds__(NWAVES * 64, 2) hymba_fwd(Args args) {
    extern __shared__ __attribute__((aligned(16))) unsigned char lds[];
    Frame F;
    F.lds = (LAS unsigned char*)lds;
    F.MISC = (volatile LAS unsigned*)(F.lds + MISC_OFF);
    F.tid = threadIdx.x; F.lane = F.tid & 63; F.wave = __builtin_amdgcn_readfirstlane(F.tid >> 6);
    F.G = gridDim.x; { const int bx = blockIdx.x; F.vcu = (F.G % 8 == 0) ? (bx % 8) * (F.G / 8) + bx / 8 : bx; }
    unsigned char* ws = args.ws; F.ws = ws; F.out = args.out;
    F.ctl = (gu32*)(ws + WS_CTL);
    F.in = args.in;
    for (int u = F.tid; u < (LDS_BYTES - LDSCTL_OFF) / 4; u += NWAVES * 64) ((LAS unsigned*)(F.lds + LDSCTL_OFF))[u] = 0u;
    __syncthreads();
    (void)xcd_barrier_post((unsigned*)F.ws + CW_BAR, F.MISC + 8);
#ifndef PHASE_MASK
#define PHASE_MASK 0xffff
#endif
#define IN(k) ((PHASE_MASK >> (k)) & 1)
#define BOTH(k) (IN(k) && IN((k) + 1))
#define GRID_BAR() do { XcdBarrier b_; b_.bar = (unsigned*)F.ws + CW_BAR; b_.x = xb_xcc_id(); b_.st = F.MISC + 8; xcd_barrier(b_); PHASE_FENCE(); } while (0)
#define PHASE_FENCE() do { asm volatile("" : "+v"(F.tid)); F.lane = F.tid & 63; } while (0)

    if (IN(0)) { p0_prologue(F); if (BOTH(0)) GRID_BAR(); }
    if (IN(1)) {
        pg8::Gemm g{(const bf16*)(ws + WS_XB), (const bf16*)(ws + WS_WIN), M, NPROJ, D}; pg8::StaticOrder S; S.init(M, NPROJ, F.G, (int)blockIdx.x);
        pg8::EpiProj E{(bf16*)(ws + WS_PROJ), NPROJ, (const float*)(ws + WS_ROPE), KSCALE, QSCALE};
        pg8::gemm_phase<pg8::EpiProj, pg8::StaticOrder, PG8_ALIGN, PG8_SP2>(F.lds + RING_OFF, g, S, E);
        if (BOTH(1)) GRID_BAR();
    }
    if (IN(2)) { p2_retention_scan(F); __syncthreads(); p2_diffattn(F, (char*)lds + RING_OFF); if (BOTH(2)) GRID_BAR(); }
    if (IN(3)) {
        p3_retention_out(F); GRID_BAR();
        pg8::Gemm g{(const bf16*)(ws + WS_MIX), (const bf16*)(ws + WS_WOUT), M, D, D}; pg8::StaticOrder S; S.init(M, D, F.G, (int)blockIdx.x);
        pg8::EpiResF32 E{F.in[0], F.out, D, ALPHA};
        pg8::gemm_phase<pg8::EpiResF32, pg8::StaticOrder, PG8_ALIGN, PG8_SP2>(F.lds + RING_OFF, g, S, E);
        if (BOTH(3)) GRID_BAR();
    }
    if (IN(4)) { p3_ln1_rows(F); if (BOTH(4)) GRID_BAR(); }
    if (IN(5)) {
        pg8::Gemm g{(const bf16*)(ws + WS_X1), (const bf16*)(ws + WS_WQ), M, NQ, D}; pg8::StaticOrder S; S.init(M, NQ, F.G, (int)blockIdx.x);
        pg8::EpiPlainBf16 E{(bf16*)(ws + WS_QP), NQ};
        pg8::gemm_phase<pg8::EpiPlainBf16, pg8::StaticOrder, PG8_ALIGN, PG8_SP2>(F.lds + RING_OFF, g, S, E);
        if (BOTH(5)) GRID_BAR();
    }
    if (IN(6)) { p5_topk_fast(F); if (BOTH(6)) GRID_BAR(); }
    if (IN(7)) { p6_experts(F); }
#undef IN
#undef BOTH
}

extern "C" void kernel_launch(void* const* d_in, const int* in_sizes, int n_in, void* d_out, int out_size, void* d_ws, size_t ws_size, hipStream_t stream) {
    static int grid = 0;
    if (grid == 0) {
        if (n_in != 18 || in_sizes[0] != M * D || out_size != M * D || ws_size < WS_END) { fprintf(stderr, "kernel_launch: unexpected shapes / workspace (n_in %d, in0 %d, out %d, ws %zu, need %zu); nothing launched\n", n_in, n_in > 0 ? in_sizes[0] : -1, out_size, ws_size, (size_t)WS_END); grid = -1; return; }
        int dev = 0, cus = 0, per_cu = 0;
        if (hipGetDevice(&dev) != hipSuccess || hipDeviceGetAttribute(&cus, hipDeviceAttributeMultiprocessorCount, dev) != hipSuccess) { fprintf(stderr, "kernel_launch: device query failed\n"); grid = -1; return; }
        if (hipFuncSetAttribute((const void*)hymba_fwd, hipFuncAttributeMaxDynamicSharedMemorySize, LDS_BYTES) != hipSuccess) { fprintf(stderr, "kernel_launch: hipFuncSetAttribute failed\n"); grid = -1; return; }
        if (hipOccupancyMaxActiveBlocksPerMultiprocessor(&per_cu, (const void*)hymba_fwd, NWAVES * 64, LDS_BYTES) != hipSuccess || per_cu < 1)
            fprintf(stderr, "kernel_launch: note: occupancy query reports %d workgroups per CU\n", per_cu);
        (void)hipGetLastError();
        grid = cus;
        if (grid != 256) fprintf(stderr, "kernel_launch: note: %d CUs (tuned for 256)\n", grid);
    }
    if (grid < 0) return;
    if (hipMemsetAsync((char*)d_ws + WS_CTL, 0, CTL_ZERO_BYTES, stream) != hipSuccess) { fprintf(stderr, "kernel_launch: memset failed\n"); return; }
    Args a{};
    for (int i = 0; i < 18; ++i) a.in[i] = (const float*)d_in[i];
    a.out = (float*)d_out; a.ws = (unsigned char*)d_ws;
    hipLaunchKernelGGL(hymba_fwd, dim3(grid), dim3(NWAVES * 64), LDS_BYTES, stream, a);
    const hipError_t le = hipPeekAtLastError();
    if (le != hipSuccess) fprintf(stderr, "kernel_launch: launch failed: %s\n", hipGetErrorName(le));
}
```

```cpp
#include <hip/hip_runtime.h>
#include <cstdio>
#include <cstdint>
#include <cmath>
namespace pg8 {
#define PG8_LAS __attribute__((address_space(3)))
typedef unsigned short bf16_t;
typedef short bf16x8 __attribute__((ext_vector_type(8)));
typedef float f32x4 __attribute__((ext_vector_type(4)));
typedef unsigned u32x4 __attribute__((ext_vector_type(4)));
constexpr int BM = 256, BK = 64, HALF = 128, HTB = HALF * BK * 2  , STAGE_BYTES = 8 * HTB, NXCD = 8, WGM = 8;

__host__ __device__ __forceinline__ int lds_byte(int r, int c) { const int st = (r >> 4) * 2 + (c >> 5), rr = r & 15, cc = c & 31, ob = rr * 64 + cc * 2; return st * 1024 + (ob ^ (((ob >> 9) & 1) << 5)); }
__host__ __device__ __forceinline__ void stage_rc(int b, int& R, int& C) { const int st = b / 1024, sb = b % 1024, swz = sb ^ (((sb >> 9) & 1) << 5); R = (st >> 1) * 16 + swz / 64; C = (st & 1) * 32 + (swz % 64) / 2; }
__host__ __device__ __forceinline__ int perm32(int rho) { const int n = rho >> 4, i = rho & 15; return 8 * (i >> 2) + 4 * n + (i & 3); }

struct Unit { int pm, pn; };
struct Gemm { const bf16_t* A; const bf16_t* Bt; int M, N, K; };

struct StaticOrder {
    int nM, nN, nwg, G, c;
    __host__ __device__ void init(int M, int N, int G_, int c_) { nM = M / BM; nN = N / BM; nwg = nM * nN; G = G_; c = c_; }
    __host__ __device__ bool next(int i, Unit& u) const {
        const long L = (long)i * G + c; if (L >= nwg) return false;
        int wgid = (int)L; { const int q = nwg / NXCD, r = nwg % NXCD, xcd = wgid % NXCD, off = wgid / NXCD; wgid = (xcd < r ? xcd * (q + 1) : r * (q + 1) + (xcd - r) * q) + off; }
        const int nig = WGM * nN, gid = wgid / nig, fm = gid * WGM, gsz = (nM - fm) < WGM ? (nM - fm) : WGM;
        u.pm = fm + ((wgid % nig) % gsz); u.pn = (wgid % nig) / gsz; return true;
    }
    __device__ __forceinline__ void a_ready(const Unit&) const {}
    __device__ __forceinline__ void done(const Unit&) const {}
};

__device__ __forceinline__ unsigned cvt_pk_bf16(float lo, float hi) { unsigned r; asm volatile("v_cvt_pk_bf16_f32 %0, %1, %2" : "=v"(r) : "v"(lo), "v"(hi)); return r; }
typedef float f32x2 __attribute__((ext_vector_type(2)));
__device__ __forceinline__ f32x2 gelu_pk(f32x2 v) {
    const f32x2 av = __builtin_elementwise_abs(v), d = av * 0.2316418882f + 1.0f;
    f32x2 t; t.x = __builtin_amdgcn_rcpf(d.x); t.y = __builtin_amdgcn_rcpf(d.y);
    f32x2 q = t * 0.5307027145f + (-0.7265760135f); q = q * t + 0.7107068705f; q = q * t + (-0.142248368f); q = q * t + 0.127414796f; q = q * t;
    const f32x2 s = (v * v) * (-0.72134752044f);
    f32x2 e; e.x = __builtin_amdgcn_exp2f(s.x); e.y = __builtin_amdgcn_exp2f(s.y);
    const f32x2 m = v * (q * e), r = v - m;
    f32x2 o; o.x = v.x < 0.f ? m.x : r.x; o.y = v.y < 0.f ? m.y : r.y; return o;
}

struct EpiProj {
    static constexpr bool PERM = true, AFTER_DRAIN = false;
    bf16_t* O; int ldc; const float* rope; float kscale, qscale;
    __device__ __forceinline__ void operator()(const f32x4 (&acc)[2][2][4][2], const Unit& u, int wr, int wc, int fr, int fq) const {
        const int row0 = u.pm * BM + wr * 64 + fr; const int col0 = u.pn * BM + wc * 32 + 8 * fq;
        const int pn = u.pn;
        const bool rot = pn < 4; const bool gate = (pn == 6 || pn == 7);
        const float sc = (pn == 2 || pn == 3) ? kscale : ((pn == 8 || pn == 9) ? qscale : 1.f);
#pragma unroll
        for (int ai = 0; ai < 2; ++ai)
#pragma unroll
            for (int m = 0; m < 4; ++m) {
                const int row = row0 + ai * HALF + m * 16;
                bf16_t* rowp = O + (size_t)row * ldc + col0;
                f32x4 cs0 = (f32x4){1.f, 0.f, 1.f, 0.f}, cs1 = cs0;
                if (rot) { const float* rp = rope + ((size_t)(row & 2047) * 64 + 16 * wc + 4 * fq) * 2; cs0 = *(const f32x4*)rp; cs1 = *(const f32x4*)(rp + 4); }
#pragma unroll
                for (int bj = 0; bj < 2; ++bj) {
                    f32x4 v0 = acc[ai][bj][m][0], v1 = acc[ai][bj][m][1];
                    if (rot) {
                        f32x4 r0, r1;
                        r0[0] = v0[0] * cs0[0] - v0[1] * cs0[1]; r0[1] = v0[0] * cs0[1] + v0[1] * cs0[0];
                        r0[2] = v0[2] * cs0[2] - v0[3] * cs0[3]; r0[3] = v0[2] * cs0[3] + v0[3] * cs0[2];
                        r1[0] = v1[0] * cs1[0] - v1[1] * cs1[1]; r1[1] = v1[0] * cs1[1] + v1[1] * cs1[0];
                        r1[2] = v1[2] * cs1[2] - v1[3] * cs1[3]; r1[3] = v1[2] * cs1[3] + v1[3] * cs1[2];
                        v0 = r0; v1 = r1;
                    }
                    if (gate) {
#pragma unroll
                        for (int j = 0; j < 4; ++j) { v0[j] = v0[j] * __builtin_amdgcn_rcpf(1.f + __builtin_amdgcn_exp2f(-1.4426950408889634f * v0[j])); v1[j] = v1[j] * __builtin_amdgcn_rcpf(1.f + __builtin_amdgcn_exp2f(-1.4426950408889634f * v1[j])); }
                    }
                    v0 = v0 * sc; v1 = v1 * sc;
                    u32x4 w; w.x = cvt_pk_bf16(v0[0], v0[1]); w.y = cvt_pk_bf16(v0[2], v0[3]); w.z = cvt_pk_bf16(v1[0], v1[1]); w.w = cvt_pk_bf16(v1[2], v1[3]);
                    *(u32x4*)(rowp + bj * HALF) = w;
                }
            }
    }
};
struct EpiPlainBf16 {
    static constexpr bool PERM = true, AFTER_DRAIN = false;
    bf16_t* O; int ldc;
    __device__ __forceinline__ void operator()(const f32x4 (&acc)[2][2][4][2], const Unit& u, int wr, int wc, int fr, int fq) const {
        const int row0 = u.pm * BM + wr * 64 + fr; const int col0 = u.pn * BM + wc * 32 + 8 * fq;
#pragma unroll
        for (int ai = 0; ai < 2; ++ai)
#pragma unroll
            for (int m = 0; m < 4; ++m) { bf16_t* rowp = O + (size_t)(row0 + ai * HALF + m * 16) * ldc + col0;
#pragma unroll
                for (int bj = 0; bj < 2; ++bj) { const f32x4 v0 = acc[ai][bj][m][0], v1 = acc[ai][bj][m][1];
                    u32x4 w; w.x = cvt_pk_bf16(v0[0], v0[1]); w.y = cvt_pk_bf16(v0[2], v0[3]); w.z = cvt_pk_bf16(v1[0], v1[1]); w.w = cvt_pk_bf16(v1[2], v1[3]);
                    *(u32x4*)(rowp + bj * HALF) = w; } }
    }
};
struct EpiResF32 {
    static constexpr bool PERM = false, AFTER_DRAIN = false;
    const float* base; float* out; int ldc; float alpha;
    __device__ __forceinline__ void operator()(const f32x4 (&acc)[2][2][4][2], const Unit& u, int wr, int wc, int fr, int fq) const {
        const int row0 = u.pm * BM + wr * 64 + fr; const int col0 = u.pn * BM + wc * 32 + 4 * fq;
#pragma unroll
        for (int ai = 0; ai < 2; ++ai)
#pragma unroll
            for (int m = 0; m < 4; ++m) { const size_t off = (size_t)(row0 + ai * HALF + m * 16) * ldc + col0;
#pragma unroll
                for (int bj = 0; bj < 2; ++bj)
#pragma unroll
                    for (int n = 0; n < 2; ++n) { const f32x4 bs = *(const f32x4*)(base + off + bj * HALF + n * 16); *(f32x4*)(out + off + bj * HALF + n * 16) = bs * alpha + acc[ai][bj][m][n]; } }
    }
};

template <class Epi, class Sched, bool ALIGN_EPI = false, bool SP2 = false>
__device__ __forceinline__ void gemm_phase(PG8_LAS unsigned char* lds, const Gemm g, const Sched& S, const Epi& E) {
    int tid_ = threadIdx.x; asm volatile("" : "+v"(tid_));
    const int tid = tid_, wid = __builtin_amdgcn_readfirstlane(tid >> 6), lane = tid & 63, wr = wid >> 2, wc = wid & 3, fr = lane & 15, fq = lane >> 4;
    const int K = g.K, nt = K / BK;
    unsigned voffA[2], voffB[2];
#pragma unroll
    for (int i = 0; i < 2; ++i) { int R, C; stage_rc(tid * 16 + i * 8192, R, C); const int Rb = Epi::PERM ? ((R & ~31) + perm32(R & 31)) : R;
        voffA[i] = (unsigned)(R * K + C) * 2u; voffB[i] = (unsigned)(Rb * K + C) * 2u; }
    const size_t kstep = (size_t)(BK * 2);
    const size_t hstep = (size_t)HALF * K * 2;
    const size_t tstep = 2 * hstep;
    const unsigned ldsw = (unsigned)wid * 1024u;
    const int aoff = lds_byte(wr * 64 + fr, fq * 8), boff = lds_byte(wc * 32 + fr, fq * 8);
#define PG8_SA(b, h) (((b) * 2 + (h)) * HTB)
#define PG8_SB(b, h) ((4 + (b) * 2 + (h)) * HTB)
#define PG8_STAGE(bufoff, gbase, voff) do { _Pragma("unroll") for (int _i = 0; _i < 2; ++_i) \
        __builtin_amdgcn_global_load_lds((const unsigned*)((const char*)(gbase) + (voff)[_i]), (PG8_LAS unsigned*)(lds + (bufoff) + ldsw + _i * 8192), 16, 0, 0); } while (0)
#define PG8_LDA(dst, b, h) do { _Pragma("unroll") for (int m = 0; m < 4; ++m) _Pragma("unroll") for (int k = 0; k < 2; ++k) dst[m][k] = *(const PG8_LAS bf16x8*)(lds + PG8_SA(b, h) + aoff + m * 2048 + k * 1024); } while (0)
#define PG8_LDB(dst, b, h) do { _Pragma("unroll") for (int n = 0; n < 2; ++n) _Pragma("unroll") for (int k = 0; k < 2; ++k) dst[n][k] = *(const PG8_LAS bf16x8*)(lds + PG8_SB(b, h) + boff + n * 2048 + k * 1024); } while (0)
#define PG8_MMA(ai, bj, At, Bt) do { __builtin_amdgcn_s_setprio(1); _Pragma("unroll") for (int m = 0; m < 4; ++m) _Pragma("unroll") for (int n = 0; n < 2; ++n) _Pragma("unroll") for (int k = 0; k < 2; ++k) \
        acc[ai][bj][m][n] = __builtin_amdgcn_mfma_f32_16x16x32_bf16(Bt[n][k], At[m][k], acc[ai][bj][m][n], 0, 0, 0); __builtin_amdgcn_s_setprio(0); } while (0)
#define PG8_WAIT_V(n) asm volatile("s_waitcnt vmcnt(" #n ")" ::: "memory")
#define PG8_WAIT_L(n) asm volatile("s_waitcnt lgkmcnt(" #n ")" ::: "memory")
#define PG8_BAR __builtin_amdgcn_s_barrier()
#define PG8_SCHED __builtin_amdgcn_sched_barrier(0)
    Unit cur, nxt; int ui = 0;
    if (!S.next(0, cur)) return;
    f32x4 acc[2][2][4][2];
#pragma unroll
    for (int a = 0; a < 2; ++a)
#pragma unroll
        for (int b = 0; b < 2; ++b)
#pragma unroll
            for (int m = 0; m < 4; ++m)
#pragma unroll
                for (int n = 0; n < 2; ++n) acc[a][b][m][n] = (f32x4){0.f, 0.f, 0.f, 0.f};
    bf16x8 At[4][2], B0[2][2], B1[2][2];
    const char* cA = (const char*)g.A + (size_t)cur.pm * tstep; const char* cB = (const char*)g.Bt + (size_t)cur.pn * tstep;
    S.a_ready(cur);
    if constexpr (SP2) {
        PG8_STAGE(PG8_SB(0, 0), cB, voffB); PG8_STAGE(PG8_SB(0, 1), cB + hstep, voffB); PG8_STAGE(PG8_SA(0, 0), cA, voffA); PG8_STAGE(PG8_SA(0, 1), cA + hstep, voffA);
        if (wr == 1) PG8_BAR;
        PG8_WAIT_V(2); PG8_BAR;
        PG8_STAGE(PG8_SB(1, 0), cB + kstep, voffB); PG8_STAGE(PG8_SA(1, 0), cA + kstep, voffA); PG8_STAGE(PG8_SB(1, 1), cB + hstep + kstep, voffB);
        PG8_WAIT_V(6); PG8_BAR;
    } else {
        PG8_STAGE(PG8_SB(0, 0), cB, voffB); PG8_STAGE(PG8_SA(0, 0), cA, voffA); PG8_STAGE(PG8_SB(0, 1), cB + hstep, voffB); PG8_STAGE(PG8_SA(0, 1), cA + hstep, voffA);
        if (wr == 1) PG8_BAR;
        PG8_WAIT_V(4); PG8_BAR;
        PG8_STAGE(PG8_SB(1, 0), cB + kstep, voffB); PG8_STAGE(PG8_SA(1, 0), cA + kstep, voffA); PG8_STAGE(PG8_SB(1, 1), cB + hstep + kstep, voffB);
        PG8_WAIT_V(6); PG8_BAR;
    }
    for (;;) {
        const bool has_next = S.next(ui + 1, nxt);
        const char* nA = has_next ? (const char*)g.A + (size_t)nxt.pm * tstep : cA; const char* nB = has_next ? (const char*)g.Bt + (size_t)nxt.pn * tstep : cB;
        for (int t = 0; t < nt; t += 2) {
            const bool last = (t == nt - 2);
            const char* a1 = cA + (size_t)(t + 1) * kstep;
            const char* a2 = last ? nA : cA + (size_t)(t + 2) * kstep; const char* b2 = last ? nB : cB + (size_t)(t + 2) * kstep;
            const char* a3 = a2 + kstep; const char* b3 = b2 + kstep;
            if (last && has_next) S.a_ready(nxt);
            if constexpr (SP2) {
            PG8_LDB(B0, 0, 0); PG8_LDB(B1, 0, 1); PG8_SCHED; PG8_LDA(At, 0, 0); PG8_STAGE(PG8_SA(1, 1), a1 + hstep, voffA);
            PG8_WAIT_V(8); PG8_WAIT_L(0); PG8_BAR; PG8_MMA(0, 0, At, B0); PG8_MMA(0, 1, At, B1); PG8_BAR; PG8_SCHED;
            PG8_LDA(At, 0, 1); PG8_STAGE(PG8_SB(0, 0), b2, voffB); PG8_STAGE(PG8_SB(0, 1), b2 + hstep, voffB); PG8_STAGE(PG8_SA(0, 0), a2, voffA);
            PG8_WAIT_V(8); PG8_WAIT_L(0); PG8_BAR; PG8_MMA(1, 0, At, B0); PG8_MMA(1, 1, At, B1); PG8_BAR; PG8_SCHED;
            PG8_LDB(B0, 1, 0); PG8_LDB(B1, 1, 1); PG8_SCHED; PG8_LDA(At, 1, 0); PG8_STAGE(PG8_SA(0, 1), a2 + hstep, voffA);
            PG8_WAIT_V(8); PG8_WAIT_L(0); PG8_BAR; PG8_MMA(0, 0, At, B0); PG8_MMA(0, 1, At, B1); PG8_BAR; PG8_SCHED;
            PG8_LDA(At, 1, 1); PG8_STAGE(PG8_SB(1, 0), b3, voffB); PG8_STAGE(PG8_SB(1, 1), b3 + hstep, voffB); PG8_STAGE(PG8_SA(1, 0), a3, voffA);
            PG8_WAIT_V(8); PG8_WAIT_L(0); PG8_BAR; PG8_MMA(1, 0, At, B0); PG8_MMA(1, 1, At, B1); PG8_BAR; PG8_SCHED;
            } else {
            PG8_LDB(B0, 0, 0); PG8_SCHED; PG8_LDA(At, 0, 0); PG8_STAGE(PG8_SA(1, 1), a1 + hstep, voffA);
            PG8_WAIT_L(8); PG8_BAR; PG8_WAIT_L(0); PG8_MMA(0, 0, At, B0); PG8_BAR; PG8_SCHED;
            PG8_LDB(B1, 0, 1); PG8_STAGE(PG8_SB(0, 0), b2, voffB);
            PG8_BAR; PG8_WAIT_L(0); PG8_MMA(0, 1, At, B1); PG8_BAR;
            PG8_LDA(At, 0, 1); PG8_STAGE(PG8_SA(0, 0), a2, voffA);
            PG8_BAR; PG8_WAIT_L(0); PG8_MMA(1, 0, At, B0); PG8_BAR; PG8_SCHED;
            PG8_STAGE(PG8_SB(0, 1), b2 + hstep, voffB);
            PG8_WAIT_V(6); PG8_BAR; PG8_MMA(1, 1, At, B1); PG8_BAR;
            PG8_LDB(B0, 1, 0); PG8_SCHED; PG8_LDA(At, 1, 0); PG8_STAGE(PG8_SA(0, 1), a2 + hstep, voffA);
            PG8_WAIT_L(8); PG8_BAR; PG8_WAIT_L(0); PG8_MMA(0, 0, At, B0); PG8_BAR; PG8_SCHED;
            PG8_LDB(B1, 1, 1); PG8_STAGE(PG8_SB(1, 0), b3, voffB);
            PG8_BAR; PG8_WAIT_L(0); PG8_MMA(0, 1, At, B1); PG8_BAR;
            PG8_LDA(At, 1, 1); PG8_STAGE(PG8_SA(1, 0), a3, voffA);
            PG8_BAR; PG8_WAIT_L(0); PG8_MMA(1, 0, At, B0); PG8_BAR; PG8_SCHED;
            PG8_STAGE(PG8_SB(1, 1), b3 + hstep, voffB);
            PG8_WAIT_V(6); PG8_BAR; PG8_MMA(1, 1, At, B1); PG8_BAR;
            }
        }
        if constexpr (ALIGN_EPI) { if (wr == 0) PG8_BAR; }
        if constexpr (!Epi::AFTER_DRAIN) { E(acc, cur, wr, wc, fr, fq); S.done(cur); }
        if (!has_next) break;
#pragma unroll
        for (int a = 0; a < 2; ++a)
#pragma unroll
            for (int b = 0; b < 2; ++b)
#pragma unroll
                for (int m = 0; m < 4; ++m)
#pragma unroll
                    for (int n = 0; n < 2; ++n) acc[a][b][m][n] = (f32x4){0.f, 0.f, 0.f, 0.f};
        cur = nxt; cA = nA; cB = nB; ++ui;
        if constexpr (ALIGN_EPI) { if (wr == 1) PG8_BAR; }
    }
    PG8_WAIT_V(0);
    if constexpr (!ALIGN_EPI) { if (wr == 0) PG8_BAR; }
    PG8_BAR;
    if constexpr (Epi::AFTER_DRAIN) { E.fused(acc, cur, wr, wc, fr, fq, lds, wid, lane); S.done(cur); }
#undef PG8_SA
#undef PG8_SB
#undef PG8_STAGE
#undef PG8_LDA
#undef PG8_LDB
#undef PG8_MMA
#undef PG8_WAIT_V
#undef PG8_WAIT_L
#undef PG8_BAR
#undef PG8_SCHED
}
}

#ifndef PG8_SP2
#define PG8_SP2 true
#endif
#ifndef PG8_ALIGN
#define PG8_ALIGN true
#endif
#include <hip/hip_bf16.h>
#include <cmath>
namespace attn_body {
using bf16=__hip_bfloat16;
using bf16x8=__attribute__((ext_vector_type(8)))short;
using s16x4=__attribute__((ext_vector_type(4)))short;
using f32x16=__attribute__((ext_vector_type(16)))float;
using u32x4=__attribute__((ext_vector_type(4)))unsigned;
constexpr int BATCH=16,SEQ=2048,D=64,PIN=3584,POUT=1024;
constexpr int NW=8,QBLK=32,QB=QBLK*NW,KVBLK=64,NQB=SEQ/QB;
constexpr int ATTN_UNIT_ROWS=QB;
__device__ __forceinline__ int crow(int r,int hi){return (r&3)+8*(r>>2)+4*hi;}
#define SBAR() __builtin_amdgcn_sched_barrier(0)
__device__ __forceinline__ void cmask(f32x16&p0,f32x16&p1,int jb,int qrel,int hi){
  const float NEG=-INFINITY; int kb=64*jb+4*hi;
  #pragma unroll
  for(int r=0;r<16;++r){int kv=kb+(r&3)+8*(r>>2); if(kv>qrel)p0[r]=NEG; if(kv+32>qrel)p1[r]=NEG;}
}

constexpr int NSLOT=3, SLOTB=8192;
constexpr int LDS_K=0, LDS_V=NSLOT*SLOTB, LDS_WS=2*NSLOT*SLOTB, LDS_OST=LDS_WS+NW*64*4, LDS_BYTES=LDS_OST+NW*4096;
constexpr float C2=0.125f*1.4426950408889634f;
__device__ __forceinline__ void glds16(const void*gsrc,unsigned lds_dst){unsigned keep;
  asm volatile("s_mov_b32 %0, m0\n\ts_mov_b32 m0, %2\n\ts_nop 0\n\tglobal_load_lds_dwordx4 %1, off\n\ts_mov_b32 m0, %0":"=&s"(keep):"v"(gsrc),"s"(lds_dst):"memory");}
__device__ __forceinline__ float max3f(float a,float b,float c){float r;asm("v_max3_f32 %0, %1, %2, %3":"=v"(r):"v"(a),"v"(b),"v"(c));return r;}
__device__ __forceinline__ float max2f(float a,float b){float r;asm("v_max_f32_e32 %0, %1, %2":"=v"(r):"v"(a),"v"(b));return r;}
__device__ __forceinline__ float fadd_s(float a,float b){float r;asm("v_add_f32_e32 %0, %1, %2":"=v"(r):"v"(a),"v"(b));return r;}
__device__ __forceinline__ float fsub_s(float a,float b){float r;asm("v_sub_f32_e32 %0, %1, %2":"=v"(r):"v"(a),"v"(b));return r;}
typedef float f32x2_t __attribute__((ext_vector_type(2))); typedef __bf16 bf16x2_t __attribute__((ext_vector_type(2)));
__device__ __forceinline__ unsigned cvtpk_s(float lo,float hi){f32x2_t v={lo,hi};bf16x2_t b=__builtin_convertvector(v,bf16x2_t);return __builtin_bit_cast(unsigned,b);}
#define WAIT_BAR(N) asm volatile("s_waitcnt vmcnt(" #N ") lgkmcnt(0)\n\ts_barrier":::"memory")

__device__ __forceinline__ void qkt(f32x16&p0,f32x16&p1,const char*Kslot,const bf16x8*qr,const f32x16&negm,int r32,int hi){
  const char*kb=Kslot+hi*1024+r32*16;
  #pragma unroll
  for(int d0=0;d0<4;++d0){
    const bf16x8 b0=*reinterpret_cast<const bf16x8*>(kb+d0*2048);
    const bf16x8 b1=*reinterpret_cast<const bf16x8*>(kb+d0*2048+512);
    if(d0==0){p0=__builtin_amdgcn_mfma_f32_32x32x16_bf16(b0,qr[0],negm,0,0,0);p1=__builtin_amdgcn_mfma_f32_32x32x16_bf16(b1,qr[0],negm,0,0,0);}
    else{p0=__builtin_amdgcn_mfma_f32_32x32x16_bf16(b0,qr[d0],p0,0,0,0);p1=__builtin_amdgcn_mfma_f32_32x32x16_bf16(b1,qr[d0],p1,0,0,0);}}
}
typedef __attribute__((address_space(3))) const char* lds_cptr;
typedef short v4i16_t __attribute__((ext_vector_type(4)));
__device__ __forceinline__ void kload8(bf16x8*kf,lds_cptr kp){
  kf[0]=*(const __attribute__((address_space(3))) bf16x8*)(kp);      kf[1]=*(const __attribute__((address_space(3))) bf16x8*)(kp+512);
  kf[2]=*(const __attribute__((address_space(3))) bf16x8*)(kp+2048); kf[3]=*(const __attribute__((address_space(3))) bf16x8*)(kp+2560);
  kf[4]=*(const __attribute__((address_space(3))) bf16x8*)(kp+4096); kf[5]=*(const __attribute__((address_space(3))) bf16x8*)(kp+4608);
  kf[6]=*(const __attribute__((address_space(3))) bf16x8*)(kp+6144); kf[7]=*(const __attribute__((address_space(3))) bf16x8*)(kp+6656);
}
__device__ __forceinline__ void kload2(bf16x8*kf,lds_cptr kp,int j){ kf[2*j]=*(const __attribute__((address_space(3))) bf16x8*)(kp+j*2048); kf[2*j+1]=*(const __attribute__((address_space(3))) bf16x8*)(kp+j*2048+512); }
__device__ __forceinline__ s16x4 vtr(lds_cptr p){ return __builtin_bit_cast(s16x4,__builtin_amdgcn_ds_read_tr16_b64_v4i16((__attribute__((address_space(3))) v4i16_t*)p)); }
__device__ __forceinline__ float rowmax(const f32x16&p0,const f32x16&p1){
  float a=max3f(p0[0],p0[1],p1[0]),b=max3f(p0[2],p0[3],p1[1]);a=max3f(a,p1[2],p1[3]);
  #pragma unroll
  for(int r=4;r<16;r+=4){a=max3f(a,p0[r],p0[r+1]);b=max3f(b,p0[r+2],p0[r+3]);a=max3f(a,p1[r],p1[r+1]);b=max3f(b,p1[r+2],p1[r+3]);}
  const float m=max2f(a,b);
  auto rr=__builtin_amdgcn_permlane32_swap(__float_as_uint(m),__float_as_uint(m),false,false);
  return max2f(__uint_as_float(rr[0]),__uint_as_float(rr[1]));
}
__device__ __forceinline__ void pv(f32x16*o,int vb,bf16x8 pa0,bf16x8 pa1,bf16x8 pa2,bf16x8 pa3){
  #pragma unroll
  for(int d0=0;d0<2;++d0){s16x4 lo[4],hi[4];
    #pragma unroll
    for(int ks=0;ks<4;++ks){
      asm volatile("ds_read_b64_tr_b16 %0,%1 offset:%c2":"=&v"(lo[ks]):"v"(vb),"i"(d0*4096+ks*1024):"memory");
      asm volatile("ds_read_b64_tr_b16 %0,%1 offset:%c2":"=&v"(hi[ks]):"v"(vb),"i"(d0*4096+ks*1024+512):"memory");}
    asm volatile("s_waitcnt lgkmcnt(0)":::"memory");SBAR();
    #define PK(k) (bf16x8){lo[k][0],lo[k][1],lo[k][2],lo[k][3],hi[k][0],hi[k][1],hi[k][2],hi[k][3]}
    o[d0]=__builtin_amdgcn_mfma_f32_32x32x16_bf16(pa0,PK(0),o[d0],0,0,0);
    o[d0]=__builtin_amdgcn_mfma_f32_32x32x16_bf16(pa1,PK(1),o[d0],0,0,0);
    o[d0]=__builtin_amdgcn_mfma_f32_32x32x16_bf16(pa2,PK(2),o[d0],0,0,0);
    o[d0]=__builtin_amdgcn_mfma_f32_32x32x16_bf16(pa3,PK(3),o[d0],0,0,0);
    #undef PK
  }
}

#ifndef ATTN_STORE16
#define ATTN_STORE16(p,v) (*(u32x4*)(p)=(v))
#endif
template<int THRL> __device__ __forceinline__ void attn_unit(int b,int qb,const bf16*Q,const bf16*__restrict__ K,const bf16*__restrict__ V,bf16*O,char*shm){
  const int tid=threadIdx.x,lane=tid&63,r32=lane&31,hi=lane>>5; const int wid=__builtin_amdgcn_readfirstlane(tid>>6);
  const long rowbase=(long)b*SEQ; const int q0=qb*QB;
  const bf16*Qw=Q+(rowbase+q0+wid*QBLK)*PIN;
  const bf16*Kh=K+rowbase*PIN,*Vh=V+rowbase*PIN;
  const unsigned lds0=(unsigned)(uintptr_t)shm;
  float*wsf=(float*)(shm+LDS_WS)+wid*64;
  const bf16*ksrc=Kh+(long)lane*PIN+wid*8;
  const bf16*vsrc=Vh+(long)(16*(wid&3)+(lane>>2))*PIN+(wid>>2)*32+(lane&3)*8;
  const unsigned kdst=lds0+LDS_K+wid*1024, vdst=lds0+LDS_V+wid*1024;
  #define DMA_K(t,slot) glds16(ksrc+(long)(t)*KVBLK*PIN,(unsigned)__builtin_amdgcn_readfirstlane(kdst+(slot)))
  #define DMA_V(t,slot) glds16(vsrc+(long)(t)*KVBLK*PIN,(unsigned)__builtin_amdgcn_readfirstlane(vdst+(slot)))
  const int vb0=(int)(lds0+LDS_V)+((lane>>4)&1)*32+(lane&3)*8+(4*hi+((lane&15)>>2))*64;
  const char*Kbase=shm+LDS_K; bf16x8 kf[8];
  const lds_cptr shm3=(lds_cptr)shm; const lds_cptr kp0=shm3+LDS_K+hi*1024+r32*16; const lds_cptr vp0=shm3+LDS_V+((lane>>4)&1)*32+(lane&3)*8+(4*hi+((lane&15)>>2))*64;
  const int NT=(q0+QB)/KVBLK;
  DMA_K(0,0);DMA_V(0,0);DMA_K(1,SLOTB);
  bf16x8 qr[4];
  #pragma unroll
  for(int d0=0;d0<4;++d0)qr[d0]=*reinterpret_cast<const bf16x8*>(&Qw[(long)r32*PIN+d0*16+hi*8]);
  float mhat=0.f,l_reg=0.f;f32x16 o[2];o[0]=f32x16{};o[1]=f32x16{};f32x16 negm=f32x16{};asm volatile("":"+v"(negm));
  const int qrel=wid*QBLK+r32;
  #define CMASK(P0,P1,t) do{int jb_=(t)-(NT-4); if(jb_>=0)cmask(P0,P1,jb_,qrel,hi);}while(0)
  bool resc=false;
  #define START(P0,P1) do{ const float rm=rowmax(P0,P1); resc=false; \
    { const float dl=rm; mhat=fadd_s(mhat,dl); \
      _Pragma("unroll") for(int r=0;r<16;++r){P0[r]=fsub_s(P0[r],dl);P1[r]=fsub_s(P1[r],dl);} \
      _Pragma("unroll") for(int r=0;r<16;++r)negm[r]=-mhat; asm volatile("":"+v"(negm)); } \
    _Pragma("unroll") for(int r=0;r<16;++r)P0[r]=__builtin_amdgcn_exp2f(P0[r]); }while(0)
  #define RESC() do{ if(resc){ asm volatile("s_waitcnt lgkmcnt(0)":::"memory"); \
      _Pragma("unroll") for(int d_=0;d_<2;++d_) _Pragma("unroll") for(int r=0;r<16;++r)o[d_][r]*=wsf[crow(r,hi)]; } }while(0)
  f32x16 pA0,pA1,pB0,pB1;
  int sl_prev=0,sl_cur=0,sl_next=SLOTB;
  #define ROT() do{sl_prev=sl_cur;sl_cur=sl_next;sl_next=(sl_next==(NSLOT-1)*SLOTB)?0:sl_next+SLOTB;}while(0)
  DMA_K(2,2*SLOTB);
  WAIT_BAR(3);
  qkt(pA0,pA1,Kbase,qr,negm,r32,hi);asm volatile("s_nop 15\n\ts_nop 7":"+v"(pA0),"+v"(pA1));CMASK(pA0,pA1,0);
  START(pA0,pA1);
  _Pragma("unroll") for(int r=0;r<16;++r)pA1[r]=__builtin_amdgcn_exp2f(pA1[r]);
  WAIT_BAR(0);
  DMA_K(3,0);DMA_V(1,SLOTB);
  ROT();
  kload8(kf,kp0+sl_cur);
  WAIT_BAR(2);
  s16x4 vlo[8],vhi[8]; u32x4 pw0,pw1,pw2,pw3;
  #define PKW(P,B) cvtpk_s(P[B],P[B+1])
  #define PAF(k) __builtin_bit_cast(bf16x8,pw##k)
  #define VFR(i) (bf16x8){vlo[i][0],vlo[i][1],vlo[i][2],vlo[i][3],vhi[i][0],vhi[i][1],vhi[i][2],vhi[i][3]}
  #define PIN(x) asm volatile("":"+v"(x))
  #define MX3(a,b,c) __builtin_fmaxf(__builtin_fmaxf((a),(b)),(c))
  #define GAPA(MF,A0,A1,A2,A3,W0,W1,PW) do{ MF; sacc+=A0; sacc+=A1; sacc+=A2; sacc+=A3; PIN(sacc); W0; W1; PIN(PW); SBAR(); }while(0)
  #define EX(v) __builtin_amdgcn_exp2f(v)
  #define GAPB(MF,X,B) do{ MF; X[B]=EX(X[B]); X[B+1]=EX(X[B+1]); X[B+2]=EX(X[B+2]); X[B+3]=EX(X[B+3]); PIN(X); SBAR(); }while(0)
  #define VRD(i) do{ vlo[i]=vtr(vp_+(((i)>>2)*4096+((i)&3)*1024)); vhi[i]=vtr(vp_+(((i)>>2)*4096+((i)&3)*1024+512)); }while(0)
  #define KRD(G,j) do{ if(G){ kload2(kf,kp0+sl_next,j); SBAR(); } }while(0)
  #define STEP(C0,C1,P0,P1,t,GK,GV,GL) do{ SBAR(); \
    const lds_cptr vp_=vp0+sl_prev; \
    VRD(0); SBAR(); float sacc=(P0[0]+P0[1]); \
    GAPA(C0=__builtin_amdgcn_mfma_f32_32x32x16_bf16(kf[0],qr[0],negm,0,0,0), P0[2],P0[3],P0[4],P0[5],     pw0[0]=PKW(P0,0), pw0[1]=PKW(P0,2), pw0); \
    VRD(4); SBAR(); GAPA(C1=__builtin_amdgcn_mfma_f32_32x32x16_bf16(kf[1],qr[0],negm,0,0,0), P0[6],P0[7],P0[8],P0[9],     pw0[2]=PKW(P0,4), pw0[3]=PKW(P0,6), pw0); \
    VRD(1); SBAR(); GAPA(C0=__builtin_amdgcn_mfma_f32_32x32x16_bf16(kf[2],qr[1],C0,0,0,0),   P0[10],P0[11],P0[12],P0[13], pw1[0]=PKW(P0,8), pw1[1]=PKW(P0,10), pw1); \
    VRD(5); SBAR(); GAPA(C1=__builtin_amdgcn_mfma_f32_32x32x16_bf16(kf[3],qr[1],C1,0,0,0),   P0[14],P0[15],P1[0],P1[1],   pw1[2]=PKW(P0,12),pw1[3]=PKW(P0,14), pw1); \
    VRD(2); SBAR(); GAPA(C0=__builtin_amdgcn_mfma_f32_32x32x16_bf16(kf[4],qr[2],C0,0,0,0),   P1[2],P1[3],P1[4],P1[5],     pw2[0]=PKW(P1,0), pw2[1]=PKW(P1,2), pw2); \
    VRD(6); SBAR(); GAPA(C1=__builtin_amdgcn_mfma_f32_32x32x16_bf16(kf[5],qr[2],C1,0,0,0),   P1[6],P1[7],P1[8],P1[9],     pw2[2]=PKW(P1,4), pw2[3]=PKW(P1,6), pw2); \
    VRD(3); SBAR(); GAPA(C0=__builtin_amdgcn_mfma_f32_32x32x16_bf16(kf[6],qr[3],C0,0,0,0),   P1[10],P1[11],P1[12],P1[13], pw3[0]=PKW(P1,8), pw3[1]=PKW(P1,10), pw3); \
    VRD(7); SBAR(); GAPA(C1=__builtin_amdgcn_mfma_f32_32x32x16_bf16(kf[7],qr[3],C1,0,0,0),   P1[14],P1[15],0.f,0.f,       pw3[2]=PKW(P1,12),pw3[3]=PKW(P1,14), pw3); \
    l_reg+=sacc; \
    if(GK){DMA_K((t)+3,sl_cur);} if(GV){DMA_V((t)+1,sl_next);} \
    CMASK(C0,C1,t); \
    { float a=MX3(C0[0],C0[1],C1[0]),b=MX3(C0[2],C0[3],C1[1]); a=MX3(a,C1[2],C1[3]); \
      _Pragma("unroll") for(int r=4;r<16;r+=4){a=MX3(a,C0[r],C0[r+1]);b=MX3(b,C0[r+2],C0[r+3]);a=MX3(a,C1[r],C1[r+1]);b=MX3(b,C1[r+2],C1[r+3]);} \
      float rm=__builtin_fmaxf(a,b); { auto rr=__builtin_amdgcn_permlane32_swap(__float_as_uint(rm),__float_as_uint(rm),false,false); rm=__builtin_fmaxf(__uint_as_float(rr[0]),__uint_as_float(rr[1])); } \
      resc=false; \
      if(__builtin_expect(__any(rm>(float)THRL),0)){ const float dl=__builtin_fmaxf(rm,0.f); mhat+=dl; \
        _Pragma("unroll") for(int r=0;r<16;++r){C0[r]-=dl;C1[r]-=dl;} \
        _Pragma("unroll") for(int r=0;r<16;++r)negm[r]=-mhat; asm volatile("":"+v"(negm)); \
        const float f=__builtin_amdgcn_exp2f(-dl); l_reg*=f; if(hi==0)wsf[r32]=f; resc=true; } } \
    SBAR(); \
    GAPB(o[0]=__builtin_amdgcn_mfma_f32_32x32x16_bf16(PAF(0),VFR(0),o[0],0,0,0), C0,0); \
    GAPB(o[1]=__builtin_amdgcn_mfma_f32_32x32x16_bf16(PAF(0),VFR(4),o[1],0,0,0), C0,4); \
    KRD(GL,0); GAPB(o[0]=__builtin_amdgcn_mfma_f32_32x32x16_bf16(PAF(1),VFR(1),o[0],0,0,0), C0,8); \
    KRD(GL,1); GAPB(o[1]=__builtin_amdgcn_mfma_f32_32x32x16_bf16(PAF(1),VFR(5),o[1],0,0,0), C0,12); \
    KRD(GL,2); GAPB(o[0]=__builtin_amdgcn_mfma_f32_32x32x16_bf16(PAF(2),VFR(2),o[0],0,0,0), C1,0); \
    KRD(GL,3); GAPB(o[1]=__builtin_amdgcn_mfma_f32_32x32x16_bf16(PAF(2),VFR(6),o[1],0,0,0), C1,4); \
    GAPB(o[0]=__builtin_amdgcn_mfma_f32_32x32x16_bf16(PAF(3),VFR(3),o[0],0,0,0), C1,8); \
    GAPB(o[1]=__builtin_amdgcn_mfma_f32_32x32x16_bf16(PAF(3),VFR(7),o[1],0,0,0), C1,12); \
    }while(0)
  int t=1;
  #undef CMASK
  #define CMASK(P0,P1,t) do{}while(0)
  for(;t+5<NT;t+=2){
    STEP(pB0,pB1,pA0,pA1,t,true,true,true);     WAIT_BAR(2); RESC(); ROT();
    STEP(pA0,pA1,pB0,pB1,t+1,true,true,true);   WAIT_BAR(2); RESC(); ROT();
  }
  #undef CMASK
  #define CMASK(P0,P1,t) do{int jb_=(t)-(NT-4); if(jb_>=0)cmask(P0,P1,jb_,qrel,hi);}while(0)
  #define ENDW(tt) do{ if((tt)+3<NT){WAIT_BAR(2);} else if((tt)+2<NT){WAIT_BAR(1);} else {WAIT_BAR(0);} }while(0)
  for(;t+1<NT;t+=2){
    STEP(pB0,pB1,pA0,pA1,t,(t+3<NT),(t+1<NT),(t+1<NT));       ENDW(t);   RESC(); ROT();
    STEP(pA0,pA1,pB0,pB1,t+1,(t+4<NT),(t+2<NT),(t+2<NT));     ENDW(t+1); RESC(); ROT();
  }
  STEP(pB0,pB1,pA0,pA1,NT-1,false,false,false); RESC();
  { float sacc=pB0[0]+pB0[1]; _Pragma("unroll") for(int r=2;r<16;++r)sacc+=pB0[r]; _Pragma("unroll") for(int r=0;r<16;++r)sacc+=pB1[r]; l_reg+=sacc;
    pw0=(u32x4){PKW(pB0,0),PKW(pB0,2),PKW(pB0,4),PKW(pB0,6)};pw1=(u32x4){PKW(pB0,8),PKW(pB0,10),PKW(pB0,12),PKW(pB0,14)};pw2=(u32x4){PKW(pB1,0),PKW(pB1,2),PKW(pB1,4),PKW(pB1,6)};pw3=(u32x4){PKW(pB1,8),PKW(pB1,10),PKW(pB1,12),PKW(pB1,14)};
    SBAR(); pv(o,vb0+sl_cur,PAF(0),PAF(1),PAF(2),PAF(3)); }
  #undef PKW
  #undef PAF
  #undef VFR
  #undef PIN
  #undef MX3
  #undef GAPA
  #undef GAPB
  #undef EX
  #undef VRD
  #undef KRD
  #undef STEP
  #undef ENDW
  {auto rr=__builtin_amdgcn_permlane32_swap(__float_as_uint(l_reg),__float_as_uint(l_reg),false,false);l_reg=__uint_as_float(rr[0])+__uint_as_float(rr[1]);}
  if(hi==0)wsf[32+r32]=l_reg;asm volatile("s_waitcnt lgkmcnt(0)":::"memory");
  float rli[16];
  #pragma unroll
  for(int r=0;r<16;++r)rli[r]=__builtin_amdgcn_rcpf(wsf[32+crow(r,hi)]);
  bf16*Ow=O+(rowbase+q0+wid*QBLK)*POUT;
  { bf16*stg=(bf16*)(shm+LDS_OST)+wid*2048;
    #pragma unroll
    for(int r=0;r<16;++r){const int orow=crow(r,hi);
      #pragma unroll
      for(int d0=0;d0<2;++d0)stg[orow*64+d0*32+r32]=__float2bfloat16(o[d0][r]*rli[r]);}
    asm volatile("s_waitcnt lgkmcnt(0)":::"memory");
    #pragma unroll
    for(int i=0;i<4;++i){const int row=i*8+(lane>>3),ch=lane&7; const u32x4 v=*(const u32x4*)(stg+row*64+ch*8); ATTN_STORE16(Ow+(long)row*POUT+ch*8,v);} }
  asm volatile("s_waitcnt lgkmcnt(0)\n\ts_barrier":::"memory");
  #undef DMA_K
  #undef DMA_V
  #undef CMASK
  #undef START
  #undef RESC
  #undef ROT
}
constexpr int ATTN_LDS_BYTES=LDS_BYTES;
#undef SBAR
#undef WAIT_BAR
}

#define GAS __attribute__((address_space(1)))
#define LAS __attribute__((address_space(3)))
typedef unsigned short bf16;
typedef unsigned v4u __attribute__((ext_vector_type(4)));
typedef float f32x4 __attribute__((ext_vector_type(4)));
typedef short bf16x8 __attribute__((ext_vector_type(8)));
typedef GAS unsigned gu32;
typedef GAS unsigned long long gu64;
#define RLX_AGENT __ATOMIC_RELAXED, __HIP_MEMORY_SCOPE_AGENT
#define LDS_WAIT() asm volatile("s_waitcnt lgkmcnt(0)" ::: "memory")
#define VM_WAIT() asm volatile("s_waitcnt vmcnt(0)" ::: "memory")
__device__ __forceinline__ unsigned long long rt() { return __builtin_amdgcn_s_memrealtime(); }
__device__ __forceinline__ unsigned f2bf(float f) { unsigned u = __builtin_bit_cast(unsigned, f); return (u + 0x7fffu + ((u >> 16) & 1u)) >> 16; }
__device__ __forceinline__ unsigned pk2(float lo, float hi) { return f2bf(lo) | (f2bf(hi) << 16); }

#define XB_TMO      128
#define XB_XCNT(j)  (256  + 64 * (j))
#define XB_XSUB(j)  (1280 + 64 * (j))
#define XB_XGEN(j)  (2304 + 64 * (j))
#define XB_TOP      3328
#define XB_TOPGEN   3392
#define XCD_BAR_WORDS 3456
#define XB_SPIN_CAP (1u << 18)

__device__ __forceinline__ unsigned xb_ld(unsigned* p)              { return __hip_atomic_load(p, __ATOMIC_RELAXED, __HIP_MEMORY_SCOPE_AGENT); }
__device__ __forceinline__ unsigned xb_add(unsigned* p, unsigned v) { return __hip_atomic_fetch_add(p, v, __ATOMIC_RELAXED, __HIP_MEMORY_SCOPE_AGENT); }
__device__ __forceinline__ unsigned xb_xcc_id() { return (unsigned)__builtin_amdgcn_s_getreg((3 << 11) | 20) & 0xFu; }
#define XB_SPIN(cond, bar) do { unsigned _sp = 0; while (cond) { __builtin_amdgcn_s_sleep(1); \
    if ((++_sp & 255u) == 0u) { if (xb_ld(&(bar)[XB_TMO])) break; if (_sp > XB_SPIN_CAP) { atomicAdd(&(bar)[XB_TMO], 1u); break; } } } } while (0)

struct XcdBarrier {
    unsigned* bar; unsigned x;
    volatile LAS unsigned* st;
};

__device__ __forceinline__ XcdBarrier xcd_barrier_post(unsigned* bar, volatile LAS unsigned* st) {
    XcdBarrier b; b.bar = bar; b.x = xb_xcc_id(); b.st = st;
    if (threadIdx.x == 0) (void)xb_add(&bar[XB_XCNT(b.x)], 1u);
    return b;
}
__device__ __forceinline__ void xcd_barrier_complete(unsigned* bar, unsigned x, unsigned& nloc, unsigned& nx) {
    const unsigned G = gridDim.x * gridDim.y * gridDim.z;
    unsigned sum, cnt, mine, sp = 0u;
    for (;;) {
        sum = 0u; cnt = 0u; mine = 0u;
#pragma unroll
        for (unsigned j = 0; j < 16; ++j) { const unsigned c = xb_ld(&bar[XB_XCNT(j)]); sum += c; cnt += (c > 0u) ? 1u : 0u; mine = (j == x) ? c : mine; }
        if (sum == G) break;
        __builtin_amdgcn_s_sleep(1);
        if ((++sp & 255u) == 0u) { if (xb_ld(&bar[XB_TMO])) break; if (sp > XB_SPIN_CAP) { atomicAdd(&bar[XB_TMO], 1u); break; } }
    }
    nloc = mine > 0u ? mine : 1u; nx = cnt > 0u ? cnt : 1u;
}

__device__ __forceinline__ void xcd_barrier(const XcdBarrier& b) {
    asm volatile("s_waitcnt vmcnt(0)" ::: "memory");
    __syncthreads();
    if (threadIdx.x == 0) {
        unsigned* bar = b.bar;
        __builtin_amdgcn_s_waitcnt(0);
        unsigned nloc = b.st[0], nx = b.st[1];
        if (nloc == 0u) { xcd_barrier_complete(bar, b.x, nloc, nx); b.st[0] = nloc; b.st[1] = nx; }
        const unsigned old = xb_add(&bar[XB_XSUB(b.x)], 1u);
        const unsigned gen = old / nloc;
        if (old + 1u == (gen + 1u) * nloc) {
            __builtin_amdgcn_fence(__ATOMIC_RELEASE, "agent");
            asm volatile("s_waitcnt vmcnt(0)" ::: "memory");
            const unsigned og = xb_add(&bar[XB_TOP], 1u);
            const unsigned tg = og / nx;
            if (og + 1u == (tg + 1u) * nx) xb_add(&bar[XB_TOPGEN], 1u);
            else XB_SPIN(xb_ld(&bar[XB_TOPGEN]) == tg, bar);
            __builtin_amdgcn_fence(__ATOMIC_ACQUIRE, "agent");
            xb_add(&bar[XB_XGEN(b.x)], 1u);
            asm volatile("s_waitcnt vmcnt(0)" ::: "memory");
        } else {
            XB_SPIN(xb_ld(&bar[XB_XGEN(b.x)]) == gen, bar);
            __builtin_amdgcn_fence(__ATOMIC_ACQUIRE, "agent");
            asm volatile("s_waitcnt vmcnt(0)" ::: "memory");
        }
    }
    __syncthreads();
}

constexpr int NWAVES = 8;
constexpr int BATCH = 16, SEQ = 2048, D = 1024, M = BATCH * SEQ;
constexpr int NPROJ = 3584;
constexpr int C_RQ = 0, C_RK = 512, C_RV = 1024, C_RG = 1536, C_DQ = 2048, C_DK = 2560, C_DV = 3072;
constexpr int NQ = 2048, NEXP = 16384, NSEL = 128;
constexpr float ALPHA = 1.189207115002721f, LN_EPS = 1e-5f, LAMBDA_INIT = 0.2f;
constexpr float QSCALE = 0.125f * 1.4426950408889634f;
constexpr float KSCALE = 0.08838834764831845f;

constexpr size_t MiB = 1u << 20;
constexpr size_t WS_CTL = 0, CTL_ZERO_BYTES = 1 * MiB;
constexpr size_t WS_WIN = 2 * MiB, WS_WOUT = 10 * MiB, WS_WQ = 12 * MiB, WS_SK = 16 * MiB, WS_ROPE = 17 * MiB, WS_MISC = 18 * MiB;
constexpr size_t WS_XB = 32 * MiB;
constexpr size_t WS_DOUT = 32 * MiB;
constexpr size_t WS_PU = 96 * MiB, WS_PV = 112 * MiB;
constexpr size_t WS_SU = 18 * MiB, WS_SV = 18 * MiB + 65536;
constexpr size_t WS_PROJ = 160 * MiB;
constexpr size_t WS_X1 = 160 * MiB, WS_IDX = 224 * MiB, WS_GATE = 240 * MiB, WS_QP = 256 * MiB;
constexpr size_t WS_MIX = 400 * MiB;
constexpr size_t WS_END = 496 * MiB;
constexpr int CW_TMO = 0, CW_CODE = 1, CW_BAR = 4096;

constexpr int RING_OFF = 0, RING_BYTES = 131072;
constexpr int LDSCTL_OFF = RING_BYTES, MISC_OFF = LDSCTL_OFF + 320;
constexpr int LDS_BYTES = 147456;

struct Frame {
    LAS unsigned char* lds;
    volatile LAS unsigned* MISC;
    gu32* ctl;
    int tid, lane, wave;
    int vcu, G;
    const float* const* in; float* out; unsigned char* ws;
};

__device__ __forceinline__ float bf2f(unsigned short b) { return __builtin_bit_cast(float, (unsigned)b << 16); }
__device__ __forceinline__ float bflo(unsigned w) { return __builtin_bit_cast(float, w << 16); }
__device__ __forceinline__ float bfhi(unsigned w) { return __builtin_bit_cast(float, w & 0xffff0000u); }
__device__ __forceinline__ float wave_sum(float v) {
#pragma unroll
    for (int o = 1; o < 64; o <<= 1) v += __shfl_xor(v, o);
    return v;
}
__device__ __forceinline__ float wave_max(float v) {
#pragma unroll
    for (int o = 1; o < 64; o <<= 1) v = fmaxf(v, __shfl_xor(v, o));
    return v;
}
__device__ __forceinline__ float dot8(v4u a, v4u b, float s) {
    s = fmaf(bflo(a.x), bflo(b.x), s); s = fmaf(bfhi(a.x), bfhi(b.x), s);
    s = fmaf(bflo(a.y), bflo(b.y), s); s = fmaf(bfhi(a.y), bfhi(b.y), s);
    s = fmaf(bflo(a.z), bflo(b.z), s); s = fmaf(bfhi(a.z), bfhi(b.z), s);
    s = fmaf(bflo(a.w), bflo(b.w), s); s = fmaf(bfhi(a.w), bfhi(b.w), s);
    return s;
}

__device__ __forceinline__ unsigned offb(unsigned row, unsigned ch) { return 256u * row + 16u * (ch ^ (((row & 3u) << 2) | ((row >> 2) & 3u))); }
__device__ __forceinline__ int phys_col(int L) { if (L >= 1024) return L; const int hd = L >> 7, l = L & 127; return hd * 128 + (l < 64 ? 2 * l : 2 * (l - 64) + 1); }
template <bool PERMQK>
__device__ __forceinline__ void p0_transpose_item(const float* W, int K, int N, bf16* WT, LAS float* scr, int item, int lane) {
    const int nblk = N / 32, kb = item / nblk, nb = item % nblk, k0 = 64 * kb, n0 = 32 * nb;
#pragma unroll 8
    for (int i = 0; i < 32; ++i) { const int kk = 2 * i + (lane >> 5); scr[kk * 33 + (lane & 31)] = W[(size_t)(k0 + kk) * N + n0 + (lane & 31)]; }
    LDS_WAIT(); asm volatile("" ::: "memory");
    const int c = lane & 7;
#pragma unroll
    for (int j = 0; j < 4; ++j) { const int n = (lane >> 3) + 8 * j; const LAS float* s = scr + (8 * c) * 33 + n;
        v4u o; o.x = pk2(s[0 * 33], s[1 * 33]); o.y = pk2(s[2 * 33], s[3 * 33]); o.z = pk2(s[4 * 33], s[5 * 33]); o.w = pk2(s[6 * 33], s[7 * 33]);
        const int orow = PERMQK ? phys_col(n0 + n) : (n0 + n);
        *(GAS v4u*)(WT + (size_t)orow * K + k0 + 8 * c) = o; }
    LDS_WAIT(); asm volatile("" ::: "memory");
}
__device__ __forceinline__ void cvt_bf16_stream(const float* src, bf16* dst, size_t n4, int gt, int ngt) {
    for (size_t i = gt; i < n4; i += ngt) { const f32x4 v = ((const GAS f32x4*)src)[i]; typedef unsigned u2 __attribute__((ext_vector_type(2))); u2 o; o.x = pk2(v.x, v.y); o.y = pk2(v.z, v.w); ((GAS u2*)dst)[i] = o; }
}
__device__ __forceinline__ void p0_prologue(Frame& F) {
    LAS float* scr = (LAS float*)(F.lds + RING_OFF + F.wave * 16384);
    const int gw = F.vcu * NWAVES + F.wave, NGW = F.G * NWAVES;
    const int gt = (int)blockIdx.x * (NWAVES * 64) + F.tid, ngt = F.G * NWAVES * 64;
    constexpr int I_IN = (D / 64) * (NPROJ / 32), I_OUT = (D / 64) * (D / 32), I_Q = (D / 64) * (NQ / 32);
    constexpr int NITEMS = I_IN + I_OUT + I_Q;
    for (int it = gw; it < NITEMS; it += NGW) {
        int r = it;
        if (r < I_IN) { p0_transpose_item<true>(F.in[1], D, NPROJ, (bf16*)(F.ws + WS_WIN), scr, r, F.lane); continue; } r -= I_IN;
        if (r < I_OUT) { p0_transpose_item<false>(F.in[9], D, D, (bf16*)(F.ws + WS_WOUT), scr, r, F.lane); continue; } r -= I_OUT;
        p0_transpose_item<false>(F.in[12], D, NQ, (bf16*)(F.ws + WS_WQ), scr, r, F.lane);
    }
    cvt_bf16_stream(F.in[13], (bf16*)(F.ws + WS_SK), (size_t)8 * 2 * 128 * 128 / 4, gt, ngt);
    for (int r = gw; r < 2 * NEXP; r += NGW) {
        const bool isv = r >= NEXP; const int row = isv ? r - NEXP : r;
        const GAS f32x4* src = (const GAS f32x4*)((isv ? F.in[15] : F.in[14]) + (size_t)row * D) + 4 * F.lane;
        f32x4 v[4]; float am = 0.f;
#pragma unroll
        for (int j = 0; j < 4; ++j) { v[j] = src[j]; am = fmaxf(am, fmaxf(fmaxf(fabsf(v[j].x), fabsf(v[j].y)), fmaxf(fabsf(v[j].z), fabsf(v[j].w)))); }
        am = wave_max(am);
        const float sc = am > 0.f ? 224.f / am : 1.f;
        v4u o;
        { int w0 = __builtin_amdgcn_cvt_pk_fp8_f32(v[0].x * sc, v[0].y * sc, 0, false); w0 = __builtin_amdgcn_cvt_pk_fp8_f32(v[0].z * sc, v[0].w * sc, w0, true); o.x = (unsigned)w0; }
        { int w0 = __builtin_amdgcn_cvt_pk_fp8_f32(v[1].x * sc, v[1].y * sc, 0, false); w0 = __builtin_amdgcn_cvt_pk_fp8_f32(v[1].z * sc, v[1].w * sc, w0, true); o.y = (unsigned)w0; }
        { int w0 = __builtin_amdgcn_cvt_pk_fp8_f32(v[2].x * sc, v[2].y * sc, 0, false); w0 = __builtin_amdgcn_cvt_pk_fp8_f32(v[2].z * sc, v[2].w * sc, w0, true); o.z = (unsigned)w0; }
        { int w0 = __builtin_amdgcn_cvt_pk_fp8_f32(v[3].x * sc, v[3].y * sc, 0, false); w0 = __builtin_amdgcn_cvt_pk_fp8_f32(v[3].z * sc, v[3].w * sc, w0, true); o.w = (unsigned)w0; }
        ((GAS v4u*)(F.ws + (isv ? WS_PV : WS_PU) + (size_t)row * D))[F.lane] = o;
        if (F.lane == 0) ((float*)(F.ws + (isv ? WS_SV : WS_SU)))[row] = am > 0.f ? am * (1.f / 224.f) : 1.f;
    }
    cvt_bf16_stream(F.in[0], (bf16*)(F.ws + WS_XB), (size_t)M * D / 4, gt, ngt);
    float* rope = (float*)(F.ws + WS_ROPE);
    for (int e = gt; e < SEQ * 64; e += ngt) {
        const int pos = e >> 6, i = e & 63;
        const float inv = exp2f(-(float)i * (13.287712379549449f / 64.f));
        const float ang = (float)pos * inv;
        const float k = rintf(ang * 0.15915494309189535f);
        float r = fmaf(-k, 6.2831854820251465f, ang); r = fmaf(-k, -1.7484555314695172e-07f, r);
        rope[2 * e] = cosf(r); rope[2 * e + 1] = sinf(r);
    }
}

__device__ __forceinline__ void p2_retention_naive(Frame& F) {
    const bf16* PROJ = (const bf16*)(F.ws + WS_PROJ); bf16* MIX = (bf16*)(F.ws + WS_MIX);
    LAS float* S = (LAS float*)(F.lds + RING_OFF); LAS float* ST = S + 128 * 128;
    const float* gn_g = F.in[2]; const float* gn_b = F.in[3];
    const int t = F.tid;
    for (int u = (int)blockIdx.x; u < BATCH * 4; u += F.G) {
        const int b = u >> 2, h = u & 3;
        const float gam = 1.f - exp2f(-5.f - (float)h); const float l2g = log2f(gam);
        for (int e = t; e < 128 * 128; e += NWAVES * 64) ST[e] = 0.f;
        __syncthreads();
        for (int c = 0; c < 16; ++c) {
            const size_t rb = (size_t)b * SEQ + c * 128;
            {
                const int i = t >> 2, jq = t & 3;
                const GAS v4u* qp = (const GAS v4u*)(PROJ + (rb + i) * NPROJ + C_RQ + h * 128);
#pragma unroll 1
                for (int jj = 0; jj < 32; ++jj) { const int j = jq * 32 + jj; float s = 0.f;
                    if (j <= i) { const GAS v4u* kp = (const GAS v4u*)(PROJ + (rb + j) * NPROJ + C_RK + h * 128);
#pragma unroll
                        for (int d = 0; d < 16; ++d) s = dot8(qp[d], kp[d], s);
                        s *= exp2f((float)(i - j) * l2g); }
                    S[i * 128 + j] = s; }
            }
            __syncthreads();
            {
                const int i = t >> 2, vq = t & 3;
                float o[32];
#pragma unroll
                for (int v = 0; v < 32; ++v) o[v] = 0.f;
#pragma unroll 2
                for (int j = 0; j <= i; ++j) { const float sij = S[i * 128 + j];
                    const GAS v4u* vp = (const GAS v4u*)(PROJ + (rb + j) * NPROJ + C_RV + h * 128 + vq * 32);
#pragma unroll
                    for (int q4 = 0; q4 < 4; ++q4) { const v4u w = vp[q4];
                        o[q4 * 8 + 0] = fmaf(sij, bflo(w.x), o[q4 * 8 + 0]); o[q4 * 8 + 1] = fmaf(sij, bfhi(w.x), o[q4 * 8 + 1]);
                        o[q4 * 8 + 2] = fmaf(sij, bflo(w.y), o[q4 * 8 + 2]); o[q4 * 8 + 3] = fmaf(sij, bfhi(w.y), o[q4 * 8 + 3]);
                        o[q4 * 8 + 4] = fmaf(sij, bflo(w.z), o[q4 * 8 + 4]); o[q4 * 8 + 5] = fmaf(sij, bfhi(w.z), o[q4 * 8 + 5]);
                        o[q4 * 8 + 6] = fmaf(sij, bflo(w.w), o[q4 * 8 + 6]); o[q4 * 8 + 7] = fmaf(sij, bfhi(w.w), o[q4 * 8 + 7]); } }
                const float dq = exp2f((float)(i + 1) * l2g);
                const GAS unsigned short* qrow = (const GAS unsigned short*)(PROJ + (rb + i) * NPROJ + C_RQ + h * 128);
#pragma unroll 2
                for (int d = 0; d < 128; ++d) { const float qd = bf2f(qrow[d]) * dq; const LAS float* sp = ST + d * 128 + vq * 32;
#pragma unroll
                    for (int v = 0; v < 32; ++v) o[v] = fmaf(qd, sp[v], o[v]); }
                float sm = 0.f;
#pragma unroll
                for (int v = 0; v < 32; ++v) sm += o[v];
                sm += __shfl_xor(sm, 1); sm += __shfl_xor(sm, 2);
                const float mu = sm * (1.f / 128.f); float q2 = 0.f;
#pragma unroll
                for (int v = 0; v < 32; ++v) { const float dlt = o[v] - mu; q2 += dlt * dlt; }
                q2 += __shfl_xor(q2, 1); q2 += __shfl_xor(q2, 2);
                const float rstd = 1.f / sqrtf(q2 * (1.f / 128.f) + LN_EPS);
                const GAS unsigned short* grow = (const GAS unsigned short*)(PROJ + (rb + i) * NPROJ + C_RG + h * 128 + vq * 32);
                GAS unsigned short* mrow = (GAS unsigned short*)(MIX + (rb + i) * D + h * 128 + vq * 32);
#pragma unroll
                for (int v = 0; v < 32; ++v) { const int ch = h * 128 + vq * 32 + v; const float r = bf2f(grow[v]) * ((o[v] - mu) * rstd * gn_g[ch] + gn_b[ch]); mrow[v] = (unsigned short)f2bf(r); }
            }
            __syncthreads();
            {
                const int d = t >> 2, vq = t & 3;
                float a[32];
                const float dc = exp2f(128.f * l2g);
                LAS float* sp = ST + d * 128 + vq * 32;
#pragma unroll
                for (int v = 0; v < 32; ++v) a[v] = sp[v] * dc;
#pragma unroll 2
                for (int j = 0; j < 128; ++j) { const float kd = bf2f(((const GAS unsigned short*)PROJ)[(rb + j) * NPROJ + C_RK + h * 128 + d]) * exp2f((float)(127 - j) * l2g);
                    const GAS v4u* vp = (const GAS v4u*)(PROJ + (rb + j) * NPROJ + C_RV + h * 128 + vq * 32);
#pragma unroll
                    for (int q4 = 0; q4 < 4; ++q4) { const v4u w = vp[q4];
                        a[q4 * 8 + 0] = fmaf(kd, bflo(w.x), a[q4 * 8 + 0]); a[q4 * 8 + 1] = fmaf(kd, bfhi(w.x), a[q4 * 8 + 1]);
                        a[q4 * 8 + 2] = fmaf(kd, bflo(w.y), a[q4 * 8 + 2]); a[q4 * 8 + 3] = fmaf(kd, bfhi(w.y), a[q4 * 8 + 3]);
                        a[q4 * 8 + 4] = fmaf(kd, bflo(w.z), a[q4 * 8 + 4]); a[q4 * 8 + 5] = fmaf(kd, bfhi(w.z), a[q4 * 8 + 5]);
                        a[q4 * 8 + 6] = fmaf(kd, bflo(w.w), a[q4 * 8 + 6]); a[q4 * 8 + 7] = fmaf(kd, bfhi(w.w), a[q4 * 8 + 7]); } }
#pragma unroll
                for (int v = 0; v < 32; ++v) sp[v] = a[v];
            }
            __syncthreads();
        }
    }
}

__device__ __forceinline__ float diff_lambda(Frame& F) {
    const float a = wave_sum(F.in[4][F.lane] * F.in[5][F.lane]); const float b = wave_sum(F.in[6][F.lane] * F.in[7][F.lane]);
    return expf(a) - expf(b) + LAMBDA_INIT;
}
__device__ __forceinline__ void p2_diffattn_naive(Frame& F) {
    const bf16* PROJ = (const bf16*)(F.ws + WS_PROJ); bf16* MIX = (bf16*)(F.ws + WS_MIX);
    LAS float* sb = (LAS float*)(F.lds + RING_OFF) + F.wave * 2048;
    const float lam = diff_lambda(F);
    const float* sg = F.in[8];
    const int gw = (int)blockIdx.x * NWAVES + F.wave, NGW = F.G * NWAVES;
    const int lane = F.lane;
    for (int task = gw; task < BATCH * 4 * SEQ; task += NGW) {
        const int i = task >> 6, bh = task & 63, b = bh >> 2, h = bh & 3;
        const size_t rb = (size_t)b * SEQ;
        float oc[2][2];
#pragma unroll
        for (int c = 0; c < 2; ++c) {
            const GAS v4u* qp = (const GAS v4u*)(PROJ + (rb + i) * NPROJ + C_DQ + h * 128 + c * 64);
            v4u q[8];
#pragma unroll
            for (int d = 0; d < 8; ++d) q[d] = qp[d];
            float mx = -INFINITY;
#pragma unroll 1
            for (int j0 = 0; j0 <= i; j0 += 64) { const int j = j0 + lane;
                if (j <= i) { const GAS v4u* kp = (const GAS v4u*)(PROJ + (rb + j) * NPROJ + C_DK + h * 128 + c * 64); float s = 0.f;
#pragma unroll
                    for (int d = 0; d < 8; ++d) s = dot8(q[d], kp[d], s);
                    sb[j] = s; mx = fmaxf(mx, s); } }
            mx = wave_max(mx);
            float l = 0.f;
            for (int j0 = 0; j0 <= i; j0 += 64) { const int j = j0 + lane; if (j <= i) { const float p = exp2f(sb[j] - mx); sb[j] = p; l += p; } }
            l = wave_sum(l);
            LDS_WAIT(); asm volatile("" ::: "memory");
            float o0 = 0.f, o1 = 0.f;
            const GAS unsigned* vp = (const GAS unsigned*)(PROJ + rb * NPROJ + C_DV + h * 128) + lane;
#pragma unroll 4
            for (int j = 0; j <= i; ++j) { const float p = sb[j]; const unsigned w = vp[(size_t)j * (NPROJ / 2)]; o0 = fmaf(p, bflo(w), o0); o1 = fmaf(p, bfhi(w), o1); }
            const float rl = 1.f / l; oc[c][0] = o0 * rl; oc[c][1] = o1 * rl;
            LDS_WAIT(); asm volatile("" ::: "memory");
        }
        const float d0 = oc[0][0] - lam * oc[1][0], d1 = oc[0][1] - lam * oc[1][1];
        const float ms = wave_sum(d0 * d0 + d1 * d1) * (1.f / 128.f);
        const float rs = (1.f - LAMBDA_INIT) / sqrtf(ms + LN_EPS);
        const int ch = h * 128 + 2 * lane;
        ((GAS unsigned*)(MIX + (rb + i) * D + 512 + h * 128))[lane] = pk2(d0 * rs * sg[ch], d1 * rs * sg[ch + 1]);
    }
}


typedef short v4i16_t __attribute__((ext_vector_type(4)));
__device__ __forceinline__ bf16x8 frag_row(LAS const unsigned char* img, int lane, int rb, int s) { return *(const LAS bf16x8*)(img + offb((unsigned)((lane & 15) + 16 * rb), (unsigned)(4 * s + (lane >> 4)))); }
__device__ __forceinline__ bf16x8 frag_tr(LAS const unsigned char* img, int lane, int c, int ks) {
    const unsigned g = (unsigned)lane >> 4, q = ((unsigned)lane & 15u) >> 2, p = (unsigned)lane & 3u;
    const unsigned a0 = offb(32u * ks + 8u * g + q, 2u * c + (p >> 1)) + 8u * (p & 1u), a1 = offb(32u * ks + 8u * g + 4u + q, 2u * c + (p >> 1)) + 8u * (p & 1u);
    const v4i16_t t0 = __builtin_amdgcn_ds_read_tr16_b64_v4i16((LAS v4i16_t*)(img + a0)), t1 = __builtin_amdgcn_ds_read_tr16_b64_v4i16((LAS v4i16_t*)(img + a1));
    return (bf16x8){t0[0], t0[1], t0[2], t0[3], t1[0], t1[1], t1[2], t1[3]};
}
constexpr size_t WS_ST = 464 * MiB;
__device__ __forceinline__ void p2_retention_scan(Frame& F) {
    const bf16* PROJ = (const bf16*)(F.ws + WS_PROJ); bf16* ST = (bf16*)(F.ws + WS_ST);
    int tid = F.tid; asm volatile("" : "+v"(tid)); const int lane = tid & 63, wave = F.wave;
    for (int u = F.vcu; u < BATCH * 4 * 4; u += F.G) {
        const int bh = u >> 2, vq = u & 3, b = bh >> 2, h = bh & 3;
        const float l2g = log2f(1.f - exp2f(-5.f - (float)h)); const float dc = exp2f(128.f * l2g);
        f32x4 acc[2] = {(f32x4){0.f, 0.f, 0.f, 0.f}, (f32x4){0.f, 0.f, 0.f, 0.f}};
        v4u rk[4], rv[4];
#define RET_LOADKV(cc) do { _Pragma("unroll") for (int q = 0; q < 4; ++q) { const int id = tid + 512 * q, row = id >> 4, ch = id & 15; const size_t r = (size_t)b * SEQ + (cc) * 128 + row; \
            rk[q] = *(const GAS v4u*)(PROJ + r * NPROJ + C_RK + h * 128 + ch * 8); rv[q] = *(const GAS v4u*)(PROJ + r * NPROJ + C_RV + h * 128 + ch * 8); } } while (0)
        RET_LOADKV(0);
#pragma unroll 1
        for (int c = 0; c < 16; ++c) {
            LAS unsigned char* kimg = F.lds + RING_OFF + (c & 1) * 65536; LAS unsigned char* vimg = kimg + 32768;
#pragma unroll
            for (int q = 0; q < 4; ++q) { const int id = tid + 512 * q, row = id >> 4, ch = id & 15; const float sc = exp2f((float)(127 - row) * l2g);
                v4u w = rk[q]; w.x = pk2(bflo(w.x) * sc, bfhi(w.x) * sc); w.y = pk2(bflo(w.y) * sc, bfhi(w.y) * sc); w.z = pk2(bflo(w.z) * sc, bfhi(w.z) * sc); w.w = pk2(bflo(w.w) * sc, bfhi(w.w) * sc);
                *(LAS v4u*)(kimg + offb((unsigned)row, (unsigned)ch)) = w; *(LAS v4u*)(vimg + offb((unsigned)row, (unsigned)ch)) = rv[q]; }
            if (c + 1 < 16) RET_LOADKV(c + 1);
            { bf16* sp = ST + ((size_t)(bh * 16 + c) * 128) * 128;
#pragma unroll
              for (int mb = 0; mb < 2; ++mb)
#pragma unroll
                  for (int rg = 0; rg < 4; ++rg) ((GAS unsigned short*)sp)[(size_t)(32 * vq + 16 * mb + 4 * (lane >> 4) + rg) * 128 + 16 * wave + (lane & 15)] = (unsigned short)f2bf(acc[mb][rg]); }
            __syncthreads();
#pragma unroll
            for (int mb = 0; mb < 2; ++mb) acc[mb] = acc[mb] * dc;
#pragma unroll
            for (int ks = 0; ks < 4; ++ks) { const bf16x8 bk = frag_tr(kimg, lane, wave, ks);
#pragma unroll
                for (int mb = 0; mb < 2; ++mb) { const bf16x8 av = frag_tr(vimg, lane, 2 * vq + mb, ks); acc[mb] = __builtin_amdgcn_mfma_f32_16x16x32_bf16(av, bk, acc[mb], 0, 0, 0); } }
        }
#undef RET_LOADKV
        __syncthreads();
    }
}
__device__ __forceinline__ void p3_retention_out(Frame& F) {
    const bf16* PROJ = (const bf16*)(F.ws + WS_PROJ); const bf16* ST = (const bf16*)(F.ws + WS_ST); bf16* MIX = (bf16*)(F.ws + WS_MIX);
    const float* gn_g = F.in[2]; const float* gn_b = F.in[3];
    int tid = F.tid; asm volatile("" : "+v"(tid)); const int lane = tid & 63, w = F.wave, g = lane >> 4, ln = lane & 15;
    LAS unsigned char* qimg = F.lds + RING_OFF; LAS unsigned char* kimg = qimg + 32768; LAS unsigned char* vimg = qimg + 65536; LAS unsigned char* pimg = qimg + 98304;
#pragma unroll 1
    for (int it = F.vcu; it < BATCH * 4 * 16; it += F.G) {
        const int bh = it >> 4, c = it & 15, b = bh >> 2, h = bh & 3;
        const float l2g = log2f(1.f - exp2f(-5.f - (float)h));
        const size_t rb0 = (size_t)b * SEQ + c * 128;
#pragma unroll
        for (int q = 0; q < 4; ++q) { const int id = tid + 512 * q, row = id >> 4, ch = id & 15; const bf16* pr = PROJ + (rb0 + row) * NPROJ + h * 128 + ch * 8; const unsigned o = offb((unsigned)row, (unsigned)ch);
            *(LAS v4u*)(qimg + o) = *(const GAS v4u*)(pr + C_RQ); *(LAS v4u*)(kimg + o) = *(const GAS v4u*)(pr + C_RK); *(LAS v4u*)(vimg + o) = *(const GAS v4u*)(pr + C_RV); }
        __syncthreads();
        bf16x8 qf[4];
#pragma unroll
        for (int s4 = 0; s4 < 4; ++s4) qf[s4] = frag_row(qimg, lane, w, s4);
        f32x4 oacc[8];
        { const bf16* sp = ST + ((size_t)(bh * 16 + c) * 128 + ln) * 128 + 8 * g;
#pragma unroll
          for (int nb = 0; nb < 8; ++nb) { oacc[nb] = (f32x4){0.f, 0.f, 0.f, 0.f};
#pragma unroll
              for (int s4 = 0; s4 < 4; ++s4) oacc[nb] = __builtin_amdgcn_mfma_f32_16x16x32_bf16(qf[s4], *(const GAS bf16x8*)(sp + (size_t)(16 * nb) * 128 + 32 * s4), oacc[nb], 0, 0, 0); } }
        { float dq[4];
#pragma unroll
          for (int rg = 0; rg < 4; ++rg) dq[rg] = exp2f((float)(16 * w + 4 * g + rg + 1) * l2g);
#pragma unroll
          for (int nb = 0; nb < 8; ++nb)
#pragma unroll
              for (int rg = 0; rg < 4; ++rg) oacc[nb][rg] *= dq[rg]; }
        { const float el = exp2f((float)(ln - 4 * g) * l2g); float fr[4];
#pragma unroll
          for (int rg = 0; rg < 4; ++rg) fr[rg] = el * exp2f(-(float)rg * l2g);
          typedef unsigned u2_t __attribute__((ext_vector_type(2)));
#pragma unroll 1
          for (int jb = 0; jb <= w; ++jb) {
              f32x4 sacc = (f32x4){0.f, 0.f, 0.f, 0.f};
#pragma unroll
              for (int s4 = 0; s4 < 4; ++s4) sacc = __builtin_amdgcn_mfma_f32_16x16x32_bf16(frag_row(kimg, lane, jb, s4), qf[s4], sacc, 0, 0, 0);
              const float fb = exp2f((float)(16 * (w - jb)) * l2g); float p4[4];
#pragma unroll
              for (int rg = 0; rg < 4; ++rg) { const int dlt = 16 * (w - jb) + ln - 4 * g - rg; p4[rg] = dlt >= 0 ? sacc[rg] * (fb * fr[rg]) : 0.f; }
              u2_t pk; pk.x = pk2(p4[0], p4[1]); pk.y = pk2(p4[2], p4[3]);
              *(LAS u2_t*)(pimg + offb((unsigned)(16 * w + ln), (unsigned)(2 * jb + (g >> 1))) + 8 * (g & 1)) = pk; }
          if ((w & 1) == 0) { u2_t z; z.x = 0u; z.y = 0u; *(LAS u2_t*)(pimg + offb((unsigned)(16 * w + ln), (unsigned)(2 * (w + 1) + (g >> 1))) + 8 * (g & 1)) = z; } }
        LDS_WAIT(); asm volatile("" ::: "memory");
#pragma unroll 1
        for (int ks = 0; ks <= (w >> 1); ++ks) { const bf16x8 pa = frag_row(pimg, lane, w, ks);
#pragma unroll
            for (int nb = 0; nb < 8; ++nb) oacc[nb] = __builtin_amdgcn_mfma_f32_16x16x32_bf16(pa, frag_tr(vimg, lane, nb, ks), oacc[nb], 0, 0, 0); }
        float mu[4], rs[4];
#pragma unroll
        for (int rg = 0; rg < 4; ++rg) { float sm = 0.f;
#pragma unroll
            for (int nb = 0; nb < 8; ++nb) sm += oacc[nb][rg];
            sm += __shfl_xor(sm, 1); sm += __shfl_xor(sm, 2); sm += __shfl_xor(sm, 4); sm += __shfl_xor(sm, 8); mu[rg] = sm * (1.f / 128.f);
            float q2 = 0.f;
#pragma unroll
            for (int nb = 0; nb < 8; ++nb) { const float dl = oacc[nb][rg] - mu[rg]; q2 += dl * dl; }
            q2 += __shfl_xor(q2, 1); q2 += __shfl_xor(q2, 2); q2 += __shfl_xor(q2, 4); q2 += __shfl_xor(q2, 8); rs[rg] = 1.f / sqrtf(q2 * (1.f / 128.f) + LN_EPS); }
#pragma unroll
        for (int nb = 0; nb < 8; ++nb) { const int ch = h * 128 + 16 * nb + ln; const float gg = gn_g[ch], gb = gn_b[ch];
#pragma unroll
            for (int rg = 0; rg < 4; ++rg) { const size_t row = rb0 + 16 * w + 4 * g + rg;
                const float gate = bf2f(((const GAS unsigned short*)PROJ)[row * NPROJ + C_RG + ch]);
                ((GAS unsigned short*)MIX)[row * D + ch] = (unsigned short)f2bf(gate * ((oacc[nb][rg] - mu[rg]) * rs[rg] * gg + gb)); } }
        __syncthreads();
    }
}
struct DiffUnit { int b, h, qb, c, hf; };
struct DiffOrder {
    int pu;
    __device__ __forceinline__ bool next(int i, DiffUnit& u) const { if (i >= 8) return false; const int bh = pu >> 2, s = pu & 3; u.b = bh >> 2; u.h = bh & 3; u.qb = (i >> 2) ? s : 7 - s; u.c = (i >> 1) & 1; u.hf = i & 1; return true; }
};
__device__ __forceinline__ void diff_combine(Frame& F, const DiffUnit& u) {
    VM_WAIT();
    const float lam = diff_lambda(F);
    const float* sg = F.in[8] + u.h * 128 + 2 * F.lane;
    const float g0 = sg[0], g1 = sg[1];
    const size_t row0 = (size_t)u.b * SEQ + u.qb * 256 + F.wave * 32;
    const GAS unsigned* op = (const GAS unsigned*)((const bf16*)(F.ws + WS_DOUT) + row0 * 1024 + u.h * 256) + F.lane;
    GAS unsigned* mp = (GAS unsigned*)((bf16*)(F.ws + WS_MIX) + row0 * D + 512 + u.h * 128) + F.lane;
#pragma unroll 4
    for (int r = 0; r < 32; ++r) {
        const unsigned w1 = op[r * 512], w2 = op[r * 512 + 64];
        const float d0 = bflo(w1) - lam * bflo(w2), d1 = bfhi(w1) - lam * bfhi(w2);
        const float ms = wave_sum(d0 * d0 + d1 * d1) * (1.f / 128.f);
        const float rs = (1.f - LAMBDA_INIT) / sqrtf(ms + LN_EPS);
        mp[r * 512] = pk2(d0 * rs * g0, d1 * rs * g1);
    }
}
template <class Sched> __device__ __forceinline__ void diff_phase(Frame& F, char* lds, const attn_body::bf16* P, attn_body::bf16* O, const Sched& S) {
    DiffUnit u;
    for (int i = 0; S.next(i, u); ++i) { const attn_body::bf16* Ph = P + u.h * 128;
        attn_body::attn_unit<8>(u.b, u.qb, Ph + C_DQ + u.c * 64, Ph + C_DK + u.c * 64, Ph + C_DV + u.hf * 64, O + u.h * 256 + u.c * 128 + u.hf * 64, lds);
    }
}
__device__ __forceinline__ void p2_diffattn(Frame& F, char* lds_generic) {
    const DiffOrder S{F.vcu};
    diff_phase<DiffOrder>(F, lds_generic, (const attn_body::bf16*)(F.ws + WS_PROJ), (attn_body::bf16*)(F.ws + WS_DOUT), S);
    DiffUnit u;
    S.next(3, u); diff_combine(F, u);
    S.next(7, u); diff_combine(F, u);
}
__device__ __forceinline__ void p3_ln1_rows(Frame& F) {
    const float* Y = F.out; bf16* X1 = (bf16*)(F.ws + WS_X1); const float* g = F.in[10]; const float* bb = F.in[11];
    const int gw = (int)blockIdx.x * NWAVES + F.wave, NGW = F.G * NWAVES;
    for (int m = gw; m < M; m += NGW) {
        const GAS f32x4* xr = (const GAS f32x4*)(Y + (size_t)m * D) + F.lane;
        f32x4 v[4]; float s = 0.f;
#pragma unroll
        for (int j = 0; j < 4; ++j) { v[j] = xr[64 * j]; s += (v[j].x + v[j].y) + (v[j].z + v[j].w); }
        const float mean = wave_sum(s) * (1.f / D); float s2 = 0.f;
#pragma unroll
        for (int j = 0; j < 4; ++j) { v[j] = v[j] - mean; s2 += (v[j].x * v[j].x + v[j].y * v[j].y) + (v[j].z * v[j].z + v[j].w * v[j].w); }
        const float rstd = 1.f / sqrtf(wave_sum(s2) * (1.f / D) + LN_EPS);
        GAS unsigned long long* o8 = (GAS unsigned long long*)(X1 + (size_t)m * D) + F.lane;
#pragma unroll
        for (int j = 0; j < 4; ++j) { const f32x4 gg = ((const GAS f32x4*)g)[F.lane + 64 * j], bv = ((const GAS f32x4*)bb)[F.lane + 64 * j]; const f32x4 r = v[j] * rstd * gg + bv;
            o8[64 * j] = (unsigned long long)pk2(r.x, r.y) | ((unsigned long long)pk2(r.z, r.w) << 32); }
    }
}

__device__ __forceinline__ void argmax_step(float& v, int& i) {
#pragma unroll
    for (int o = 1; o < 64; o <<= 1) { const float ov = __shfl_xor(v, o); const int oi = __shfl_xor(i, o); if (ov > v || (ov == v && oi < i)) { v = ov; i = oi; } }
}
__device__ __forceinline__ void p5_topk_naive(Frame& F) {
    const bf16* QP = (const bf16*)(F.ws + WS_QP); const bf16* SK = (const bf16*)(F.ws + WS_SK);
    int* IDX = (int*)(F.ws + WS_IDX); float* GATE = (float*)(F.ws + WS_GATE);
    const int gw = (int)blockIdx.x * NWAVES + F.wave, NGW = F.G * NWAVES; const int lane = F.lane;
    for (int task = gw; task < M * 8; task += NGW) {
        const int t = task >> 3, h = task & 7;
        float ts[2]; int ti[2];
#pragma unroll
        for (int c = 0; c < 2; ++c) {
            const GAS v4u* qp = (const GAS v4u*)(QP + (size_t)t * NQ + h * 256 + c * 128);
            const GAS v4u* k0p = (const GAS v4u*)(SK + ((size_t)(h * 2 + c) * 128 + lane) * 128);
            const GAS v4u* k1p = (const GAS v4u*)(SK + ((size_t)(h * 2 + c) * 128 + lane + 64) * 128);
            float s0 = 0.f, s1 = 0.f;
#pragma unroll
            for (int d = 0; d < 16; ++d) { const v4u q = qp[d]; s0 = dot8(q, k0p[d], s0); s1 = dot8(q, k1p[d], s1); }
            float mys = 0.f; int myi = 0;
            for (int r = 0; r < 16; ++r) {
                float v = fmaxf(s0, s1); int ix = (s0 >= s1) ? lane : lane + 64;
                argmax_step(v, ix);
                if (lane == r) { mys = v; myi = ix; }
                if ((ix & 63) == lane) { if (ix < 64) s0 = -INFINITY; else s1 = -INFINITY; }
            }
            ts[c] = mys; ti[c] = myi;
        }
        float cs[4]; int ci[4];
#pragma unroll
        for (int q = 0; q < 4; ++q) { const int a = (lane >> 4) + 4 * q, bq = lane & 15; cs[q] = __shfl(ts[0], a) + __shfl(ts[1], bq); ci[q] = __shfl(ti[0], a) * 128 + __shfl(ti[1], bq); }
        float bs = 0.f; int be = 0;
        {
            LAS float* bsl = (LAS float*)(F.lds + RING_OFF) + F.wave * 32; LAS int* bel = (LAS int*)(bsl + 16);
            int rk[4] = {0, 0, 0, 0};
            for (int k = 0; k < 64; ++k) {
#pragma unroll
                for (int qq = 0; qq < 4; ++qq) { const float av = __shfl(cs[qq], k); const int an = k + 64 * qq;
#pragma unroll
                    for (int q = 0; q < 4; ++q) { const int n = lane + 64 * q; rk[q] += (av > cs[q] || (av == cs[q] && an < n)) ? 1 : 0; } } }
#pragma unroll
            for (int q = 0; q < 4; ++q) if (rk[q] < 16) { bsl[rk[q]] = cs[q]; bel[rk[q]] = ci[q]; }
            LDS_WAIT(); asm volatile("" ::: "memory");
            bs = bsl[lane & 15]; be = bel[lane & 15];
            LDS_WAIT(); asm volatile("" ::: "memory");
        }
        const float mx = __shfl(bs, 0);
        float ex = expf(bs - mx); float sm = ex;
        sm += __shfl_xor(sm, 1); sm += __shfl_xor(sm, 2); sm += __shfl_xor(sm, 4); sm += __shfl_xor(sm, 8);
        if (lane < 16) { IDX[(size_t)t * NSEL + h * 16 + lane] = be; GATE[(size_t)t * NSEL + h * 16 + lane] = ex / sm; }
    }
}

__device__ __forceinline__ void unpack8(v4u w, float* f) { f[0] = bflo(w.x); f[1] = bfhi(w.x); f[2] = bflo(w.y); f[3] = bfhi(w.y); f[4] = bflo(w.z); f[5] = bfhi(w.z); f[6] = bflo(w.w); f[7] = bfhi(w.w); }
__device__ __forceinline__ void p6_experts_naive(Frame& F) {
    const bf16* X1 = (const bf16*)(F.ws + WS_X1); const bf16* PU = (const bf16*)(F.ws + WS_PU); const bf16* PV = (const bf16*)(F.ws + WS_PV);
    const int* IDX = (const int*)(F.ws + WS_IDX); const float* GATE = (const float*)(F.ws + WS_GATE);
    const float* g2 = F.in[16]; const float* b2 = F.in[17];
    const int gw = (int)blockIdx.x * NWAVES + F.wave, NGW = F.G * NWAVES; const int lane = F.lane;
    for (int t = gw; t < M; t += NGW) {
        float x[16], acc[16];
        { const GAS v4u* xp = (const GAS v4u*)(X1 + (size_t)t * D); unpack8(xp[lane], x); unpack8(xp[64 + lane], x + 8); }
#pragma unroll
        for (int k = 0; k < 16; ++k) acc[k] = 0.f;
#pragma unroll 2
        for (int e = 0; e < NSEL; ++e) {
            const int idx = IDX[(size_t)t * NSEL + e]; const float gt = GATE[(size_t)t * NSEL + e];
            const GAS v4u* up = (const GAS v4u*)(PU + (size_t)idx * D); const GAS v4u* vp = (const GAS v4u*)(PV + (size_t)idx * D);
            const v4u u0 = up[lane], u1 = up[64 + lane], v0 = vp[lane], v1 = vp[64 + lane];
            float uf[16]; unpack8(u0, uf); unpack8(u1, uf + 8);
            float s = 0.f;
#pragma unroll
            for (int k = 0; k < 16; ++k) s = fmaf(x[k], uf[k], s);
            s = wave_sum(s);
            const float w = gt * 0.5f * s * (1.f + erff(s * 0.7071067811865476f));
            float vf[16]; unpack8(v0, vf); unpack8(v1, vf + 8);
#pragma unroll
            for (int k = 0; k < 16; ++k) acc[k] = fmaf(w, vf[k], acc[k]);
        }
        float sm = 0.f;
#pragma unroll
        for (int k = 0; k < 16; ++k) { acc[k] = fmaf(ALPHA, x[k], acc[k]); sm += acc[k]; }
        const float mean = wave_sum(sm) * (1.f / D); float q2 = 0.f;
#pragma unroll
        for (int k = 0; k < 16; ++k) { acc[k] -= mean; q2 += acc[k] * acc[k]; }
        const float rstd = 1.f / sqrtf(wave_sum(q2) * (1.f / D) + LN_EPS);
        GAS f32x4* op = (GAS f32x4*)(F.out + (size_t)t * D);
#pragma unroll
        for (int hf = 0; hf < 2; ++hf)
#pragma unroll
            for (int q4 = 0; q4 < 2; ++q4) { const int c0 = hf * 512 + lane * 8 + q4 * 4; const f32x4 gg = *(const GAS f32x4*)(g2 + c0), bv = *(const GAS f32x4*)(b2 + c0);
                f32x4 r; r.x = acc[hf * 8 + q4 * 4 + 0] * rstd * gg.x + bv.x; r.y = acc[hf * 8 + q4 * 4 + 1] * rstd * gg.y + bv.y; r.z = acc[hf * 8 + q4 * 4 + 2] * rstd * gg.z + bv.z; r.w = acc[hf * 8 + q4 * 4 + 3] * rstd * gg.w + bv.w;
                op[c0 / 4] = r; }
    }
}


typedef float f32x16_t __attribute__((ext_vector_type(16)));
__device__ __forceinline__ int enc_key(float f) { const int u = __builtin_bit_cast(int, f); return u ^ ((u >> 31) & 0x7fffffff); }
__device__ __forceinline__ float dec_key(int k) { return __builtin_bit_cast(float, k ^ ((k >> 31) & 0x7fffffff)); }
__device__ __forceinline__ int pair_max(int m) { const auto rr = __builtin_amdgcn_permlane32_swap((unsigned)m, (unsigned)m, false, false); const int a = (int)rr[0], b = (int)rr[1]; return a > b ? a : b; }
__device__ __forceinline__ void p5_topk_fast(Frame& F) {
    constexpr int PI[50] = {0, 0, 0, 0, 0, 0, 0, 0, 0, 0, 0, 0, 0, 0, 0, 0, 1, 1, 1, 1, 1, 1, 1, 1, 2, 2, 2, 2, 2, 3, 3, 3, 3, 4, 4, 4, 5, 5, 6, 6, 7, 7, 8, 9, 10, 11, 12, 13, 14, 15};
    constexpr int PJ[50] = {0, 1, 2, 3, 4, 5, 6, 7, 8, 9, 10, 11, 12, 13, 14, 15, 0, 1, 2, 3, 4, 5, 6, 7, 0, 1, 2, 3, 4, 0, 1, 2, 3, 0, 1, 2, 0, 1, 0, 1, 0, 1, 0, 0, 0, 0, 0, 0, 0, 0};
    const bf16* QP = (const bf16*)(F.ws + WS_QP); const bf16* SK = (const bf16*)(F.ws + WS_SK);
    int* IDX = (int*)(F.ws + WS_IDX); float* GATE = (float*)(F.ws + WS_GATE);
    LAS unsigned char* skl = F.lds + RING_OFF;
    const int h = F.vcu & 7;
    for (int n = F.tid; n < 4096; n += NWAVES * 64) { const unsigned row = (unsigned)n >> 4, ch = (unsigned)n & 15u;
        const v4u v = *(const GAS v4u*)(SK + ((size_t)h * 256 + row) * 128 + ch * 8); *(LAS v4u*)(skl + offb(row, ch)) = v; }
    __syncthreads();
    LAS int* TOP = (LAS int*)(F.lds + RING_OFF + 65536 + F.wave * 4096);
    LAS unsigned short* EIDX = (LAS unsigned short*)TOP;
    LAS int* WIN = (LAS int*)(F.lds + RING_OFF + 98304 + F.wave * 2048);
    const int lane = F.lane, tok = lane & 31, hi = lane >> 5;
    const int IMIN = (int)0x80000000;
#pragma unroll 1
    for (int tile = F.vcu >> 3; tile < M / 256; tile += F.G >> 3) {
        const size_t token = (size_t)tile * 256 + F.wave * 32 + tok;
#pragma unroll 1
        for (int c = 0; c < 2; ++c) {
            f32x16_t acc[4];
#pragma unroll
            for (int kb = 0; kb < 4; ++kb) acc[kb] = f32x16_t{};
            const bf16* qrow = QP + token * NQ + h * 256 + c * 128 + 8 * hi;
#pragma unroll
            for (int sst = 0; sst < 8; ++sst) { const bf16x8 bq = *(const GAS bf16x8*)(qrow + 16 * sst);
#pragma unroll
                for (int kb = 0; kb < 4; ++kb) { const bf16x8 a = *(const LAS bf16x8*)(skl + offb((unsigned)(c * 128 + 32 * kb + tok), (unsigned)(2 * sst + hi)));
                    acc[kb] = __builtin_amdgcn_mfma_f32_32x32x16_bf16(a, bq, acc[kb], 0, 0, 0); } }
            int k[64];
#pragma unroll
            for (int kb = 0; kb < 4; ++kb)
#pragma unroll
                for (int r = 0; r < 16; ++r) { const int kidx = 32 * kb + (r & 3) + 8 * (r >> 2) + 4 * hi; k[kb * 16 + r] = (enc_key(acc[kb][r]) & ~127) | (127 - kidx); }
            int prev = 0x7fffffff;
#pragma unroll 1
            for (int r = 0; r < 16; ++r) {
                int m = IMIN;
#pragma unroll
                for (int i = 0; i < 64; ++i) { const int t = k[i] < prev ? k[i] : IMIN; m = t > m ? t : m; }
                m = pair_max(m);
                TOP[(c * 16 + r) * 32 + tok] = m;
                prev = m;
            }
        }
        LDS_WAIT(); asm volatile("" ::: "memory");
        int a[16], b[16]; float af[16], bf_[16];
#pragma unroll
        for (int i = 0; i < 16; ++i) { a[i] = TOP[i * 32 + tok]; b[i] = TOP[(16 + i) * 32 + tok]; }
        LDS_WAIT(); asm volatile("" ::: "memory");
#pragma unroll
        for (int i = 0; i < 16; ++i) { af[i] = dec_key(a[i] & ~127); bf_[i] = dec_key(b[i] & ~127); a[i] = 127 - (a[i] & 127); b[i] = 127 - (b[i] & 127); }
        int ck[25];
#pragma unroll
        for (int n = 0; n < 25; ++n) { const int i0 = PI[2 * n], j0 = PJ[2 * n], i1 = PI[2 * n + 1], j1 = PJ[2 * n + 1];
            const float s0 = af[i0] + bf_[j0], s1 = af[i1] + bf_[j1]; const int e0 = a[i0] * 128 + b[j0], e1 = a[i1] * 128 + b[j1];
            const float sv = hi ? s1 : s0; const int ev = hi ? e1 : e0; const int id = 2 * n + hi;
            ck[n] = (enc_key(sv) & ~63) | (63 - id); EIDX[tok * 64 + id] = (unsigned short)ev; }
        int prev = 0x7fffffff;
#pragma unroll 1
        for (int r = 0; r < 16; ++r) {
            int m = IMIN;
#pragma unroll
            for (int i = 0; i < 25; ++i) { const int t = ck[i] < prev ? ck[i] : IMIN; m = t > m ? t : m; }
            m = pair_max(m);
            WIN[r * 32 + tok] = m;
            prev = m;
        }
        LDS_WAIT(); asm volatile("" ::: "memory");
        int w[16]; float e[16];
#pragma unroll
        for (int r = 0; r < 16; ++r) w[r] = WIN[r * 32 + tok];
        LDS_WAIT(); asm volatile("" ::: "memory");
        const float mx = dec_key(w[0] & ~63); float sm = 0.f;
#pragma unroll
        for (int r = 0; r < 16; ++r) { e[r] = __builtin_amdgcn_exp2f((dec_key(w[r] & ~63) - mx) * 1.4426950408889634f); sm += e[r]; }
        const float inv = 1.f / sm;
        int oi[8]; float og[8];
#pragma unroll
        for (int q = 0; q < 8; ++q) { const int wq = hi ? w[8 + q] : w[q]; const float eq = hi ? e[8 + q] : e[q]; oi[q] = (int)EIDX[tok * 64 + (63 - (wq & 63))]; og[q] = eq * inv; }
        LDS_WAIT(); asm volatile("" ::: "memory");
        int* ip = IDX + token * NSEL + h * 16 + 8 * hi; float* gp = GATE + token * NSEL + h * 16 + 8 * hi;
        typedef int i32x4 __attribute__((ext_vector_type(4)));
        *(GAS i32x4*)ip = (i32x4){oi[0], oi[1], oi[2], oi[3]}; *(GAS i32x4*)(ip + 4) = (i32x4){oi[4], oi[5], oi[6], oi[7]};
        *(GAS f32x4*)gp = (f32x4){og[0], og[1], og[2], og[3]}; *(GAS f32x4*)(gp + 4) = (f32x4){og[4], og[5], og[6], og[7]};
    }
    __syncthreads();
}
typedef __bf16 bf16x2_t __attribute__((ext_vector_type(2)));
__device__ __forceinline__ float dot2bf(unsigned a, unsigned b, float c) { return __builtin_amdgcn_fdot2_f32_bf16(__builtin_bit_cast(bf16x2_t, a), __builtin_bit_cast(bf16x2_t, b), c, false); }
__device__ __forceinline__ float dot8p(v4u a, v4u b, float s) { s = dot2bf(a.x, b.x, s); s = dot2bf(a.y, b.y, s); s = dot2bf(a.z, b.z, s); return dot2bf(a.w, b.w, s); }
__device__ __forceinline__ float gelu_erf(float v) {
    const float av = fabsf(v), t = __builtin_amdgcn_rcpf(fmaf(av, 0.2316418882f, 1.0f));
    float q = fmaf(t, 0.5307027145f, -0.7265760135f); q = fmaf(q, t, 0.7107068705f); q = fmaf(q, t, -0.142248368f); q = fmaf(q, t, 0.127414796f); q = q * t;
    const float e = __builtin_amdgcn_exp2f(v * v * -0.72134752044f);
    const float m = v * (q * e);
    return v < 0.f ? m : v - m;
}
#define ACC8(A, W, S, O) do { A[O + 0] = fmaf(S, bflo(W.x), A[O + 0]); A[O + 1] = fmaf(S, bfhi(W.x), A[O + 1]); A[O + 2] = fmaf(S, bflo(W.y), A[O + 2]); A[O + 3] = fmaf(S, bfhi(W.y), A[O + 3]); \
                               A[O + 4] = fmaf(S, bflo(W.z), A[O + 4]); A[O + 5] = fmaf(S, bfhi(W.z), A[O + 5]); A[O + 6] = fmaf(S, bflo(W.w), A[O + 6]); A[O + 7] = fmaf(S, bfhi(W.w), A[O + 7]); } while (0)
typedef float f32x2_t __attribute__((ext_vector_type(2)));
__device__ __forceinline__ float dot16_fp8(const f32x2_t (&x2)[8], v4u w) {
    f32x2_t a = x2[0] * __builtin_amdgcn_cvt_pk_f32_fp8((int)w.x, false);
    a = x2[1] * __builtin_amdgcn_cvt_pk_f32_fp8((int)w.x, true) + a;
    a = x2[2] * __builtin_amdgcn_cvt_pk_f32_fp8((int)w.y, false) + a; a = x2[3] * __builtin_amdgcn_cvt_pk_f32_fp8((int)w.y, true) + a;
    a = x2[4] * __builtin_amdgcn_cvt_pk_f32_fp8((int)w.z, false) + a; a = x2[5] * __builtin_amdgcn_cvt_pk_f32_fp8((int)w.z, true) + a;
    a = x2[6] * __builtin_amdgcn_cvt_pk_f32_fp8((int)w.w, false) + a; a = x2[7] * __builtin_amdgcn_cvt_pk_f32_fp8((int)w.w, true) + a;
    return a.x + a.y;
}
__device__ __forceinline__ void axpy16_fp8(f32x2_t (&acc)[8], float wk, v4u w) {
    const f32x2_t w2 = (f32x2_t){wk, wk};
    acc[0] = w2 * __builtin_amdgcn_cvt_pk_f32_fp8((int)w.x, false) + acc[0]; acc[1] = w2 * __builtin_amdgcn_cvt_pk_f32_fp8((int)w.x, true) + acc[1];
    acc[2] = w2 * __builtin_amdgcn_cvt_pk_f32_fp8((int)w.y, false) + acc[2]; acc[3] = w2 * __builtin_amdgcn_cvt_pk_f32_fp8((int)w.y, true) + acc[3];
    acc[4] = w2 * __builtin_amdgcn_cvt_pk_f32_fp8((int)w.z, false) + acc[4]; acc[5] = w2 * __builtin_amdgcn_cvt_pk_f32_fp8((int)w.z, true) + acc[5];
    acc[6] = w2 * __builtin_amdgcn_cvt_pk_f32_fp8((int)w.w, false) + acc[6]; acc[7] = w2 * __builtin_amdgcn_cvt_pk_f32_fp8((int)w.w, true) + acc[7];
}
__device__ __forceinline__ void p6_experts(Frame& F) {
    const bf16* X1 = (const bf16*)(F.ws + WS_X1); const unsigned char* PU = F.ws + WS_PU; const unsigned char* PV = F.ws + WS_PV;
    const float* SU = (const float*)(F.ws + WS_SU); const float* SV = (const float*)(F.ws + WS_SV);
    const int* IDX = (const int*)(F.ws + WS_IDX); const float* GATE = (const float*)(F.ws + WS_GATE);
    const float* g2 = F.in[16]; const float* b2 = F.in[17];
    const int gw = (int)blockIdx.x * NWAVES + F.wave, NGW = F.G * NWAVES;
    const int e_of_lane = (F.lane >> 3) & 7; const bool h5 = F.lane >= 32, h4 = (F.lane >> 4) & 1, h3 = (F.lane >> 3) & 1;
#pragma unroll 1
    for (int t = gw; t < M; t += NGW) {
        int lane = F.lane; asm volatile("" : "+v"(lane));
        f32x2_t x2[8];
        { const GAS v4u* xp = (const GAS v4u*)(X1 + (size_t)t * D) + 2 * lane; const v4u xa = xp[0], xb = xp[1];
          x2[0] = (f32x2_t){bflo(xa.x), bfhi(xa.x)}; x2[1] = (f32x2_t){bflo(xa.y), bfhi(xa.y)}; x2[2] = (f32x2_t){bflo(xa.z), bfhi(xa.z)}; x2[3] = (f32x2_t){bflo(xa.w), bfhi(xa.w)};
          x2[4] = (f32x2_t){bflo(xb.x), bfhi(xb.x)}; x2[5] = (f32x2_t){bflo(xb.y), bfhi(xb.y)}; x2[6] = (f32x2_t){bflo(xb.z), bfhi(xb.z)}; x2[7] = (f32x2_t){bflo(xb.w), bfhi(xb.w)}; }
        const int ilo = IDX[(size_t)t * NSEL + lane], ihi = IDX[(size_t)t * NSEL + 64 + lane];
        const float glo = GATE[(size_t)t * NSEL + lane], ghi = GATE[(size_t)t * NSEL + 64 + lane];
        f32x2_t acc[8];
#pragma unroll
        for (int k = 0; k < 8; ++k) acc[k] = (f32x2_t){0.f, 0.f};
        v4u ur[8], vr[8];
#pragma unroll
        for (int k = 0; k < 8; ++k) { const int idx = __builtin_amdgcn_readlane(ilo, k); ur[k] = ((const GAS v4u*)(PU + (size_t)idx * D))[lane]; vr[k] = ((const GAS v4u*)(PV + (size_t)idx * D))[lane]; }
#pragma unroll 1
        for (int bb = 0; bb < 16; ++bb) {
            float s[8];
#pragma unroll
            for (int k = 0; k < 8; ++k) s[k] = dot16_fp8(x2, ur[k]);
            const int nb = bb + 1; const int isrc_n = nb < 8 ? ilo : ihi;
            if (nb < 16) {
#pragma unroll
                for (int k = 0; k < 8; ++k) { const int idx = __builtin_amdgcn_readlane(isrc_n, (nb & 7) * 8 + k); ur[k] = ((const GAS v4u*)(PU + (size_t)idx * D))[lane]; }
            }
            float r4[4], r2[2], z;
#pragma unroll
            for (int i = 0; i < 4; ++i) { const float send = h5 ? s[i] : s[i + 4], keep = h5 ? s[i + 4] : s[i]; r4[i] = keep + __shfl_xor(send, 32); }
#pragma unroll
            for (int i = 0; i < 2; ++i) { const float send = h4 ? r4[i] : r4[i + 2], keep = h4 ? r4[i + 2] : r4[i]; r2[i] = keep + __shfl_xor(send, 16); }
            { const float send = h3 ? r2[0] : r2[1], keep = h3 ? r2[1] : r2[0]; z = keep + __shfl_xor(send, 8); }
            z += __shfl_xor(z, 4); z += __shfl_xor(z, 2); z += __shfl_xor(z, 1);
            const int isrc = bb < 8 ? ilo : ihi; const float gsrc = bb < 8 ? glo : ghi;
            const int my_idx = __shfl(isrc, (bb & 7) * 8 + e_of_lane);
            const float w = __shfl(gsrc, (bb & 7) * 8 + e_of_lane) * gelu_erf(z * SU[my_idx]) * SV[my_idx];
#pragma unroll
            for (int k = 0; k < 8; ++k) { const float wk = __builtin_bit_cast(float, __builtin_amdgcn_readlane(__builtin_bit_cast(int, w), 8 * k)); axpy16_fp8(acc, wk, vr[k]); }
            if (nb < 16) {
#pragma unroll
                for (int k = 0; k < 8; ++k) { const int idx = __builtin_amdgcn_readlane(isrc_n, (nb & 7) * 8 + k); vr[k] = ((const GAS v4u*)(PV + (size_t)idx * D))[lane]; }
            }
        }
        float sm = 0.f;
#pragma unroll
        for (int k = 0; k < 8; ++k) { acc[k] = x2[k] * ALPHA + acc[k]; sm += acc[k].x + acc[k].y; }
        const float mean = wave_sum(sm) * (1.f / D); float q2 = 0.f;
#pragma unroll
        for (int k = 0; k < 8; ++k) { acc[k] = acc[k] - mean; q2 += acc[k].x * acc[k].x + acc[k].y * acc[k].y; }
        const float rstd = 1.f / sqrtf(wave_sum(q2) * (1.f / D) + LN_EPS);
        GAS f32x4* op = (GAS f32x4*)(F.out + (size_t)t * D) + 4 * lane;
#pragma unroll
        for (int j = 0; j < 4; ++j) { const f32x4 gg = ((const GAS f32x4*)g2)[4 * lane + j], bv = ((const GAS f32x4*)b2)[4 * lane + j];
            f32x4 r; r.x = acc[2 * j].x * rstd * gg.x + bv.x; r.y = acc[2 * j].y * rstd * gg.y + bv.y; r.z = acc[2 * j + 1].x * rstd * gg.z + bv.z; r.w = acc[2 * j + 1].y * rstd * gg.w + bv.w;
            op[j] = r; }
    }
}
struct Args { const float* in[18]; float* out; unsigned char* ws; };
__global__ void __launch_bounds__(NWAVES * 64, 2) hymba_fwd(Args args) {
    extern __shared__ __attribute__((aligned(16))) unsigned char lds[];
    Frame F;
    F.lds = (LAS unsigned char*)lds;
    F.MISC = (volatile LAS unsigned*)(F.lds + MISC_OFF);
    F.tid = threadIdx.x; F.lane = F.tid & 63; F.wave = __builtin_amdgcn_readfirstlane(F.tid >> 6);
    F.G = gridDim.x; { const int bx = blockIdx.x; F.vcu = (F.G % 8 == 0) ? (bx % 8) * (F.G / 8) + bx / 8 : bx; }
    unsigned char* ws = args.ws; F.ws = ws; F.out = args.out;
    F.ctl = (gu32*)(ws + WS_CTL);
    F.in = args.in;
    for (int u = F.tid; u < (LDS_BYTES - LDSCTL_OFF) / 4; u += NWAVES * 64) ((LAS unsigned*)(F.lds + LDSCTL_OFF))[u] = 0u;
    __syncthreads();
    (void)xcd_barrier_post((unsigned*)F.ws + CW_BAR, F.MISC + 8);
#ifndef PHASE_MASK
#define PHASE_MASK 0xffff
#endif
#define IN(k) ((PHASE_MASK >> (k)) & 1)
#define BOTH(k) (IN(k) && IN((k) + 1))
#define GRID_BAR() do { XcdBarrier b_; b_.bar = (unsigned*)F.ws + CW_BAR; b_.x = xb_xcc_id(); b_.st = F.MISC + 8; xcd_barrier(b_); PHASE_FENCE(); } while (0)
#define PHASE_FENCE() do { asm volatile("" : "+v"(F.tid)); F.lane = F.tid & 63; } while (0)

    if (IN(0)) { p0_prologue(F); if (BOTH(0)) GRID_BAR(); }
    if (IN(1)) {
        pg8::Gemm g{(const bf16*)(ws + WS_XB), (const bf16*)(ws + WS_WIN), M, NPROJ, D}; pg8::StaticOrder S; S.init(M, NPROJ, F.G, (int)blockIdx.x);
        pg8::EpiProj E{(bf16*)(ws + WS_PROJ), NPROJ, (const float*)(ws + WS_ROPE), KSCALE, QSCALE};
        pg8::gemm_phase<pg8::EpiProj, pg8::StaticOrder, PG8_ALIGN, PG8_SP2>(F.lds + RING_OFF, g, S, E);
        if (BOTH(1)) GRID_BAR();
    }
    if (IN(2)) { p2_retention_scan(F); __syncthreads(); p2_diffattn(F, (char*)lds + RING_OFF); if (BOTH(2)) GRID_BAR(); }
    if (IN(3)) {
        p3_retention_out(F); GRID_BAR();
        pg8::Gemm g{(const bf16*)(ws + WS_MIX), (const bf16*)(ws + WS_WOUT), M, D, D}; pg8::StaticOrder S; S.init(M, D, F.G, (int)blockIdx.x);
        pg8::EpiResF32 E{F.in[0], F.out, D, ALPHA};
        pg8::gemm_phase<pg8::EpiResF32, pg8::StaticOrder, PG8_ALIGN, PG8_SP2>(F.lds + RING_OFF, g, S, E);
        if (BOTH(3)) GRID_BAR();
    }
    if (IN(4)) { p3_ln1_rows(F); if (BOTH(4)) GRID_BAR(); }
    if (IN(5)) {
        pg8::Gemm g{(const bf16*)(ws + WS_X1), (const bf16*)(ws + WS_WQ), M, NQ, D}; pg8::StaticOrder S; S.init(M, NQ, F.G, (int)blockIdx.x);
        pg8::EpiPlainBf16 E{(bf16*)(ws + WS_QP), NQ};
        pg8::gemm_phase<pg8::EpiPlainBf16, pg8::StaticOrder, PG8_ALIGN, PG8_SP2>(F.lds + RING_OFF, g, S, E);
        if (BOTH(5)) GRID_BAR();
    }
    if (IN(6)) { p5_topk_fast(F); if (BOTH(6)) GRID_BAR(); }
    if (IN(7)) { p6_experts(F); }
#undef IN
#undef BOTH
}

extern "C" void kernel_launch(void* const* d_in, const int* in_sizes, int n_in, void* d_out, int out_size, void* d_ws, size_t ws_size, hipStream_t stream) {
    static int grid = 0;
    if (grid == 0) {
        if (n_in != 18 || in_sizes[0] != M * D || out_size != M * D || ws_size < WS_END) { fprintf(stderr, "kernel_launch: unexpected shapes / workspace (n_in %d, in0 %d, out %d, ws %zu, need %zu); nothing launched\n", n_in, n_in > 0 ? in_sizes[0] : -1, out_size, ws_size, (size_t)WS_END); grid = -1; return; }
        int dev = 0, cus = 0, per_cu = 0;
        if (hipGetDevice(&dev) != hipSuccess || hipDeviceGetAttribute(&cus, hipDeviceAttributeMultiprocessorCount, dev) != hipSuccess) { fprintf(stderr, "kernel_launch: device query failed\n"); grid = -1; return; }
        if (hipFuncSetAttribute((const void*)hymba_fwd, hipFuncAttributeMaxDynamicSharedMemorySize, LDS_BYTES) != hipSuccess) { fprintf(stderr, "kernel_launch: hipFuncSetAttribute failed\n"); grid = -1; return; }
        if (hipOccupancyMaxActiveBlocksPerMultiprocessor(&per_cu, (const void*)hymba_fwd, NWAVES * 64, LDS_BYTES) != hipSuccess || per_cu < 1)
            fprintf(stderr, "kernel_launch: note: occupancy query reports %d workgroups per CU\n", per_cu);
        (void)hipGetLastError();
        grid = cus;
        if (grid != 256) fprintf(stderr, "kernel_launch: note: %d CUs (tuned for 256)\n", grid);
    }
    if (grid < 0) return;
    if (hipMemsetAsync((char*)d_ws + WS_CTL, 0, CTL_ZERO_BYTES, stream) != hipSuccess) { fprintf(stderr, "kernel_launch: memset failed\n"); return; }
    Args a{};
    for (int i = 0; i < 18; ++i) a.in[i] = (const float*)d_in[i];
    a.out = (float*)d_out; a.ws = (unsigned char*)d_ws;
    hipLaunchKernelGGL(hymba_fwd, dim3(grid), dim3(NWAVES * 64), LDS_BYTES, stream, a);
    const hipError_t le = hipPeekAtLastError();
    if (le != hipSuccess) fprintf(stderr, "kernel_launch: launch failed: %s\n", hipGetErrorName(le));
}
```
